# Optimizing an MI355X kernel written in HIP

```python
import jax, jax.numpy as jnp
from jax import lax
import numpy as np

D_MODEL = 2048
BATCH = 1
SEQ = 16384
DEPTH = 2

HEAD_DIM = 128
ROPE_DIM = HEAD_DIM // 4
ROPE_THETA = 500000.0
A_Q_HEADS = 16
A_KV_HEADS = 4
IDX_HEADS = 16
IDX_DIM = 64
IDX_ROPE_DIM = IDX_DIM // 4
TOPK_MAX = 256
B_GROUPS = ((128, 1), (512, 4), (2048, 16))
B_Q_HEADS = 16
B_KV_HEADS = 4
D_FF = 4 * D_MODEL
Q_BLOCK = 128
EPS = 1e-6
N_A = DEPTH // 2
N_B = DEPTH - N_A

A_Q_W = A_Q_HEADS * HEAD_DIM
A_KV_W = A_KV_HEADS * HEAD_DIM
A_QI_W = IDX_HEADS * IDX_DIM
A_IN_W = A_Q_W + 2 * A_KV_W + A_QI_W + IDX_DIM + IDX_HEADS
A_SPLITS = (A_Q_W, A_Q_W + A_KV_W, A_Q_W + 2 * A_KV_W, A_Q_W + 2 * A_KV_W + A_QI_W,
            A_Q_W + 2 * A_KV_W + A_QI_W + IDX_DIM)
B_Q_W = len(B_GROUPS) * B_Q_HEADS * HEAD_DIM
B_KV_W = B_KV_HEADS * HEAD_DIM
B_OUT_W = B_Q_HEADS * HEAD_DIM

kernel_name = "yoco_dsa_dilated_hybrid"


def rmsnorm(x, g):
    x32 = x.astype(jnp.float32)
    y = x32 * lax.rsqrt(jnp.mean(x32 * x32, axis=-1, keepdims=True) + EPS)
    return (y * g.astype(jnp.float32)).astype(x.dtype)


def rope_tables(seq, rot_dim):
    inv = ROPE_THETA ** (-jnp.arange(0, rot_dim, 2, dtype=jnp.float32) / rot_dim)
    ang = jnp.arange(seq, dtype=jnp.float32)[:, None] * inv[None, :]
    return jnp.cos(ang), jnp.sin(ang)


def apply_rope(x, cos, sin):
    half = cos.shape[-1]
    c = cos[None, :, None, :].astype(x.dtype)
    s = sin[None, :, None, :].astype(x.dtype)
    x1, x2, xp = x[..., :half], x[..., half:2 * half], x[..., 2 * half:]
    return jnp.concatenate([x1 * c - x2 * s, x2 * c + x1 * s, xp], axis=-1)


def to_blocks(a):
    b, s = a.shape[:2]
    return jnp.moveaxis(a.reshape(b, s // Q_BLOCK, Q_BLOCK, *a.shape[2:]), 1, 0)


def from_blocks(a):
    a = jnp.moveaxis(a, 0, 1)
    return a.reshape(a.shape[0], a.shape[1] * a.shape[2], *a.shape[3:])


def dsa_mixer(h, w_in, w_out, rope_h, rope_i):
    b, s, _ = h.shape
    rep = A_Q_HEADS // A_KV_HEADS
    topk = min(TOPK_MAX, s // 4)
    q, k, v, qi, ki, wi = jnp.split(h @ w_in, A_SPLITS, axis=-1)
    q = apply_rope(q.reshape(b, s, A_Q_HEADS, HEAD_DIM), *rope_h).reshape(b, s, A_KV_HEADS, rep, HEAD_DIM)
    k = apply_rope(k.reshape(b, s, A_KV_HEADS, HEAD_DIM), *rope_h)
    v = v.reshape(b, s, A_KV_HEADS, HEAD_DIM)
    qi = apply_rope(qi.reshape(b, s, IDX_HEADS, IDX_DIM), *rope_i)
    ki = apply_rope(ki.reshape(b, s, 1, IDX_DIM), *rope_i)[:, :, 0]
    wi = wi * (IDX_HEADS ** -0.5)
    key_pos = jnp.arange(s)
    bidx = jnp.arange(b)[:, None, None]

    def block(args):
        qb, qib, wib, tq = args
        isc = jnp.einsum('bqhd,bsd->bqhs', qib, ki, preferred_element_type=jnp.float32) * (IDX_DIM ** -0.5)
        isc = jnp.einsum('bqhs,bqh->bqs', jax.nn.relu(isc), wib.astype(jnp.float32))
        isc = jnp.where((key_pos[None, :] <= tq[:, None])[None], isc, -jnp.inf)
        _, sel = lax.top_k(isc, topk)
        kg = k[bidx, sel]
        vg = v[bidx, sel]
        sc = jnp.einsum('bqgrd,bqkgd->bqgrk', qb, kg, preferred_element_type=jnp.float32) * (HEAD_DIM ** -0.5)
        valid = (sel <= tq[None, :, None])[:, :, None, None, :]
        p = jax.nn.softmax(jnp.where(valid, sc, -jnp.inf), axis=-1)
        o = jnp.einsum('bqgrk,bqkgd->bqgrd', p.astype(vg.dtype), vg)
        return o.reshape(b, Q_BLOCK, A_Q_W)

    tpos = key_pos.reshape(s // Q_BLOCK, Q_BLOCK)
    out = lax.map(block, (to_blocks(q), to_blocks(qi), to_blocks(wi), tpos))
    return from_blocks(out) @ w_out


def dilated_mixer(h, w_q, w_out, k_sh, v_sh, rope_h):
    b, s, _ = h.shape
    ng = len(B_GROUPS)
    rep = B_Q_HEADS // B_KV_HEADS
    q = apply_rope((h @ w_q).reshape(b, s, ng * B_Q_HEADS, HEAD_DIM), *rope_h)
    q = q.reshape(b, s, ng, B_KV_HEADS, rep, HEAD_DIM)

    def block(args):
        qb, tq = args
        outs, lses = [], []
        for g, (win, dil) in enumerate(B_GROUPS):
            pos = tq[:, None] - dil * jnp.arange(win // dil + 1)[None, :]
            valid = (pos >= 0)[None, :, None, None, :]
            pos = jnp.maximum(pos, 0)
            kg = k_sh[:, pos]
            vg = v_sh[:, pos]
            sc = jnp.einsum('bqhrd,bqnhd->bqhrn', qb[:, :, g], kg, preferred_element_type=jnp.float32) * (HEAD_DIM ** -0.5)
            sc = jnp.where(valid, sc, -jnp.inf)
            m = jnp.max(sc, axis=-1, keepdims=True)
            e = jnp.exp(sc - m)
            den = jnp.sum(e, axis=-1, keepdims=True)
            o = jnp.einsum('bqhrn,bqnhd->bqhrd', (e / den).astype(vg.dtype), vg)
            outs.append(o.astype(jnp.float32))
            lses.append((m + jnp.log(den))[..., 0])
        wts = jax.nn.softmax(jnp.stack(lses, axis=0), axis=0)
        o = jnp.einsum('gbqhr,gbqhrd->bqhrd', wts, jnp.stack(outs, axis=0))
        return o.reshape(b, Q_BLOCK, B_OUT_W).astype(h.dtype)

    tpos = jnp.arange(s).reshape(s // Q_BLOCK, Q_BLOCK)
    out = lax.map(block, (to_blocks(q), tpos))
    return from_blocks(out) @ w_out


def sq_relu_mlp(h, w_up, w_down):
    u = jax.nn.relu(h @ w_up)
    return (u * u) @ w_down


def setup_inputs(seed: int = 0) -> dict:
    key = jax.random.key(seed)
    ks = jax.random.split(key, 13)

    def w(k, shape):
        return jax.random.normal(k, shape, jnp.float32) * (shape[-2] ** -0.5)

    def gain(k, shape):
        return 1.0 + 0.01 * jax.random.normal(k, shape, jnp.float32)

    return {
        'x': jax.random.normal(ks[0], (BATCH, SEQ, D_MODEL), jnp.float32),
        'a_attn_norm': gain(ks[1], (N_A, D_MODEL)),
        'a_w_in': w(ks[2], (N_A, D_MODEL, A_IN_W)),
        'a_w_out': w(ks[3], (N_A, A_Q_W, D_MODEL)),
        'kv_norm': gain(ks[4], (D_MODEL,)),
        'w_kv': w(ks[5], (D_MODEL, 2 * B_KV_W)),
        'b_attn_norm': gain(ks[6], (N_B, D_MODEL)),
        'b_w_q': w(ks[7], (N_B, D_MODEL, B_Q_W)),
        'b_w_out': w(ks[8], (N_B, B_OUT_W, D_MODEL)),
        'mlp_norm': gain(ks[9], (DEPTH, D_MODEL)),
        'w_up': w(ks[10], (DEPTH, D_MODEL, D_FF)),
        'w_down': w(ks[11], (DEPTH, D_FF, D_MODEL)),
        'final_norm': gain(ks[12], (D_MODEL,)),
    }


def reference(x, a_attn_norm, a_w_in, a_w_out, kv_norm, w_kv, b_attn_norm, b_w_q, b_w_out,
              mlp_norm, w_up, w_down, final_norm):
    b, s, _ = x.shape
    rope_h = rope_tables(s, ROPE_DIM)
    rope_i = rope_tables(s, IDX_ROPE_DIM)
    h = x
    k_sh = None
    v_sh = None
    for i in range(DEPTH):
        if i < N_A:
            h = h + dsa_mixer(rmsnorm(h, a_attn_norm[i]), a_w_in[i], a_w_out[i], rope_h, rope_i)
        else:
            j = i - N_A
            if j == 0:
                kv = rmsnorm(h, kv_norm) @ w_kv
                k_sh = apply_rope(kv[..., :B_KV_W].reshape(b, s, B_KV_HEADS, HEAD_DIM), *rope_h)
                v_sh = kv[..., B_KV_W:].reshape(b, s, B_KV_HEADS, HEAD_DIM)
            h = h + dilated_mixer(rmsnorm(h, b_attn_norm[j]), b_w_q[j], b_w_out[j], k_sh, v_sh, rope_h)
        h = h + sq_relu_mlp(rmsnorm(h, mlp_norm[i]), w_up[i], w_down[i])
    return rmsnorm(h, final_norm)
```

```cpp
#include <hip/hip_runtime.h>
#include <cstdio>
#include <cstdint>
#include <cmath>
namespace pg8 {
#define PG8_LAS __attribute__((address_space(3)))
typedef unsigned short bf16_t;
typedef short bf16x8 __attribute__((ext_vector_type(8)));
typedef float f32x4 __attribute__((ext_vector_type(4)));
typedef unsigned u32x4 __attribute__((ext_vector_type(4)));
constexpr int BM = 256, BK = 64, HALF = 128, HTB = HALF * BK * 2  , STAGE_BYTES = 8 * HTB, NXCD = 8, WGM = 8;

__host__ __device__ __forceinline__ int lds_byte(int r, int c) { const int st = (r >> 4) * 2 + (c >> 5), rr = r & 15, cc = c & 31, ob = rr * 64 + cc * 2; return st * 1024 + (ob ^ (((ob >> 9) & 1) << 5)); }
__host__ __device__ __forceinline__ void stage_rc(int b, int& R, int& C) { const int st = b / 1024, sb = b % 1024, swz = sb ^ (((sb >> 9) & 1) << 5); R = (st >> 1) * 16 + swz / 64; C = (st & 1) * 32 + (swz % 64) / 2; }
__host__ __device__ __forceinline__ int perm32(int rho) { const int n = rho >> 4, i = rho & 15; return 8 * (i >> 2) + 4 * n + (i & 3); }

struct Unit { int pm, pn; };
struct Gemm { const bf16_t* A; const bf16_t* Bt; int M, N, K; };

struct StaticOrder {
    int nM, nN, nwg, G, c;
    __host__ __device__ void init(int M, int N, int G_, int c_) { nM = M / BM; nN = N / BM; nwg = nM * nN; G = G_; c = c_; }
    __host__ __device__ bool next(int i, Unit& u) const {
        const long L = (long)i * G + c; if (L >= nwg) return false;
        int wgid = (int)L; { const int q = nwg / NXCD, r = nwg % NXCD, xcd = wgid % NXCD, off = wgid / NXCD; wgid = (xcd < r ? xcd * (q + 1) : r * (q + 1) + (xcd - r) * q) + off; }
        const int nig = WGM * nN, gid = wgid / nig, fm = gid * WGM, gsz = (nM - fm) < WGM ? (nM - fm) : WGM;
        u.pm = fm + ((wgid % nig) % gsz); u.pn = (wgid % nig) / gsz; return true;
    }
    __device__ __forceinline__ void a_ready(const Unit&) const {}
    __device__ __forceinline__ void done(const Unit&) const {}
};


__device__ __forceinline__ unsigned cvt_pk_bf16(float lo, float hi) { unsigned r; asm volatile("v_cvt_pk_bf16_f32 %0, %1, %2" : "=v"(r) : "v"(lo), "v"(hi)); return r; }
typedef unsigned u32x2 __attribute__((ext_vector_type(2)));
constexpr float RMS_EPS = 1e-6f;
typedef unsigned long long ssq_t;
__device__ __forceinline__ ssq_t ss_fix(float q) { return (ssq_t)(q * 65536.0f + 0.5f); }
__device__ __forceinline__ float rstd_of(ssq_t ss) { return 1.0f / sqrtf((float)ss * (1.0f / (65536.0f * 2048.0f)) + RMS_EPS); }
__device__ __forceinline__ u32x2 pack4(f32x4 v) { u32x2 w; w.x = cvt_pk_bf16(v[0], v[1]); w.y = cvt_pk_bf16(v[2], v[3]); return w; }

__device__ __forceinline__ size_t tm_off(int t, int c, int ld) { return (size_t)((t >> 8) * (ld >> 8) + (c >> 8)) * (size_t)(BM * BM) + (size_t)((t & 255) * BM + (c & 255)); }

__device__ __forceinline__ void store_heads128(const f32x4 (&acc)[2][2][4][2], int row0, int wc, int fq, const ssq_t* ss, bf16_t* base, int ld, int colt, bool rope, const float* cosh, const float* sinh) {
    rope = rope && (wc == 0);
    const int col0 = colt + wc * 32 + 4 * fq;
#pragma unroll
    for (int ai = 0; ai < 2; ++ai)
#pragma unroll
        for (int m = 0; m < 4; ++m) {
            const int row = row0 + ai * HALF + m * 16;
            const float rs = rstd_of(ss[row]);
            f32x4 c4 = (f32x4){1.f, 1.f, 1.f, 1.f}, s4 = (f32x4){0.f, 0.f, 0.f, 0.f};
            if (rope) { c4 = *(const f32x4*)(cosh + (size_t)row * 16 + 4 * fq); s4 = *(const f32x4*)(sinh + (size_t)row * 16 + 4 * fq); }
            bf16_t* rowp = base + tm_off(row, col0, ld);
#pragma unroll
            for (int bj = 0; bj < 2; ++bj) {
                f32x4 v0 = acc[ai][bj][m][0] * rs, v1 = acc[ai][bj][m][1] * rs;
                if (rope) { const f32x4 a = v0 * c4 - v1 * s4, b = v1 * c4 + v0 * s4; v0 = a; v1 = b; }
                *(u32x2*)(rowp + bj * HALF) = pack4(v0); *(u32x2*)(rowp + bj * HALF + 16) = pack4(v1);
            }
        }
}

constexpr int SEQ = 16384;
__device__ __forceinline__ int pack4_fp8(f32x4 v) { int w = __builtin_amdgcn_cvt_pk_fp8_f32(v[0], v[1], 0, false); return __builtin_amdgcn_cvt_pk_fp8_f32(v[2], v[3], w, true); }
__device__ __forceinline__ void store_heads128_fp8(const f32x4 (&acc)[2][2][4][2], int row0, int wc, int fq, const ssq_t* ss, unsigned char* base, int head0, bool rope, const float* cosh, const float* sinh) {
    rope = rope && (wc == 0);
#pragma unroll
    for (int ai = 0; ai < 2; ++ai)
#pragma unroll
        for (int m = 0; m < 4; ++m) {
            const int row = row0 + ai * HALF + m * 16;
            const float rs = rstd_of(ss[row]);
            f32x4 c4 = (f32x4){1.f, 1.f, 1.f, 1.f}, s4 = (f32x4){0.f, 0.f, 0.f, 0.f};
            if (rope) { c4 = *(const f32x4*)(cosh + (size_t)row * 16 + 4 * fq); s4 = *(const f32x4*)(sinh + (size_t)row * 16 + 4 * fq); }
#pragma unroll
            for (int bj = 0; bj < 2; ++bj) {
                f32x4 v0 = acc[ai][bj][m][0] * rs, v1 = acc[ai][bj][m][1] * rs;
                if (rope) { const f32x4 a = v0 * c4 - v1 * s4, b = v1 * c4 + v0 * s4; v0 = a; v1 = b; }
                unsigned char* p = base + ((size_t)(head0 + bj) * SEQ + row) * 128 + wc * 32 + 4 * fq;
                *(int*)p = pack4_fp8(v0); *(int*)(p + 16) = pack4_fp8(v1);
            }
        }
}

__device__ __forceinline__ void store_heads128_q8(const f32x4 (&acc)[2][2][4][2], int row0, int wc, int fq, const ssq_t* ss, unsigned char* base, int ld, int colt, const float* cosh, const float* sinh) {
    const bool rope = (wc == 0);
    const int col0 = colt + wc * 32 + 4 * fq;
#pragma unroll
    for (int ai = 0; ai < 2; ++ai)
#pragma unroll
        for (int m = 0; m < 4; ++m) {
            const int row = row0 + ai * HALF + m * 16;
            const float rs = rstd_of(ss[row]);
            f32x4 c4 = (f32x4){1.f, 1.f, 1.f, 1.f}, s4 = (f32x4){0.f, 0.f, 0.f, 0.f};
            if (rope) { c4 = *(const f32x4*)(cosh + (size_t)row * 16 + 4 * fq); s4 = *(const f32x4*)(sinh + (size_t)row * 16 + 4 * fq); }
            unsigned char* rowp = base + tm_off(row, col0, ld);
#pragma unroll
            for (int bj = 0; bj < 2; ++bj) {
                f32x4 v0 = acc[ai][bj][m][0] * rs, v1 = acc[ai][bj][m][1] * rs;
                if (rope) { const f32x4 a = v0 * c4 - v1 * s4, b = v1 * c4 + v0 * s4; v0 = a; v1 = b; }
                *(int*)(rowp + bj * HALF) = pack4_fp8(v0); *(int*)(rowp + bj * HALF + 16) = pack4_fp8(v1);
            }
        }
}

struct EpiIn {
    static constexpr bool PERM = false, AFTER_DRAIN = false;
    const ssq_t* ss;
    const float *cosh, *sinh, *cosi, *sini;
    bf16_t *Q, *K, *V, *QI, *KI; float* WI;
    __device__ __forceinline__ void operator()(const f32x4 (&acc)[2][2][4][2], const Unit& u, int wr, int wc, int fr, int fq) const {
        const int row0 = u.pm * BM + wr * 64 + fr, pn = u.pn;
        if (pn < 12) {
            if (pn < 8) store_heads128_q8(acc, row0, wc, fq, ss, (unsigned char*)Q, 2048, pn * 256, cosh, sinh);
            else if (pn < 10) store_heads128_fp8(acc, row0, wc, fq, ss, (unsigned char*)K, 2 * (pn - 8), true, cosh, sinh);
            else store_heads128_fp8(acc, row0, wc, fq, ss, (unsigned char*)V, 2 * (pn - 10), false, cosh, sinh);
        } else if (pn < 16) {
            const int col0 = (pn - 12) * 256 + wc * 32 + 4 * fq; const bool rope = (wc & 1) == 0;
#pragma unroll
            for (int ai = 0; ai < 2; ++ai)
#pragma unroll
                for (int m = 0; m < 4; ++m) {
                    const int row = row0 + ai * HALF + m * 16; const float rs = rstd_of(ss[row]);
                    const f32x4 c4 = *(const f32x4*)(cosi + (size_t)row * 8 + 4 * (fq & 1)), s4 = *(const f32x4*)(sini + (size_t)row * 8 + 4 * (fq & 1));
                    bf16_t* rowp = QI + tm_off(row, col0, 1024);
#pragma unroll
                    for (int bj = 0; bj < 2; ++bj) {
                        f32x4 v0 = acc[ai][bj][m][0] * rs; const f32x4 v1 = acc[ai][bj][m][1] * rs;
                        f32x4 p; p[0] = __shfl_xor(v0[0], 32); p[1] = __shfl_xor(v0[1], 32); p[2] = __shfl_xor(v0[2], 32); p[3] = __shfl_xor(v0[3], 32);
                        if (rope) v0 = (fq < 2) ? (v0 * c4 - p * s4) : (v0 * c4 + p * s4);
                        *(u32x2*)(rowp + bj * HALF) = pack4(v0); *(u32x2*)(rowp + bj * HALF + 16) = pack4(v1);
                    }
                }
        } else {
#pragma unroll
            for (int ai = 0; ai < 2; ++ai)
#pragma unroll
                for (int m = 0; m < 4; ++m) {
                    const int row = row0 + ai * HALF + m * 16; const float rs = rstd_of(ss[row]);
                    if (wc < 2) {
                        const f32x4 c4 = *(const f32x4*)(cosi + (size_t)row * 8 + 4 * (fq & 1)), s4 = *(const f32x4*)(sini + (size_t)row * 8 + 4 * (fq & 1));
                        f32x4 v0 = acc[ai][0][m][0] * rs; const f32x4 v1 = acc[ai][0][m][1] * rs;
                        f32x4 p; p[0] = __shfl_xor(v0[0], 32); p[1] = __shfl_xor(v0[1], 32); p[2] = __shfl_xor(v0[2], 32); p[3] = __shfl_xor(v0[3], 32);
                        if (wc == 0) v0 = (fq < 2) ? (v0 * c4 - p * s4) : (v0 * c4 + p * s4);
                        bf16_t* rowp = KI + ((size_t)(((row >> 5) * 4 + 2 * wc) * 32 + (row & 31)) * 2 + (fq >> 1)) * 8 + 4 * (fq & 1);
                        *(u32x2*)(rowp) = pack4(v0); *(u32x2*)(rowp + 512) = pack4(v1);
                    } else if (wc == 2) {
                        *(f32x4*)(WI + (size_t)row * 16 + 4 * fq) = acc[ai][0][m][0] * (rs * 0.03125f);
                    }
                }
        }
    }
};

struct EpiKvq {
    static constexpr bool PERM = false, AFTER_DRAIN = false;
    const ssq_t* ss; const float *cosh, *sinh; bf16_t *K, *V, *Q;
    __device__ __forceinline__ void operator()(const f32x4 (&acc)[2][2][4][2], const Unit& u, int wr, int wc, int fr, int fq) const {
        const int row0 = u.pm * BM + wr * 64 + fr, pn = u.pn;
        if (pn < 2) store_heads128(acc, row0, wc, fq, ss, K, 512, pn * 256, true, cosh, sinh);
        else if (pn < 4) store_heads128(acc, row0, wc, fq, ss, V, 512, (pn - 2) * 256, false, cosh, sinh);
        else store_heads128_q8(acc, row0, wc, fq, ss, (unsigned char*)Q, 6144, (pn - 4) * 256, cosh, sinh);
    }
};

struct EpiRes {
    static constexpr bool PERM = true, AFTER_DRAIN = false;
    bf16_t* hb; ssq_t* ssq;
    __device__ __forceinline__ void operator()(const f32x4 (&acc)[2][2][4][2], const Unit& u, int wr, int wc, int fr, int fq) const {
        const int row0 = u.pm * BM + wr * 64 + fr, col0 = u.pn * BM + wc * 32 + 8 * fq;
#pragma unroll
        for (int ai = 0; ai < 2; ++ai)
#pragma unroll
            for (int m = 0; m < 4; ++m) {
                const int row = row0 + ai * HALF + m * 16; float q = 0.f;
                bf16_t* rowp = hb + ((size_t)(u.pm * 8 + u.pn) * (size_t)(BM * BM) + (size_t)((wc >> 1) * (BM * BK) + (row - u.pm * BM) * BK + (wc & 1) * 32 + 8 * fq));
                u32x4 b[2];
#pragma unroll
                for (int bj = 0; bj < 2; ++bj) b[bj] = *(const u32x4*)(rowp + bj * (2 * BM * BK));
#pragma unroll
                for (int bj = 0; bj < 2; ++bj) {
                    u32x4 w;
#pragma unroll
                    for (int i = 0; i < 4; ++i) {
                        const f32x4& a = acc[ai][bj][m][i >> 1];
                        const float lo = __uint_as_float(b[bj][i] << 16) + a[(i & 1) * 2], hi = __uint_as_float(b[bj][i] & 0xffff0000u) + a[(i & 1) * 2 + 1];
                        const unsigned pk = cvt_pk_bf16(lo, hi); w[i] = pk;
                        const float rl = __uint_as_float(pk << 16), rh = __uint_as_float(pk & 0xffff0000u);
                        q += rl * rl + rh * rh;
                    }
                    *(u32x4*)(rowp + bj * (2 * BM * BK)) = w;
                }
                q += __shfl_xor(q, 16); q += __shfl_xor(q, 32);
                if (fq == 0) atomicAdd(ssq + row, ss_fix(q));
            }
    }
};

struct RowOrder {
    int nN, nwg, G, c;
    __host__ __device__ void init(int M, int N, int G_, int c_) { nN = N / BM; nwg = (M / BM) * nN; G = G_; c = c_; }
    __host__ __device__ static bool usable(int M, int N, int G_) { const int n = N / BM; return G_ % (NXCD * n) == 0 && ((M / BM) * n) % G_ == 0; }
    __host__ __device__ bool next(int i, Unit& u) const {
        if ((long)i * G + c >= nwg) return false;
        const int ppx = G / NXCD / nN, x = c % NXCD, j = c / NXCD;
        u.pm = i * (G / nN) + x * ppx + (j % ppx); u.pn = j / ppx; return true;
    }
    __device__ __forceinline__ void a_ready(const Unit&) const {}
    __device__ __forceinline__ void done(const Unit&) const {}
};

struct EpiUp {
    static constexpr bool PERM = true, AFTER_DRAIN = false;
    const ssq_t* ss; bf16_t* O; int ldc; int dry;
    __device__ __forceinline__ void operator()(const f32x4 (&acc)[2][2][4][2], const Unit& u, int wr, int wc, int fr, int fq) const {
        const int row0 = u.pm * BM + wr * 64 + fr, col0 = u.pn * BM + wc * 32 + 8 * fq;
#pragma unroll
        for (int ai = 0; ai < 2; ++ai)
#pragma unroll
            for (int m = 0; m < 4; ++m) {
                const int row = row0 + ai * HALF + m * 16; const float rs = rstd_of(ss[row]);
                bf16_t* rowp = O + ((size_t)(u.pm * (ldc / BM) + u.pn) * (size_t)(BM * BM) + (size_t)((wc >> 1) * (BM * BK) + (row - u.pm * BM) * BK + (wc & 1) * 32 + 8 * fq));
#pragma unroll
                for (int bj = 0; bj < 2; ++bj) {
                    f32x4 v0 = acc[ai][bj][m][0] * rs, v1 = acc[ai][bj][m][1] * rs;
                    v0 = __builtin_elementwise_max(v0, (f32x4){0.f, 0.f, 0.f, 0.f}); v1 = __builtin_elementwise_max(v1, (f32x4){0.f, 0.f, 0.f, 0.f});
                    v0 = v0 * v0; v1 = v1 * v1;
                    u32x4 w; w.x = cvt_pk_bf16(v0[0], v0[1]); w.y = cvt_pk_bf16(v0[2], v0[3]); w.z = cvt_pk_bf16(v1[0], v1[1]); w.w = cvt_pk_bf16(v1[2], v1[3]);
                    if (dry) asm volatile("" :: "v"(w.x), "v"(w.y), "v"(w.z), "v"(w.w)); else *(u32x4*)(rowp + bj * (2 * BM * BK)) = w;
                }
            }
    }
};
template <class Epi, class Sched, bool ALIGN_EPI = false, bool SP2 = false, bool ATILED = false>
__device__ __forceinline__ void gemm_phase(PG8_LAS unsigned char* lds, const Gemm g, const Sched& S, const Epi& E) {
    const int tid = threadIdx.x, wid = __builtin_amdgcn_readfirstlane(tid >> 6), lane = tid & 63, wr = wid >> 2, wc = wid & 3, fr = lane & 15, fq = lane >> 4;
    const int K = g.K, nt = K / BK;
    const int LDA = ATILED ? BK : K;
    unsigned voffA[2], voffB[2];
#pragma unroll
    for (int i = 0; i < 2; ++i) { int R, C; stage_rc(tid * 16 + i * 8192, R, C); const int Rb = Epi::PERM ? ((R & ~31) + perm32(R & 31)) : R;
        voffA[i] = (unsigned)(R * LDA + C) * 2u; voffB[i] = (unsigned)(Rb * LDA + C) * 2u; }
    const size_t kstep = (size_t)(BK * 2);
    const size_t hstepA = (size_t)HALF * LDA * 2, hstepB = hstepA;
    const size_t tstep = (size_t)BM * K * 2;
    const unsigned ldsw = (unsigned)wid * 1024u;
    const int aoff = lds_byte(wr * 64 + fr, fq * 8), boff = lds_byte(wc * 32 + fr, fq * 8);
#define PG8_SA(b, h) (((b) * 2 + (h)) * HTB)
#define PG8_SB(b, h) ((4 + (b) * 2 + (h)) * HTB)
#define PG8_STAGE(bufoff, gbase, voff) do { _Pragma("unroll") for (int _i = 0; _i < 2; ++_i) \
        __builtin_amdgcn_global_load_lds((const unsigned*)((const char*)(gbase) + (voff)[_i]), (PG8_LAS unsigned*)(lds + (bufoff) + ldsw + _i * 8192), 16, 0, 0); } while (0)
#define PG8_LDA(dst, b, h) do { _Pragma("unroll") for (int m = 0; m < 4; ++m) _Pragma("unroll") for (int k = 0; k < 2; ++k) dst[m][k] = *(const PG8_LAS bf16x8*)(lds + PG8_SA(b, h) + aoff + m * 2048 + k * 1024); } while (0)
#define PG8_LDB(dst, b, h) do { _Pragma("unroll") for (int n = 0; n < 2; ++n) _Pragma("unroll") for (int k = 0; k < 2; ++k) dst[n][k] = *(const PG8_LAS bf16x8*)(lds + PG8_SB(b, h) + boff + n * 2048 + k * 1024); } while (0)
#define PG8_MMA(ai, bj, At, Bt) do { __builtin_amdgcn_s_setprio(1); _Pragma("unroll") for (int m = 0; m < 4; ++m) _Pragma("unroll") for (int n = 0; n < 2; ++n) _Pragma("unroll") for (int k = 0; k < 2; ++k) \
        acc[ai][bj][m][n] = __builtin_amdgcn_mfma_f32_16x16x32_bf16(Bt[n][k], At[m][k], acc[ai][bj][m][n], 0, 0, 0); __builtin_amdgcn_s_setprio(0); } while (0)
#define PG8_WAIT_V(n) asm volatile("s_waitcnt vmcnt(" #n ")" ::: "memory")
#define PG8_WAIT_L(n) asm volatile("s_waitcnt lgkmcnt(" #n ")" ::: "memory")
#define PG8_BAR __builtin_amdgcn_s_barrier()
#define PG8_SCHED __builtin_amdgcn_sched_barrier(0)
    auto akt = [&](int t) -> size_t { return ATILED ? (size_t)t * (size_t)(BM * BK * 2) : (size_t)t * kstep; };
    const size_t akt1 = akt(1);
    Unit cur, nxt; int ui = 0;
    if (!S.next(0, cur)) return;
    f32x4 acc[2][2][4][2];
#pragma unroll
    for (int a = 0; a < 2; ++a)
#pragma unroll
        for (int b = 0; b < 2; ++b)
#pragma unroll
            for (int m = 0; m < 4; ++m)
#pragma unroll
                for (int n = 0; n < 2; ++n) acc[a][b][m][n] = (f32x4){0.f, 0.f, 0.f, 0.f};
    bf16x8 At[4][2], B0[2][2], B1[2][2];
    const char* cA = (const char*)g.A + (size_t)cur.pm * tstep; const char* cB = (const char*)g.Bt + (size_t)cur.pn * tstep;
    S.a_ready(cur);
    if constexpr (SP2) {
        PG8_STAGE(PG8_SB(0, 0), cB, voffB); PG8_STAGE(PG8_SB(0, 1), cB + hstepB, voffB); PG8_STAGE(PG8_SA(0, 0), cA, voffA); PG8_STAGE(PG8_SA(0, 1), cA + hstepA, voffA);
        if (wr == 1) PG8_BAR;
        PG8_WAIT_V(2); PG8_BAR;
        PG8_STAGE(PG8_SB(1, 0), cB + akt1, voffB); PG8_STAGE(PG8_SA(1, 0), cA + akt1, voffA); PG8_STAGE(PG8_SB(1, 1), cB + hstepB + akt1, voffB);
        PG8_WAIT_V(6); PG8_BAR;
    } else {
        PG8_STAGE(PG8_SB(0, 0), cB, voffB); PG8_STAGE(PG8_SA(0, 0), cA, voffA); PG8_STAGE(PG8_SB(0, 1), cB + hstepB, voffB); PG8_STAGE(PG8_SA(0, 1), cA + hstepA, voffA);
        if (wr == 1) PG8_BAR;
        PG8_WAIT_V(4); PG8_BAR;
        PG8_STAGE(PG8_SB(1, 0), cB + akt1, voffB); PG8_STAGE(PG8_SA(1, 0), cA + akt1, voffA); PG8_STAGE(PG8_SB(1, 1), cB + hstepB + akt1, voffB);
        PG8_WAIT_V(6); PG8_BAR;
    }
    for (;;) {
        const bool has_next = S.next(ui + 1, nxt);
        const char* nA = has_next ? (const char*)g.A + (size_t)nxt.pm * tstep : cA; const char* nB = has_next ? (const char*)g.Bt + (size_t)nxt.pn * tstep : cB;
        for (int t = 0; t < nt; t += 2) {
            const bool last = (t == nt - 2);
            const char* a1 = cA + akt(t + 1);
            const char* a2 = last ? nA : cA + akt(t + 2); const char* b2 = last ? nB : cB + akt(t + 2);
            const char* a3 = a2 + akt1; const char* b3 = b2 + akt1;
            if (last && has_next) S.a_ready(nxt);
            if constexpr (SP2) {
            PG8_LDB(B0, 0, 0); PG8_LDB(B1, 0, 1); PG8_SCHED; PG8_LDA(At, 0, 0); PG8_STAGE(PG8_SA(1, 1), a1 + hstepA, voffA);
            PG8_WAIT_V(8); PG8_WAIT_L(0); PG8_BAR; PG8_MMA(0, 0, At, B0); PG8_MMA(0, 1, At, B1); PG8_BAR; PG8_SCHED;
            PG8_LDA(At, 0, 1); PG8_STAGE(PG8_SB(0, 0), b2, voffB); PG8_STAGE(PG8_SB(0, 1), b2 + hstepB, voffB); PG8_STAGE(PG8_SA(0, 0), a2, voffA);
            PG8_WAIT_V(8); PG8_WAIT_L(0); PG8_BAR; PG8_MMA(1, 0, At, B0); PG8_MMA(1, 1, At, B1); PG8_BAR; PG8_SCHED;
            PG8_LDB(B0, 1, 0); PG8_LDB(B1, 1, 1); PG8_SCHED; PG8_LDA(At, 1, 0); PG8_STAGE(PG8_SA(0, 1), a2 + hstepA, voffA);
            PG8_WAIT_V(8); PG8_WAIT_L(0); PG8_BAR; PG8_MMA(0, 0, At, B0); PG8_MMA(0, 1, At, B1); PG8_BAR; PG8_SCHED;
            PG8_LDA(At, 1, 1); PG8_STAGE(PG8_SB(1, 0), b3, voffB); PG8_STAGE(PG8_SB(1, 1), b3 + hstepB, voffB); PG8_STAGE(PG8_SA(1, 0), a3, voffA);
            PG8_WAIT_V(8); PG8_WAIT_L(0); PG8_BAR; PG8_MMA(1, 0, At, B0); PG8_MMA(1, 1, At, B1); PG8_BAR; PG8_SCHED;
            } else {
            PG8_LDB(B0, 0, 0); PG8_SCHED; PG8_LDA(At, 0, 0); PG8_STAGE(PG8_SA(1, 1), a1 + hstepA, voffA);
            PG8_WAIT_L(8); PG8_BAR; PG8_WAIT_L(0); PG8_MMA(0, 0, At, B0); PG8_BAR; PG8_SCHED;
            PG8_LDB(B1, 0, 1); PG8_STAGE(PG8_SB(0, 0), b2, voffB);
            PG8_BAR; PG8_WAIT_L(0); PG8_MMA(0, 1, At, B1); PG8_BAR;
            PG8_LDA(At, 0, 1); PG8_STAGE(PG8_SA(0, 0), a2, voffA);
            PG8_BAR; PG8_WAIT_L(0); PG8_MMA(1, 0, At, B0); PG8_BAR; PG8_SCHED;
            PG8_STAGE(PG8_SB(0, 1), b2 + hstepB, voffB);
            PG8_WAIT_V(6); PG8_BAR; PG8_MMA(1, 1, At, B1); PG8_BAR;
            PG8_LDB(B0, 1, 0); PG8_SCHED; PG8_LDA(At, 1, 0); PG8_STAGE(PG8_SA(0, 1), a2 + hstepA, voffA);
            PG8_WAIT_L(8); PG8_BAR; PG8_WAIT_L(0); PG8_MMA(0, 0, At, B0); PG8_BAR; PG8_SCHED;
            PG8_LDB(B1, 1, 1); PG8_STAGE(PG8_SB(1, 0), b3, voffB);
            PG8_BAR; PG8_WAIT_L(0); PG8_MMA(0, 1, At, B1); PG8_BAR;
            PG8_LDA(At, 1, 1); PG8_STAGE(PG8_SA(1, 0), a3, voffA);
            PG8_BAR; PG8_WAIT_L(0); PG8_MMA(1, 0, At, B0); PG8_BAR; PG8_SCHED;
            PG8_STAGE(PG8_SB(1, 1), b3 + hstepB, voffB);
            PG8_WAIT_V(6); PG8_BAR; PG8_MMA(1, 1, At, B1); PG8_BAR;
            }
        }
        if constexpr (ALIGN_EPI) { if (wr == 0) PG8_BAR; }
        if constexpr (!Epi::AFTER_DRAIN) { E(acc, cur, wr, wc, fr, fq); S.done(cur); }
        if (!has_next) break;
#pragma unroll
        for (int a = 0; a < 2; ++a)
#pragma unroll
            for (int b = 0; b < 2; ++b)
#pragma unroll
                for (int m = 0; m < 4; ++m)
#pragma unroll
                    for (int n = 0; n < 2; ++n) acc[a][b][m][n] = (f32x4){0.f, 0.f, 0.f, 0.f};
        cur = nxt; cA = nA; cB = nB; ++ui;
        if constexpr (ALIGN_EPI) { if (wr == 1) PG8_BAR; }
    }
    PG8_WAIT_V(0);
    if constexpr (!ALIGN_EPI) { if (wr == 0) PG8_BAR; }
    PG8_BAR;
    if constexpr (Epi::AFTER_DRAIN) { E.fused(acc, cur, wr, wc, fr, fq, lds, wid, lane); S.done(cur); }
#undef PG8_SA
#undef PG8_SB
#undef PG8_STAGE
#undef PG8_LDA
#undef PG8_LDB
#undef PG8_MMA
#undef PG8_WAIT_V
#undef PG8_WAIT_L
#undef PG8_BAR
#undef PG8_SCHED
}
}

constexpr int S = 16384, D = 2048, FF = 8192;
constexpr int NIN = 4176, NIN_PAD = 4352;
constexpr int NKVQ = 7168;
constexpr int TOPK = 256;
constexpr int NWAVES = 8;
constexpr int N_PHASES = 14;
#ifndef MK_ONE_LAUNCH
#define MK_ONE_LAUNCH 1
#endif

constexpr size_t MiB = 1u << 20;
constexpr size_t WS_CTL = 0, CTL_ZERO_BYTES = 16384;
constexpr size_t WS_COSH = 1 * MiB, WS_SINH = 2 * MiB, WS_COSI = 3 * MiB, WS_SINI = 3 * MiB + 512 * 1024;
constexpr size_t WS_SS = 4 * MiB;
constexpr size_t WS_SEL = 5 * MiB;
constexpr size_t WS_WIN = 13 * MiB, WS_WOA = 30 * MiB, WS_WOB = 38 * MiB, WS_WKVQ = 46 * MiB, WS_WUP = 74 * MiB, WS_WDN = 106 * MiB;
constexpr size_t WS_HB = 138 * MiB;
constexpr size_t WS_R = 202 * MiB;
constexpr size_t WS_QA = WS_R, WS_KA = WS_R + 64 * MiB, WS_VA = WS_R + 80 * MiB, WS_QI = WS_R + 96 * MiB, WS_KI = WS_R + 128 * MiB, WS_WI = WS_R + 130 * MiB, WS_OA = WS_R + 132 * MiB;
constexpr size_t WS_U = WS_R;
constexpr size_t WS_Q2 = WS_R, WS_KS = WS_R + 192 * MiB, WS_VS = WS_R + 208 * MiB, WS_O2 = WS_R + 224 * MiB;
constexpr size_t WS_END = WS_R + 288 * MiB;
constexpr size_t WS_VT0 = 5 * MiB, WS_VT1 = 21 * MiB, WS_VT2 = 46 * MiB;
static_assert(WS_OA + 64 * MiB <= WS_END && WS_U + 256 * MiB <= WS_END && WS_O2 + 64 * MiB <= WS_END, "ws map");
constexpr int CW_BAR = 0;

constexpr int RING_OFF = 0, RING_BYTES = 131072;
constexpr int LDSCTL_OFF = RING_BYTES, MISC_OFF = LDSCTL_OFF + 320;
constexpr int LDS_BYTES = 147456;

#define GAS __attribute__((address_space(1)))
#define LAS __attribute__((address_space(3)))
typedef unsigned short bf16;
typedef unsigned v4u __attribute__((ext_vector_type(4)));
typedef unsigned v2u __attribute__((ext_vector_type(2)));
typedef float f32x4 __attribute__((ext_vector_type(4)));
typedef float f32x16 __attribute__((ext_vector_type(16)));
typedef short bf16x8 __attribute__((ext_vector_type(8)));
typedef GAS unsigned gu32;
#define LDS_WAIT() asm volatile("s_waitcnt lgkmcnt(0)" ::: "memory")
#define VM_WAIT() asm volatile("s_waitcnt vmcnt(0)" ::: "memory")
__device__ __forceinline__ unsigned f2bf(float f) { unsigned u = __builtin_bit_cast(unsigned, f); return (u + 0x7fffu + ((u >> 16) & 1u)) >> 16; }
__device__ __forceinline__ unsigned pk2(float lo, float hi) { return f2bf(lo) | (f2bf(hi) << 16); }
__device__ __forceinline__ float bf2f(short v) { return __uint_as_float(((unsigned)(unsigned short)v) << 16); }
#define XB_TMO      128
#define XB_XCNT(j)  (256  + 64 * (j))
#define XB_XSUB(j)  (1280 + 64 * (j))
#define XB_XGEN(j)  (2304 + 64 * (j))
#define XB_TOP      3328
#define XB_TOPGEN   3392
#define XCD_BAR_WORDS 3456
#define XB_SPIN_CAP (1u << 18)

__device__ __forceinline__ unsigned xb_ld(unsigned* p)              { return __hip_atomic_load(p, __ATOMIC_RELAXED, __HIP_MEMORY_SCOPE_AGENT); }
__device__ __forceinline__ unsigned xb_add(unsigned* p, unsigned v) { return __hip_atomic_fetch_add(p, v, __ATOMIC_RELAXED, __HIP_MEMORY_SCOPE_AGENT); }
__device__ __forceinline__ unsigned xb_xcc_id() { return (unsigned)__builtin_amdgcn_s_getreg((3 << 11) | 20) & 0xFu; }
#define XB_SPIN(cond, bar) do { unsigned _sp = 0; while (cond) { __builtin_amdgcn_s_sleep(1); \
    if ((++_sp & 255u) == 0u) { if (xb_ld(&(bar)[XB_TMO])) break; if (_sp > XB_SPIN_CAP) { atomicAdd(&(bar)[XB_TMO], 1u); break; } } } } while (0)

struct XcdBarrier {
    unsigned* bar; unsigned x;
    volatile LAS unsigned* st;
};

__device__ __forceinline__ XcdBarrier xcd_barrier_post(unsigned* bar, volatile LAS unsigned* st) {
    XcdBarrier b; b.bar = bar; b.x = xb_xcc_id(); b.st = st;
    if (threadIdx.x == 0) (void)xb_add(&bar[XB_XCNT(b.x)], 1u);
    return b;
}
__device__ __forceinline__ void xcd_barrier_complete(unsigned* bar, unsigned x, unsigned& nloc, unsigned& nx) {
    const unsigned G = gridDim.x * gridDim.y * gridDim.z;
    unsigned sum, cnt, mine, sp = 0u;
    for (;;) {
        sum = 0u; cnt = 0u; mine = 0u;
#pragma unroll
        for (unsigned j = 0; j < 16; ++j) { const unsigned c = xb_ld(&bar[XB_XCNT(j)]); sum += c; cnt += (c > 0u) ? 1u : 0u; mine = (j == x) ? c : mine; }
        if (sum == G) break;
        __builtin_amdgcn_s_sleep(1);
        if ((++sp & 255u) == 0u) { if (xb_ld(&bar[XB_TMO])) break; if (sp > XB_SPIN_CAP) { atomicAdd(&bar[XB_TMO], 1u); break; } }
    }
    nloc = mine > 0u ? mine : 1u; nx = cnt > 0u ? cnt : 1u;
}

__device__ __forceinline__ void xcd_barrier(const XcdBarrier& b) {
    asm volatile("s_waitcnt vmcnt(0)" ::: "memory");
    __syncthreads();
    if (threadIdx.x == 0) {
        unsigned* bar = b.bar;
        __builtin_amdgcn_s_waitcnt(0);
        unsigned nloc = b.st[0], nx = b.st[1];
        if (nloc == 0u) { xcd_barrier_complete(bar, b.x, nloc, nx); b.st[0] = nloc; b.st[1] = nx; }
        const unsigned old = xb_add(&bar[XB_XSUB(b.x)], 1u);
        const unsigned gen = old / nloc;
        if (old + 1u == (gen + 1u) * nloc) {
            __builtin_amdgcn_fence(__ATOMIC_RELEASE, "agent");
            asm volatile("s_waitcnt vmcnt(0)" ::: "memory");
            const unsigned og = xb_add(&bar[XB_TOP], 1u);
            const unsigned tg = og / nx;
            if (og + 1u == (tg + 1u) * nx) xb_add(&bar[XB_TOPGEN], 1u);
            else XB_SPIN(xb_ld(&bar[XB_TOPGEN]) == tg, bar);
            __builtin_amdgcn_fence(__ATOMIC_ACQUIRE, "agent");
            xb_add(&bar[XB_XGEN(b.x)], 1u);
            asm volatile("s_waitcnt vmcnt(0)" ::: "memory");
        } else {
            XB_SPIN(xb_ld(&bar[XB_XGEN(b.x)]) == gen, bar);
            __builtin_amdgcn_fence(__ATOMIC_ACQUIRE, "agent");
            asm volatile("s_waitcnt vmcnt(0)" ::: "memory");
        }
    }
    __syncthreads();
}

struct Params { const float* in[13]; float* out; unsigned char* ws; float invh[16]; float invi[8]; int ph_lo, ph_hi; };
struct Frame {
    LAS unsigned char* lds;
    int tid, lane, wave, vcu, G;
    unsigned char* ws; unsigned char* outb;
};
template <int CTRL> __device__ __forceinline__ float dpp_mov(float v) { return __uint_as_float(__builtin_amdgcn_update_dpp(0u, __float_as_uint(v), CTRL, 0xf, 0xf, false)); }
__device__ __forceinline__ float row_sum16(float v) { v += dpp_mov<0x128>(v); v += dpp_mov<0x124>(v); v += dpp_mov<0x122>(v); v += dpp_mov<0x121>(v); return v; }
__device__ __forceinline__ float row_max16(float v) { v = __builtin_fmaxf(v, dpp_mov<0x128>(v)); v = __builtin_fmaxf(v, dpp_mov<0x124>(v)); v = __builtin_fmaxf(v, dpp_mov<0x122>(v)); v = __builtin_fmaxf(v, dpp_mov<0x121>(v)); return v; }
__device__ __forceinline__ float swap16_sum(float v) { const auto r = __builtin_amdgcn_permlane16_swap(__float_as_uint(v), __float_as_uint(v), false, false); return __uint_as_float(r[0]) + __uint_as_float(r[1]); }
__device__ __forceinline__ float swap32_sum(float v) { const auto r = __builtin_amdgcn_permlane32_swap(__float_as_uint(v), __float_as_uint(v), false, false); return __uint_as_float(r[0]) + __uint_as_float(r[1]); }
__device__ __forceinline__ float swap32_max(float v) { const auto r = __builtin_amdgcn_permlane32_swap(__float_as_uint(v), __float_as_uint(v), false, false); return __builtin_fmaxf(__uint_as_float(r[0]), __uint_as_float(r[1])); }
__device__ __forceinline__ float bcast_row0(float v) {
    const auto r = __builtin_amdgcn_permlane16_swap(__float_as_uint(v), __float_as_uint(v), false, false);
    const auto q = __builtin_amdgcn_permlane32_swap(r[0], r[0], false, false);
    return __uint_as_float(q[0]);
}
__device__ __forceinline__ float wave_sum(float v) { return swap32_sum(swap16_sum(row_sum16(v))); }

__device__ __forceinline__ size_t ktm_off(int t, int c) { return (size_t)(t >> 8) * (size_t)(256 * 2048) + (size_t)((c >> 6) * 16384 + (t & 255) * 64 + (c & 63)); }
__device__ __forceinline__ void tr_item(const float* W, int K, int N, int Npad, const float* gain, bf16* WT, int row_off, LAS float* scr, int item, int lane) {
    const int nblk = Npad / 32, kb = item / nblk, nb = item - kb * nblk, k0 = 64 * kb, n0 = 32 * nb;
    const int kr = lane >> 3, c = lane & 7, n = n0 + 4 * c;
    f32x4 v[8];
#pragma unroll
    for (int i = 0; i < 8; ++i) {
        const float* src = W + (size_t)(k0 + kr + 8 * i) * N + n;
        if (n + 3 < N) v[i] = *(const GAS f32x4*)src;
        else { v[i] = (f32x4){0.f, 0.f, 0.f, 0.f}; if (n < N) v[i].x = src[0]; if (n + 1 < N) v[i].y = src[1]; if (n + 2 < N) v[i].z = src[2]; }
    }
#pragma unroll
    for (int i = 0; i < 8; ++i) {
        const int kk = kr + 8 * i; const float gsc = gain ? gain[k0 + kk] : 1.0f;
        LAS float* d = scr + kk * 33 + 4 * c;
        d[0] = v[i].x * gsc; d[1] = v[i].y * gsc; d[2] = v[i].z * gsc; d[3] = v[i].w * gsc;
    }
    LDS_WAIT(); asm volatile("" ::: "memory");
    const int c8 = lane & 7;
#pragma unroll
    for (int j = 0; j < 4; ++j) { const int nn = (lane >> 3) + 8 * j; const LAS float* s = scr + (8 * c8) * 33 + nn;
        v4u o; o.x = pk2(s[0 * 33], s[1 * 33]); o.y = pk2(s[2 * 33], s[3 * 33]); o.z = pk2(s[4 * 33], s[5 * 33]); o.w = pk2(s[6 * 33], s[7 * 33]);
        const int row = row_off + n0 + nn;
        *(GAS v4u*)(WT + (size_t)(row >> 8) * ((size_t)256 * K) + (size_t)(kb * 16384 + (row & 255) * 64 + 8 * c8)) = o; }
    LDS_WAIT(); asm volatile("" ::: "memory");
}
__device__ __forceinline__ void sincos_acc(float angf, float& sn_, float& cs_) {
    const double a = (double)angf;
    const double k = __builtin_rint(a * 0.15915494309189535);
    double r = __builtin_fma(-k, 6.283185307179586, a); r = __builtin_fma(-k, 2.4492935982947064e-16, r);
    const double x = r * 0.25, x2 = x * x;
    const double sn = x * (1.0 + x2 * (-1.0 / 6.0 + x2 * (1.0 / 120.0 + x2 * (-1.0 / 5040.0 + x2 * (1.0 / 362880.0 + x2 * (-1.0 / 39916800.0 + x2 * (1.0 / 6227020800.0)))))));
    const double cs = 1.0 + x2 * (-0.5 + x2 * (1.0 / 24.0 + x2 * (-1.0 / 720.0 + x2 * (1.0 / 40320.0 + x2 * (-1.0 / 3628800.0 + x2 * (1.0 / 479001600.0 + x2 * (-1.0 / 87178291200.0)))))));
    const double s2 = 2.0 * sn * cs, c2 = 1.0 - 2.0 * sn * sn;
    const double s4 = 2.0 * s2 * c2, c4 = 1.0 - 2.0 * s2 * s2;
    sn_ = (float)s4; cs_ = (float)c4;
}

__device__ __forceinline__ void p0_prologue(Frame& F, const Params& P) {
    LAS float* scr = (LAS float*)(F.lds + RING_OFF + F.wave * 16384);
    const int gw = F.vcu * NWAVES + F.wave, NGW = F.G * NWAVES;
    bf16* WinT = (bf16*)(F.ws + WS_WIN); bf16* WoaT = (bf16*)(F.ws + WS_WOA); bf16* WobT = (bf16*)(F.ws + WS_WOB); bf16* WkvqT = (bf16*)(F.ws + WS_WKVQ);
    bf16* WupT = (bf16*)(F.ws + WS_WUP); bf16* WdnT = (bf16*)(F.ws + WS_WDN);
    constexpr int I0 = (D / 64) * (NIN_PAD / 32), I1 = (D / 64) * (D / 32), I2 = I1, I3 = (D / 64) * (1024 / 32), I4 = (D / 64) * (6144 / 32), I5 = (D / 64) * (FF / 32), I6 = (FF / 64) * (D / 32);
    constexpr int NITEMS = I0 + I1 + I2 + I3 + I4 + I5 + I6;
    for (int it = gw; it < NITEMS; it += NGW) {
        int r = it;
        if (r < I0) { tr_item(P.in[2], D, NIN, NIN_PAD, P.in[1], WinT, 0, scr, r, F.lane); continue; } r -= I0;
        if (r < I1) { tr_item(P.in[3], D, D, D, nullptr, WoaT, 0, scr, r, F.lane); continue; } r -= I1;
        if (r < I2) { tr_item(P.in[8], D, D, D, nullptr, WobT, 0, scr, r, F.lane); continue; } r -= I2;
        if (r < I3) { tr_item(P.in[5], D, 1024, 1024, P.in[4], WkvqT, 0, scr, r, F.lane); continue; } r -= I3;
        if (r < I4) { tr_item(P.in[7], D, 6144, 6144, P.in[6], WkvqT, 1024, scr, r, F.lane); continue; } r -= I4;
        if (r < I5) { tr_item(P.in[10], D, FF, FF, P.in[9], WupT, 0, scr, r, F.lane); continue; } r -= I5;
        tr_item(P.in[11], FF, D, D, nullptr, WdnT, 0, scr, r, F.lane);
    }
    bf16* hb = (bf16*)(F.ws + WS_HB); pg8::ssq_t* ss = (pg8::ssq_t*)(F.ws + WS_SS);
    for (int m = gw; m < S; m += NGW) {
        const GAS f32x4* xr = (const GAS f32x4*)(P.in[0] + (size_t)m * D) + F.lane;
        f32x4 v[8]; float s = 0.f;
#pragma unroll
        for (int j = 0; j < 8; ++j) { v[j] = xr[64 * j]; s += (v[j].x * v[j].x + v[j].y * v[j].y) + (v[j].z * v[j].z + v[j].w * v[j].w); }
        s = wave_sum(s);
        GAS v2u* o8 = (GAS v2u*)(hb + (size_t)(m >> 8) * (256 * D) + (size_t)((F.lane >> 4) * 16384 + (m & 255) * 64 + 4 * (F.lane & 15)));
#pragma unroll
        for (int j = 0; j < 8; ++j) { v2u w; w.x = pk2(v[j].x, v[j].y); w.y = pk2(v[j].z, v[j].w); o8[(4 * 16384 / 4) * j] = w; }
        if (F.lane == 0) ss[m] = pg8::ss_fix(s);
    }
    { const int gt = gw * 64 + F.lane, NT = NGW * 64; for (int i = gt; i < 4 * S; i += NT) ss[S + i] = 0ull; }
    { float* cosh = (float*)(F.ws + WS_COSH); float* sinh = (float*)(F.ws + WS_SINH); float* cosi = (float*)(F.ws + WS_COSI); float* sini = (float*)(F.ws + WS_SINI);
      const int gt = gw * 64 + F.lane, NT = NGW * 64;
      float ivh = P.invh[0], ivi = P.invi[0];
#pragma unroll
      for (int kk = 1; kk < 16; ++kk) ivh = ((gt & 15) == kk) ? P.invh[kk] : ivh;
#pragma unroll
      for (int kk = 1; kk < 8; ++kk) ivi = ((gt & 7) == kk) ? P.invi[kk] : ivi;
      for (int i = gt; i < S * 16; i += NT) { const int pos = i >> 4; float sn, cs; sincos_acc((float)pos * ivh, sn, cs); cosh[i] = cs; sinh[i] = sn; }
      for (int i = gt; i < S * 8; i += NT) { const int pos = i >> 3; float sn, cs; sincos_acc((float)pos * ivi, sn, cs); cosi[i] = cs; sini[i] = sn; }
    }
}
__device__ __forceinline__ void p7_convert_mlp2(Frame& F, const Params& P) {
    LAS float* scr = (LAS float*)(F.lds + RING_OFF + F.wave * 16384);
    const int gw = F.vcu * NWAVES + F.wave, NGW = F.G * NWAVES;
    bf16* WupT = (bf16*)(F.ws + WS_WUP); bf16* WdnT = (bf16*)(F.ws + WS_WDN);
    constexpr int I5 = (D / 64) * (FF / 32), I6 = (FF / 64) * (D / 32);
    for (int it = gw; it < I5 + I6; it += NGW) {
        int r = it;
        if (r < I5) { tr_item(P.in[10] + (size_t)D * FF, D, FF, FF, P.in[9] + D, WupT, 0, scr, r, F.lane); continue; } r -= I5;
        tr_item(P.in[11] + (size_t)FF * D, FF, D, D, nullptr, WdnT, 0, scr, r, F.lane);
    }
}

__device__ __forceinline__ void p1_kiwi(Frame& F, const float* cosi, const float* sini) {
    const bf16* hb = (const bf16*)(F.ws + WS_HB); const bf16* Wt = (const bf16*)(F.ws + WS_WIN) + (size_t)16 * 256 * D;
    const pg8::ssq_t* ss = (const pg8::ssq_t*)(F.ws + WS_SS); bf16* KI = (bf16*)(F.ws + WS_KI); float* WI = (float*)(F.ws + WS_WI);
    LAS f32x4* red = (LAS f32x4*)(F.lds + RING_OFF);
    const int lane = F.lane, fr = lane & 15, fq = lane >> 4, w = F.wave;
    for (int blk = (int)blockIdx.x; blk < S / 64; blk += F.G) {
        const int row0 = blk * 64;
        const bf16* ap = hb + (size_t)(row0 >> 8) * (256 * D) + (size_t)(((row0 & 255) + fr) * 64 + 8 * fq);
        const bf16* wp = Wt + fr * 64 + 8 * fq;
        f32x4 acc[4][5];
#pragma unroll
        for (int rb = 0; rb < 4; ++rb)
#pragma unroll
            for (int cb = 0; cb < 5; ++cb) acc[rb][cb] = (f32x4){0.f, 0.f, 0.f, 0.f};
        bf16x8 a0[4], b0[5], a1[4], b1[5];
#define KIWI_LOAD(a, b, st) do { const int k = w * 256 + (st) * 32, ko = (k >> 6) * 16384 + (k & 63); _Pragma("unroll") for (int rb = 0; rb < 4; ++rb) a[rb] = *(const bf16x8*)(ap + rb * 1024 + ko); \
            _Pragma("unroll") for (int cb = 0; cb < 5; ++cb) b[cb] = *(const bf16x8*)(wp + cb * 1024 + ko); __builtin_amdgcn_sched_barrier(0); } while (0)
#define KIWI_MMA(a, b) do { _Pragma("unroll") for (int rb = 0; rb < 4; ++rb) _Pragma("unroll") for (int cb = 0; cb < 5; ++cb) acc[rb][cb] = __builtin_amdgcn_mfma_f32_16x16x32_bf16(b[cb], a[rb], acc[rb][cb], 0, 0, 0); \
            __builtin_amdgcn_sched_barrier(0); } while (0)
        KIWI_LOAD(a0, b0, 0);
#pragma unroll 1
        for (int it = 0; it < 4; ++it) {
            KIWI_LOAD(a1, b1, 2 * it + 1); KIWI_MMA(a0, b0);
            if (it < 3) KIWI_LOAD(a0, b0, 2 * it + 2);
            KIWI_MMA(a1, b1);
        }
#undef KIWI_LOAD
#undef KIWI_MMA
#pragma unroll
        for (int r = 0; r < 2; ++r) {
#pragma unroll
            for (int jb = 0; jb < 2; ++jb)
#pragma unroll
                for (int cb = 0; cb < 5; ++cb) red[(w * 10 + jb * 5 + cb) * 64 + lane] = acc[2 * r + jb][cb];
            __syncthreads();
            for (int item = w; item < 10; item += 8) {
                f32x4 v = red[item * 64 + lane];
#pragma unroll
                for (int ww = 1; ww < 8; ++ww) v += red[(ww * 10 + item) * 64 + lane];
                const int jb = item / 5, cb = item - 5 * jb, row = row0 + 16 * (2 * r + jb) + fr;
                const float rs = pg8::rstd_of(ss[row]);
                if (cb < 4) {
                    v = v * rs;
                    if (cb == 0) { const f32x4 c4 = *(const f32x4*)(cosi + (size_t)row * 8 + 4 * (fq & 1)), s4 = *(const f32x4*)(sini + (size_t)row * 8 + 4 * (fq & 1));
                                   f32x4 p; p[0] = __shfl_xor(v[0], 32); p[1] = __shfl_xor(v[1], 32); p[2] = __shfl_xor(v[2], 32); p[3] = __shfl_xor(v[3], 32);
                                   v = (fq < 2) ? (v * c4 - p * s4) : (v * c4 + p * s4); }
                    bf16* dst = KI + ((size_t)(((row >> 5) * 4 + cb) * 32 + (row & 31)) * 2 + (fq >> 1)) * 8 + 4 * (fq & 1);
                    *(pg8::u32x2*)dst = pg8::pack4(v);
                } else {
                    *(f32x4*)(WI + (size_t)row * 16 + 4 * fq) = v * (rs * 0.03125f);
                }
            }
            __syncthreads();
        }
    }
}

constexpr int CAP = 512;
__device__ __forceinline__ unsigned f2ord(float f) { const unsigned u = __float_as_uint(f); return (u & 0x80000000u) ? ~u : (u | 0x80000000u); }
__device__ __forceinline__ float ord2f(unsigned k) { const unsigned u = (k & 0x80000000u) ? (k & 0x7fffffffu) : ~k; return __uint_as_float(u); }
template <int CTRL> __device__ __forceinline__ unsigned dpp_movu(unsigned v) { return (unsigned)__builtin_amdgcn_update_dpp(0u, v, CTRL, 0xf, 0xf, false); }
__device__ __forceinline__ unsigned umax2(unsigned a, unsigned b) { return a > b ? a : b; }
__device__ __forceinline__ unsigned wave_max_u32(unsigned v) {
    v = umax2(v, dpp_movu<0x128>(v)); v = umax2(v, dpp_movu<0x124>(v)); v = umax2(v, dpp_movu<0x122>(v)); v = umax2(v, dpp_movu<0x121>(v));
    { const auto r = __builtin_amdgcn_permlane16_swap(v, v, false, false); v = umax2(r[0], r[1]); }
    { const auto r = __builtin_amdgcn_permlane32_swap(v, v, false, false); v = umax2(r[0], r[1]); }
    return v;
}
template <bool EXACT> __device__ __forceinline__ void topk_select(LAS float* s_, LAS unsigned* i_, int& cnt, float& tau, int lane) {
    const int n = cnt;
    unsigned k[8], ix[8];
#pragma unroll
    for (int j = 0; j < 8; ++j) { const int e = lane + 64 * j; const bool v = e < n; k[j] = v ? f2ord(s_[e]) : 0u; ix[j] = i_[e]; }
    unsigned mxk = k[0], mnk = ~k[0];
#pragma unroll
    for (int j = 1; j < 8; ++j) { mxk = umax2(mxk, k[j]); mnk = umax2(mnk, (lane + 64 * j < n) ? ~k[j] : 0u); }
    mxk = (unsigned)__builtin_amdgcn_readfirstlane((int)wave_max_u32(mxk)); mnk = ~(unsigned)__builtin_amdgcn_readfirstlane((int)wave_max_u32(mnk));
    const unsigned diff = mxk ^ mnk;
    unsigned T = mnk; int need_eq = TOPK;
    if (diff != 0u) {
        const int top = 31 - __builtin_clz(diff);
        T = (top == 31) ? 0u : ((mxk >> (top + 1)) << (top + 1));
        bool coarse_done = false;
        for (int bit = top; bit >= 0; --bit) {
            const unsigned cand = T | (1u << bit);
            int c = 0;
#pragma unroll
            for (int j = 0; j < 8; ++j) c += __popcll(__ballot(k[j] >= cand));
            if (c >= TOPK) { T = cand; if (c == TOPK || (!EXACT && c <= TOPK + 64)) { coarse_done = true; break; } }
        }
        if (!EXACT && coarse_done) need_eq = 1 << 20;
    }
    int ngt = 0;
#pragma unroll
    for (int j = 0; j < 8; ++j) ngt += __popcll(__ballot(k[j] > T));
    if (need_eq == TOPK) need_eq = TOPK - ngt;
    int offg = 0, offe = 0;
    const unsigned long long lm = (1ull << lane) - 1ull;
#pragma unroll
    for (int j = 0; j < 8; ++j) {
        const bool g = k[j] > T, e = k[j] == T;
        const unsigned long long bg = __ballot(g), be = __ballot(e);
        const int pg = offg + __popcll(bg & lm), pe = offe + __popcll(be & lm);
        if (g) { s_[pg] = ord2f(k[j]); i_[pg] = ix[j]; }
        else if (e && pe < need_eq) { s_[ngt + pe] = ord2f(k[j]); i_[ngt + pe] = ix[j]; }
        offg += __popcll(bg); offe += __popcll(be);
    }
    cnt = ngt + (offe < need_eq ? offe : need_eq); tau = ord2f(T);
    LDS_WAIT();
}
__device__ __forceinline__ float relu_f(float x) { const int b = __float_as_int(x); return __int_as_float(b > 0 ? b : 0); }
__device__ __forceinline__ float idx_score(const f32x16& acc, const float (&w)[16]) {
    float sc = 0.f;
#pragma unroll
    for (int i = 0; i < 16; ++i) sc = __builtin_fmaf(w[i], relu_f(acc[i]), sc);
    return sc;
}
__device__ __forceinline__ void idx_tile_tail(float sc, int (&cnt)[2], float (&tau)[2], LAS float* bs, LAS unsigned* bi, int key, int tq0, int r, int hh, int lane) {
    const float mytau = hh ? tau[1] : tau[0];
    const bool pass = (key <= tq0 + hh) && (sc > mytau);
    const unsigned long long mk = __ballot(pass);
    if (mk) {
        const unsigned m0 = (unsigned)mk, m1 = (unsigned)(mk >> 32);
        const unsigned mym = hh ? m1 : m0;
        const int pos = (hh ? cnt[1] : cnt[0]) + __popc(mym & ((1u << r) - 1u));
        if (pass) { bs[hh * CAP + pos] = sc; bi[hh * CAP + pos] = (unsigned)key; }
        cnt[0] += __popc(m0); cnt[1] += __popc(m1);
    }
}
__device__ __forceinline__ bool idx_tile_tail2(float s0, float s1, int (&cnt)[2][2], float t0, float t1, bool lastt, LAS float* bs, LAS unsigned* bi, int key, int q0, int r, int hh, int lane) {
    bool p0 = s0 > t0, p1 = s1 > t1;
    if (lastt) { p0 = p0 && (key <= q0 + hh); p1 = p1 && (key <= q0 + 2 + hh); }
    const unsigned long long k0 = __ballot(p0), k1 = __ballot(p1);
    if (k0 | k1) {
        const unsigned a0 = (unsigned)k0, a1 = (unsigned)(k0 >> 32), b0 = (unsigned)k1, b1 = (unsigned)(k1 >> 32);
        const int na0 = __popc(a0), na1 = __popc(a1), nb0 = __popc(b0), nb1 = __popc(b1);
        const int pa = (int)__builtin_amdgcn_mbcnt_hi(a1, __builtin_amdgcn_mbcnt_lo(a0, 0u)) - (hh ? na0 : 0) + (hh ? cnt[0][1] : cnt[0][0]);
        const int pb = (int)__builtin_amdgcn_mbcnt_hi(b1, __builtin_amdgcn_mbcnt_lo(b0, 0u)) - (hh ? nb0 : 0) + (hh ? cnt[1][1] : cnt[1][0]);
        if (p0) { bs[hh * CAP + pa] = s0; bi[hh * CAP + pa] = (unsigned)key; }
        if (p1) { bs[(2 + hh) * CAP + pb] = s1; bi[(2 + hh) * CAP + pb] = (unsigned)key; }
        cnt[0][0] += na0; cnt[0][1] += na1; cnt[1][0] += nb0; cnt[1][1] += nb1;
        return true;
    }
    return false;
}
template <bool EXACT> __device__ __forceinline__ void idx_reselect(int (&cnt)[2][2], float (&tau)[2][2], LAS float* bs, LAS unsigned* bi, int limit, int lane) {
#pragma unroll 1
    for (int qs = 0; qs < 4; ++qs) {
        int c = qs == 0 ? cnt[0][0] : (qs == 1 ? cnt[0][1] : (qs == 2 ? cnt[1][0] : cnt[1][1]));
        if (c > limit) {
            float t = 0.f;
            topk_select<EXACT>(bs + qs * CAP, bi + qs * CAP, c, t, lane);
            cnt[0][0] = qs == 0 ? c : cnt[0][0]; cnt[0][1] = qs == 1 ? c : cnt[0][1]; cnt[1][0] = qs == 2 ? c : cnt[1][0]; cnt[1][1] = qs == 3 ? c : cnt[1][1];
            tau[0][0] = qs == 0 ? t : tau[0][0]; tau[0][1] = qs == 1 ? t : tau[0][1]; tau[1][0] = qs == 2 ? t : tau[1][0]; tau[1][1] = qs == 3 ? t : tau[1][1];
        }
    }
}
template <int PMODE> __device__ __forceinline__ void p2_indexer(Frame& F) {
    const bf16* QI = (const bf16*)(F.ws + WS_QI); const bf16* KI = (const bf16*)(F.ws + WS_KI); const float* WI = (const float*)(F.ws + WS_WI);
    unsigned short* sel = (unsigned short*)(F.ws + WS_SEL);
    const int lane = F.lane, r = lane & 31, hh = lane >> 5;
    LAS float* bs = (LAS float*)(F.lds + RING_OFF + F.wave * 16384);
    LAS unsigned* bi = (LAS unsigned*)(F.lds + RING_OFF + F.wave * 16384 + 8192);
    const int gw = F.vcu * NWAVES + F.wave, NGW = F.G * NWAVES;
    constexpr int NT = S / 4;
    for (int it = 0;; ++it) {
        const int kk = it * NGW + ((it & 1) ? (NGW - 1 - gw) : gw);
        if (it * NGW >= NT) break;
        if (kk >= NT) continue;
        const int task = NT - 1 - kk, q0 = task * 4;
        bf16x8 Af[2][4]; float w[2][16];
#pragma unroll
        for (int pi = 0; pi < 2; ++pi) {
            const int qa = q0 + 2 * pi + ((r >> 2) & 1), head = (r & 3) + 4 * (r >> 3);
#pragma unroll
            for (int ks = 0; ks < 4; ++ks) Af[pi][ks] = *(const bf16x8*)(QI + pg8::tm_off(qa, head * 64 + 16 * ks + 8 * hh, 1024));
#pragma unroll
            for (int i = 0; i < 4; ++i) { const f32x4 t = *(const f32x4*)(WI + (size_t)(q0 + 2 * pi + hh) * 16 + 4 * i); w[pi][4 * i] = t[0]; w[pi][4 * i + 1] = t[1]; w[pi][4 * i + 2] = t[2]; w[pi][4 * i + 3] = t[3]; }
        }
        int cnt[2][2] = {{0, 0}, {0, 0}}; float tau[2][2];
        tau[0][0] = tau[0][1] = tau[1][0] = tau[1][1] = -__builtin_inff();
        float tl0 = -__builtin_inff(), tl1 = -__builtin_inff();
        const int ntile = (q0 + 3) / 32 + 1;
        const bf16* kb = KI + (size_t)(r * 2 + hh) * 8;
        bf16x8 Bf[4];
#define P2_LOADB(t_) do { const int tc_ = (t_) < ntile ? (t_) : ntile - 1; const bf16* kn_ = kb + (size_t)tc_ * 2048; \
            _Pragma("unroll") for (int ks = 0; ks < 4; ++ks) Bf[ks] = *(const bf16x8*)(kn_ + ks * 512); } while (0)
#define P2_MFMA(x0_, x1_) do { _Pragma("unroll") for (int i = 0; i < 16; ++i) { x0_[i] = 0.f; x1_[i] = 0.f; } \
            _Pragma("unroll") for (int ks = 0; ks < 4; ++ks) x0_ = __builtin_amdgcn_mfma_f32_32x32x16_bf16(Af[0][ks], Bf[ks], x0_, 0, 0, 0); \
            _Pragma("unroll") for (int ks = 0; ks < 4; ++ks) x1_ = __builtin_amdgcn_mfma_f32_32x32x16_bf16(Af[1][ks], Bf[ks], x1_, 0, 0, 0); } while (0)
#define P2_TAIL(x0_, x1_, t_) do { const int key = (t_) * 32 + r; \
            if (PMODE == 0) { const float s0 = idx_score(x0_, w[0]), s1 = idx_score(x1_, w[1]); \
                if (idx_tile_tail2(s0, s1, cnt, tl0, tl1, (t_) == ntile - 1, bs, bi, key, q0, r, hh, lane)) { \
                    if ((cnt[0][0] > CAP - 32) | (cnt[0][1] > CAP - 32) | (cnt[1][0] > CAP - 32) | (cnt[1][1] > CAP - 32)) { idx_reselect<false>(cnt, tau, bs, bi, CAP - 32, lane); \
                        tl0 = hh ? tau[0][1] : tau[0][0]; tl1 = hh ? tau[1][1] : tau[1][0]; } } } \
            else if (PMODE == 1) { const float s0 = idx_score(x0_, w[0]), s1 = idx_score(x1_, w[1]); asm volatile("" :: "v"(s0), "v"(s1), "v"(key)); } \
            else { asm volatile("" :: "v"(x0_[0]), "v"(x1_[0]), "v"(x0_[15]), "v"(x1_[15]), "v"(key)); } } while (0)
        f32x16 a0, a1, b0, b1;
        P2_LOADB(0); P2_MFMA(a0, a1); P2_LOADB(1);
        for (int tile = 0; tile < ntile; tile += 2) {
            P2_MFMA(b0, b1); P2_LOADB(tile + 2);
            P2_TAIL(a0, a1, tile);
            if (tile + 1 >= ntile) break;
            P2_MFMA(a0, a1); P2_LOADB(tile + 3);
            P2_TAIL(b0, b1, tile + 1);
        }
#undef P2_LOADB
#undef P2_MFMA
#undef P2_TAIL
        if (PMODE == 0) {
            idx_reselect<true>(cnt, tau, bs, bi, TOPK, lane);
            LDS_WAIT();
#pragma unroll 1
            for (int qs = 0; qs < 4; ++qs) {
                const int n = qs == 0 ? cnt[0][0] : (qs == 1 ? cnt[0][1] : (qs == 2 ? cnt[1][0] : cnt[1][1]));
#pragma unroll
                for (int j = 0; j < 4; ++j) { const int e = lane + 64 * j; if (e < n) sel[(size_t)(q0 + qs) * TOPK + e] = (unsigned short)bi[qs * CAP + e]; }
            }
        }
        LDS_WAIT();
    }
}

template <int MODE> __device__ __forceinline__ void attn_gather_phase(Frame& F, const bf16* Qp, const bf16* Kp, const bf16* Vp, const unsigned short* sel, bf16* Op) {
    constexpr int NE = MODE == 0 ? 256 : 432;
    constexpr int NEP = MODE == 0 ? 256 : 448;
    constexpr int QLD = MODE == 0 ? 2048 : 6144;
    constexpr int NGI = MODE == 0 ? 1 : 3, GPG = MODE == 0 ? 16 : 9, UNRA = MODE == 0 ? 4 : 3;
    LAS float* Pl = (LAS float*)(F.lds + RING_OFF + F.wave * 12288);
    LAS unsigned* Sl = (LAS unsigned*)(F.lds + RING_OFF + F.wave * 12288 + 8192);
    const int lane = F.lane, c16 = lane & 15, kg = lane >> 4;
    const int gw = F.vcu * NWAVES + F.wave, NGW = F.G * NWAVES;
    const float scale = 0.08838834764831845f * 1.4426950408889634f;
    for (int task = gw; task < 4 * S; task += NGW) {
        const int g = task / S, t = task - g * S;
#pragma unroll
        for (int i = 0; i < NEP / 64; ++i) {
            const int e = lane + 64 * i; unsigned pv;
            if (MODE == 0) { const int n = t + 1 < TOPK ? t + 1 : TOPK; pv = e < n ? (unsigned)sel[(size_t)t * TOPK + e] : 0x80000000u; }
            else { const int gi = e / 144, j = e - 144 * gi; const int pos = t - (j << (2 * gi)); pv = (e < NE && j <= 128 && pos >= 0) ? (unsigned)pos : 0x80000000u; }
            Sl[e] = pv;
        }
        bf16x8 Aq[NGI][4];
#pragma unroll
        for (int gi = 0; gi < NGI; ++gi)
#pragma unroll
            for (int ks = 0; ks < 4; ++ks) {
                bf16x8 z = (bf16x8){0, 0, 0, 0, 0, 0, 0, 0};
                if (c16 < 4) z = *(const bf16x8*)(Qp + (size_t)t * QLD + (size_t)(gi * 16 + 4 * g + c16) * 128 + 32 * kg + 8 * ks);
                Aq[gi][ks] = z;
            }
        LDS_WAIT();
        float mx[4] = {-__builtin_inff(), -__builtin_inff(), -__builtin_inff(), -__builtin_inff()};
#pragma unroll
        for (int gi = 0; gi < NGI; ++gi) {
#pragma unroll UNRA
            for (int gl = 0; gl < GPG; ++gl) {
                const int e = (gi * GPG + gl) * 16 + c16;
                const unsigned pv = Sl[e]; const bool valid = (pv >> 31) == 0u; const unsigned pos = pv & 0x7fffffffu;
                const bf16* kp = Kp + (size_t)pos * 512 + g * 128 + 32 * kg;
                bf16x8 Bk[4];
#pragma unroll
                for (int ks = 0; ks < 4; ++ks) Bk[ks] = *(const bf16x8*)(kp + 8 * ks);
                f32x4 a = (f32x4){0.f, 0.f, 0.f, 0.f};
#pragma unroll
                for (int ks = 0; ks < 4; ++ks) a = __builtin_amdgcn_mfma_f32_16x16x32_bf16(Aq[gi][ks], Bk[ks], a, 0, 0, 0);
                f32x4 sv;
#pragma unroll
                for (int j = 0; j < 4; ++j) { sv[j] = valid ? a[j] * scale : -__builtin_inff(); mx[j] = __builtin_fmaxf(mx[j], sv[j]); }
                if (kg == 0) *(LAS f32x4*)(Pl + e * 4) = sv;
            }
        }
        if (MODE == 1) { if (lane < 16) *(LAS f32x4*)(Pl + (NE + lane) * 4) = (f32x4){-__builtin_inff(), -__builtin_inff(), -__builtin_inff(), -__builtin_inff()}; }
#pragma unroll
        for (int j = 0; j < 4; ++j) {
            float v = mx[j];
            mx[j] = bcast_row0(row_max16(v));
        }
        LDS_WAIT();
        float sum[4] = {0.f, 0.f, 0.f, 0.f};
#pragma unroll
        for (int i = 0; i < NEP / 64; ++i) {
            const int e = lane + 64 * i;
            f32x4 sv = *(LAS f32x4*)(Pl + e * 4);
#pragma unroll
            for (int j = 0; j < 4; ++j) { sv[j] = __builtin_amdgcn_exp2f(sv[j] - mx[j]); sum[j] += sv[j]; }
            *(LAS f32x4*)(Pl + e * 4) = sv;
        }
#pragma unroll
        for (int j = 0; j < 4; ++j) sum[j] = wave_sum(sum[j]);
        LDS_WAIT();
        float o[4][8];
#pragma unroll
        for (int j = 0; j < 4; ++j)
#pragma unroll
            for (int d = 0; d < 8; ++d) o[j][d] = 0.f;
        for (int e0 = 0; e0 < NEP; e0 += 32) {
            bf16x8 vv[8]; f32x4 pp[8];
#pragma unroll
            for (int u = 0; u < 8; ++u) {
                const int e = e0 + 4 * u + kg;
                const unsigned pos = Sl[e] & 0x7fffffffu;
                vv[u] = *(const bf16x8*)(Vp + (size_t)pos * 512 + g * 128 + 8 * c16);
                pp[u] = *(LAS f32x4*)(Pl + e * 4);
            }
#pragma unroll
            for (int u = 0; u < 8; ++u)
#pragma unroll
                for (int d = 0; d < 8; ++d) { const float vf = bf2f(vv[u][d]);
#pragma unroll
                    for (int j = 0; j < 4; ++j) o[j][d] = __builtin_fmaf(pp[u][j], vf, o[j][d]); }
        }
#pragma unroll
        for (int j = 0; j < 4; ++j) {
            const float inv = 1.0f / sum[j];
#pragma unroll
            for (int d = 0; d < 8; ++d) { float v = o[j][d]; v += __shfl_xor(v, 16); v += __shfl_xor(v, 32); o[j][d] = v * inv; }
        }
        if (kg == 0) {
#pragma unroll
            for (int j = 0; j < 4; ++j) {
                v4u w; w.x = pk2(o[j][0], o[j][1]); w.y = pk2(o[j][2], o[j][3]); w.z = pk2(o[j][4], o[j][5]); w.w = pk2(o[j][6], o[j][7]);
                *(GAS v4u*)(Op + (size_t)t * 2048 + (size_t)(4 * g + j) * 128 + 8 * c16) = w;
            }
        }
        LDS_WAIT();
    }
}


typedef float f32x2 __attribute__((ext_vector_type(2)));
__device__ __forceinline__ long pk_long(unsigned lo, unsigned hi) { return (long)(((unsigned long long)hi << 32) | (unsigned long long)lo); }
template <int NV> __device__ __forceinline__ void pv_accum(f32x2 (&o2)[4][8], const v4u (&vv)[NV], const LAS float* Pl, int ebase) {
#pragma unroll
    for (int u = 0; u < NV; ++u) {
        const f32x4 pp = *(const LAS f32x4*)(Pl + (ebase + 8 * u) * 4);
#pragma unroll
        for (int d2 = 0; d2 < 8; ++d2) {
            const int wsrc = (int)((d2 >> 1) == 0 ? vv[u].x : ((d2 >> 1) == 1 ? vv[u].y : ((d2 >> 1) == 2 ? vv[u].z : vv[u].w)));
            const f32x2 vf = (d2 & 1) ? __builtin_amdgcn_cvt_pk_f32_fp8(wsrc, true) : __builtin_amdgcn_cvt_pk_f32_fp8(wsrc, false);
#pragma unroll
            for (int j = 0; j < 4; ++j) o2[j][d2] = __builtin_elementwise_fma(vf, (f32x2){pp[j], pp[j]}, o2[j][d2]);
        }
    }
}
typedef int v2i __attribute__((ext_vector_type(2)));
__device__ __forceinline__ void p3_sparse_fp8(Frame& F) {
    const unsigned char* Qp = F.ws + WS_QA; const unsigned char* K8 = F.ws + WS_KA; const unsigned char* V8 = F.ws + WS_VA;
    const unsigned short* sel = (const unsigned short*)(F.ws + WS_SEL); bf16* Op = (bf16*)(F.ws + WS_OA);
    LAS float* Pt = (LAS float*)(F.lds + RING_OFF + F.wave * 16384);
    LAS unsigned* Sl = (LAS unsigned*)(F.lds + RING_OFF + F.wave * 16384 + 4096);
    LAS unsigned char* Kst = F.lds + RING_OFF + F.wave * 16384 + 8192;
    const int lane = F.lane, c16 = lane & 15, kg = lane >> 4, e8 = lane >> 3, ch = lane & 7;
    const int gw = F.vcu * NWAVES + F.wave, NGW = F.G * NWAVES;
    const float scale = 0.08838834764831845f * 1.4426950408889634f;
    unsigned short selv[4]; v4u qv[2];
    { const int task = gw; if (task < 4 * S) { const int g = task / S, t = task - g * S;
#pragma unroll
        for (int i = 0; i < 4; ++i) selv[i] = sel[(size_t)t * TOPK + lane + 64 * i];
        { const unsigned char* q8 = Qp + pg8::tm_off(t, (4 * g + (c16 & 3)) * 128 + 32 * kg, 2048); qv[0] = *(const GAS v4u*)q8; qv[1] = *(const GAS v4u*)(q8 + 16); } } }
    for (int task = gw; task < 4 * S; task += NGW) {
        const int g = task / S, t = task - g * S;
        const int n = t + 1 < TOPK ? t + 1 : TOPK;
#pragma unroll
        for (int i = 0; i < 4; ++i) { const int e = lane + 64 * i; Sl[e] = e < n ? (unsigned)selv[i] : 0x80000000u; }
        long Aq[4];
        Aq[0] = (c16 < 4) ? pk_long(qv[0].x, qv[0].y) : 0l; Aq[1] = (c16 < 4) ? pk_long(qv[0].z, qv[0].w) : 0l;
        Aq[2] = (c16 < 4) ? pk_long(qv[1].x, qv[1].y) : 0l; Aq[3] = (c16 < 4) ? pk_long(qv[1].z, qv[1].w) : 0l;
        LDS_WAIT();
        const unsigned char* kb2 = K8 + (size_t)g * S * 128 + 16 * ch;
        const unsigned char* vb2 = V8 + (size_t)g * S * 128 + 16 * ch;
        float mx[4] = {-__builtin_inff(), -__builtin_inff(), -__builtin_inff(), -__builtin_inff()};
#pragma unroll
        for (int half = 0; half < 2; ++half) {
            v4u kq[16];
#pragma unroll
            for (int u = 0; u < 16; ++u) { const unsigned pos = Sl[128 * half + 8 * u + e8] & 0x7fffffffu; kq[u] = *(const GAS v4u*)(kb2 + (size_t)pos * 128); }
            __builtin_amdgcn_sched_barrier(0);
#pragma unroll
            for (int r2 = 0; r2 < 2; ++r2) {
#pragma unroll
                for (int uu = 0; uu < 8; ++uu) { const int ksl = 8 * uu + e8; *(LAS v4u*)(Kst + ksl * 128 + 16 * (ch ^ ((ksl >> 1) & 7))) = kq[8 * r2 + uu]; }
#pragma unroll
                for (int g4 = 0; g4 < 4; ++g4) {
                    const int ksl = 16 * g4 + c16, e = 128 * half + 64 * r2 + ksl, f = (ksl >> 1) & 7;
                    const v4u k0 = *(const LAS v4u*)(Kst + ksl * 128 + 16 * ((2 * kg) ^ f)), k1 = *(const LAS v4u*)(Kst + ksl * 128 + 16 * ((2 * kg + 1) ^ f));
                    const bool valid = (Sl[e] >> 31) == 0u;
                    f32x4 a = (f32x4){0.f, 0.f, 0.f, 0.f};
                    a = __builtin_amdgcn_mfma_f32_16x16x32_fp8_fp8(Aq[0], pk_long(k0.x, k0.y), a, 0, 0, 0);
                    a = __builtin_amdgcn_mfma_f32_16x16x32_fp8_fp8(Aq[1], pk_long(k0.z, k0.w), a, 0, 0, 0);
                    a = __builtin_amdgcn_mfma_f32_16x16x32_fp8_fp8(Aq[2], pk_long(k1.x, k1.y), a, 0, 0, 0);
                    a = __builtin_amdgcn_mfma_f32_16x16x32_fp8_fp8(Aq[3], pk_long(k1.z, k1.w), a, 0, 0, 0);
#pragma unroll
                    for (int j = 0; j < 4; ++j) { const float sv = valid ? a[j] * scale : -__builtin_inff(); mx[j] = __builtin_fmaxf(mx[j], sv); if (kg == 0) Pt[j * 256 + e] = sv; }
                }
            }
            __builtin_amdgcn_sched_barrier(0);
        }
        v4u vA[8], vB[8];
#pragma unroll
        for (int u = 0; u < 8; ++u) { const unsigned pos = Sl[8 * u + e8] & 0x7fffffffu; vA[u] = *(const GAS v4u*)(vb2 + (size_t)pos * 128); }
#pragma unroll
        for (int j = 0; j < 4; ++j) {
            float v = mx[j];
            mx[j] = bcast_row0(row_max16(v));
        }
        LDS_WAIT();
        float sum[4] = {0.f, 0.f, 0.f, 0.f};
#pragma unroll
        for (int j = 0; j < 4; ++j)
#pragma unroll
            for (int i = 0; i < 4; ++i) {
                const int e = lane + 64 * i;
                const float pr = __builtin_amdgcn_exp2f(Pt[j * 256 + e] - mx[j] + 8.0f);
                sum[j] += pr; Pt[j * 256 + e] = pr;
            }
#pragma unroll
        for (int j = 0; j < 4; ++j) sum[j] = wave_sum(sum[j]);
        { const int tn = task + NGW; if (tn < 4 * S) { const int g2 = tn / S, t2 = tn - g2 * S;
#pragma unroll
            for (int i = 0; i < 4; ++i) selv[i] = sel[(size_t)t2 * TOPK + lane + 64 * i];
            { const unsigned char* q8 = Qp + pg8::tm_off(t2, (4 * g2 + (c16 & 3)) * 128 + 32 * kg, 2048); qv[0] = *(const GAS v4u*)q8; qv[1] = *(const GAS v4u*)(q8 + 16); } } }
        LDS_WAIT();
        f32x4 oacc[8];
#pragma unroll
        for (int dt = 0; dt < 8; ++dt) oacc[dt] = (f32x4){0.f, 0.f, 0.f, 0.f};
#pragma unroll
        for (int c4 = 0; c4 < 4; ++c4) {
#pragma unroll
            for (int uu = 0; uu < 8; ++uu) { const int ksl = 8 * uu + e8; *(LAS v4u*)(Kst + ksl * 128 + 16 * (ch ^ ((ksl >> 1) & 7))) = (c4 & 1) ? vB[uu] : vA[uu]; }
            if (c4 < 3) {
#pragma unroll
                for (int u = 0; u < 8; ++u) { const unsigned pos = Sl[64 * (c4 + 1) + 8 * u + e8] & 0x7fffffffu; const v4u vv = *(const GAS v4u*)(vb2 + (size_t)pos * 128); if (c4 & 1) vA[u] = vv; else vB[u] = vv; }
            }
#pragma unroll
            for (int ks2 = 0; ks2 < 2; ++ks2) {
                const LAS float* pp = Pt + (c16 & 3) * 256 + 64 * c4 + 32 * ks2 + 8 * kg;
                const f32x4 p0 = *(const LAS f32x4*)pp, p1 = *(const LAS f32x4*)(pp + 4);
                int w0 = __builtin_amdgcn_cvt_pk_fp8_f32(p0[0], p0[1], 0, false); w0 = __builtin_amdgcn_cvt_pk_fp8_f32(p0[2], p0[3], w0, true);
                int w1 = __builtin_amdgcn_cvt_pk_fp8_f32(p1[0], p1[1], 0, false); w1 = __builtin_amdgcn_cvt_pk_fp8_f32(p1[2], p1[3], w1, true);
                const long Ap = (c16 < 4) ? pk_long((unsigned)w0, (unsigned)w1) : 0l;
                const int ksl = 32 * ks2 + 8 * kg + (c16 >> 1), f = (ksl >> 1) & 7;
                const LAS unsigned char* vrow = Kst + ksl * 128 + 8 * (c16 & 1);
#pragma unroll
                for (int dt = 0; dt < 8; ++dt) {
                    const v2i bv = __builtin_amdgcn_ds_read_tr8_b64_v2i32((LAS v2i*)(vrow + 16 * (dt ^ f)));
                    oacc[dt] = __builtin_amdgcn_mfma_f32_16x16x32_fp8_fp8(Ap, pk_long((unsigned)bv.x, (unsigned)bv.y), oacc[dt], 0, 0, 0);
                }
            }
        }
        LDS_WAIT();
        if (kg == 0) {
#pragma unroll
            for (int j = 0; j < 4; ++j) { const float inv = 1.0f / sum[j];
#pragma unroll
                for (int dt = 0; dt < 8; ++dt) Pt[j * 128 + 16 * dt + c16] = oacc[dt][j] * inv; }
        }
        LDS_WAIT();
        { const LAS float* op = Pt + (lane >> 4) * 128 + 8 * (lane & 15);
          const f32x4 a = *(const LAS f32x4*)op, b = *(const LAS f32x4*)(op + 4);
          v4u w; w.x = pk2(a[0], a[1]); w.y = pk2(a[2], a[3]); w.z = pk2(b[0], b[1]); w.w = pk2(b[2], b[3]);
          *(GAS v4u*)(Op + ktm_off(t, (4 * g + (lane >> 4)) * 128 + 8 * (lane & 15))) = w; }
        LDS_WAIT();
    }
}

constexpr size_t KC8_BYTES = (size_t)4 * 512 * 4096;
__device__ __forceinline__ unsigned pk4_fp8(float a, float b, float c, float d) { int w = __builtin_amdgcn_cvt_pk_fp8_f32(a, b, 0, false); return (unsigned)__builtin_amdgcn_cvt_pk_fp8_f32(c, d, w, true); }
__device__ __forceinline__ float bfu(unsigned short v) { return __uint_as_float(((unsigned)v) << 16); }
__device__ __forceinline__ void p8_kv_copies(Frame& F) {
    const bf16* Ks = (const bf16*)(F.ws + WS_KS); const bf16* Vs = (const bf16*)(F.ws + WS_VS);
    LAS unsigned short* scr = (LAS unsigned short*)(F.lds + RING_OFF + F.wave * 16384);
    const int gw = F.vcu * NWAVES + F.wave, NGW = F.G * NWAVES, lane = F.lane;
    constexpr int NITEM = 3 * 4 * (S / 32);
    for (int it = gw; it < NITEM; it += NGW) {
        const int tile = it & 511, kh = (it >> 9) & 3, g = it >> 11;
        const int sh = 2 * g, per = S >> sh;
        const int idx0 = tile * 32, rho = idx0 / per, kap0 = idx0 - rho * per;
        unsigned char* Kc = F.outb + (size_t)g * KC8_BYTES + (size_t)(kh * 512 + tile) * 4096;
        unsigned char* Vc = F.ws + (g == 0 ? WS_VT0 : (g == 1 ? WS_VT1 : WS_VT2)) + (size_t)(kh * 512 + tile) * 4096;
#pragma unroll
        for (int q = 0; q < 8; ++q) {
            const int ch = q * 64 + lane, key = ch >> 4, cc = ch & 15;
            const int pos = rho + ((kap0 + key) << sh);
            const v4u kv = *(const GAS v4u*)(Ks + pg8::tm_off(pos, kh * 128 + 8 * cc, 512));
            const v4u vv = *(const GAS v4u*)(Vs + pg8::tm_off(pos, kh * 128 + 8 * cc, 512));
            *(LAS v4u*)(scr + key * 128 + 8 * cc) = kv;
            *(LAS v4u*)(scr + 4096 + key * 128 + 8 * cc) = vv;
        }
        LDS_WAIT(); asm volatile("" ::: "memory");
#pragma unroll
        for (int q = 0; q < 4; ++q) {
            const int co = q * 64 + lane;
            { const int hh = co & 1, key = (co >> 1) & 31, ksp = co >> 6;
              const LAS unsigned short* s0 = scr + key * 128 + 32 * ksp + 8 * hh;
              v4u w; w.x = pk4_fp8(bfu(s0[0]), bfu(s0[1]), bfu(s0[2]), bfu(s0[3])); w.y = pk4_fp8(bfu(s0[4]), bfu(s0[5]), bfu(s0[6]), bfu(s0[7]));
              w.z = pk4_fp8(bfu(s0[16]), bfu(s0[17]), bfu(s0[18]), bfu(s0[19])); w.w = pk4_fp8(bfu(s0[20]), bfu(s0[21]), bfu(s0[22]), bfu(s0[23]));
              *(GAS v4u*)(Kc + 16 * co) = w; }
            { const int hh = co & 1, dimt = (co >> 1) & 31, dt = co >> 6, dim = 32 * dt + dimt;
              float e[16];
#pragma unroll
              for (int s2 = 0; s2 < 2; ++s2)
#pragma unroll
                  for (int j = 0; j < 8; ++j) e[8 * s2 + j] = bfu(scr[4096 + (16 * s2 + 8 * (j >> 2) + 4 * hh + (j & 3)) * 128 + dim]);
              v4u w; w.x = pk4_fp8(e[0], e[1], e[2], e[3]); w.y = pk4_fp8(e[4], e[5], e[6], e[7]); w.z = pk4_fp8(e[8], e[9], e[10], e[11]); w.w = pk4_fp8(e[12], e[13], e[14], e[15]);
              *(GAS v4u*)(Vc + 16 * co) = w; }
        }
        LDS_WAIT(); asm volatile("" ::: "memory");
    }
}

__device__ __forceinline__ void p9_dilated_dense(Frame& F) {
    const unsigned char* Q2 = F.ws + WS_Q2; bf16* O2 = (bf16*)(F.ws + WS_O2);
    const int lane = F.lane, ar = lane & 31, h = lane >> 5, qi = ar >> 2, rep = ar & 3;
    const int gw = F.vcu * NWAVES + F.wave, NGW = F.G * NWAVES;
    const float scale = 0.08838834764831845f * 1.4426950408889634f;
    for (int uid = gw; uid < 8192; uid += NGW) {
        const int c = uid & 15, b = (uid >> 4) & 127, kh = uid >> 11;
        const int t = c + 16 * (8 * b + qi);
        f32x16 O[4];
#pragma unroll
        for (int dt = 0; dt < 4; ++dt)
#pragma unroll
            for (int i = 0; i < 16; ++i) O[dt][i] = 0.f;
        float m = -1e30f, l = 0.f;
#pragma unroll 1
        for (int g = 0; g < 3; ++g) {
            const int sh = 2 * g, per = S >> sh;
            const int rho = (g == 0) ? 0 : ((g == 1) ? (c & 3) : c);
            const int tau = (t - rho) >> sh;
            const int wlo = tau > 128 ? tau - 128 : 0; const unsigned wrng = (unsigned)(tau - wlo);
            const int tau0 = (c + 128 * b - rho) >> sh, tau7 = tau0 + 7 * (16 >> sh);
            const int full_lo = tau7 > 128 ? tau7 - 128 : 0, full_hi = tau0;
            const int kap0 = (g == 0) ? (128 * b - 128) : ((g == 1) ? (32 * b - 128) : ((8 * b - 128) & ~31));
            const int ntile = (g == 0) ? 8 : 5;
            const int tmax = (per >> 5) - 1;
            const unsigned char* Kc = F.outb + (size_t)g * KC8_BYTES + ((size_t)kh * 512 + (size_t)rho * (per >> 5)) * 4096 + (ar * 2 + h) * 16;
            const unsigned char* Vc = F.ws + (g == 0 ? WS_VT0 : (g == 1 ? WS_VT1 : WS_VT2)) + ((size_t)kh * 512 + (size_t)rho * (per >> 5)) * 4096 + (ar * 2 + h) * 16;
            long Qf[8];
            { const unsigned char* qp = Q2 + pg8::tm_off(t, (g * 16 + 4 * kh + rep) * 128 + 8 * h, 6144);
#pragma unroll
              for (int ks = 0; ks < 8; ++ks) Qf[ks] = *(const GAS long*)(qp + 16 * ks); }
            const int tt0 = kap0 >= -31 ? 0 : ((-31 - kap0) + 31) / 32;
            v4u K0[4], V0[4], K1[4], V1[4], K2[4], V2[4]; long Pf[2]; f32x16 acc;
#define P9_GLD(dst_, ptr_, off_) asm volatile("global_load_dwordx4 %0, %1, off offset:" #off_ : "=v"(dst_) : "v"(ptr_) : "memory")
#define P9_LOAD(KF_, VF_, tt_) do { int ti_ = (kap0 + 32 * (tt_)) >> 5; ti_ = ti_ < 0 ? 0 : (ti_ > tmax ? tmax : ti_); const unsigned char* kp_ = Kc + (size_t)ti_ * 4096; const unsigned char* vp_ = Vc + (size_t)ti_ * 4096; \
                P9_GLD(KF_[0], kp_, 0); P9_GLD(KF_[1], kp_, 1024); P9_GLD(KF_[2], kp_, 2048); P9_GLD(KF_[3], kp_, 3072); P9_GLD(VF_[0], vp_, 0); P9_GLD(VF_[1], vp_, 1024); P9_GLD(VF_[2], vp_, 2048); P9_GLD(VF_[3], vp_, 3072); } while (0)
#define P9_WAIT(KF_, VF_) do { asm volatile("s_waitcnt vmcnt(16)" : "+v"(KF_[0]), "+v"(KF_[1]), "+v"(KF_[2]), "+v"(KF_[3]), "+v"(VF_[0]), "+v"(VF_[1]), "+v"(VF_[2]), "+v"(VF_[3]) :: "memory"); __builtin_amdgcn_sched_barrier(0); } while (0)
#define P9_BODY(KF_, VF_, tt_) do { \
                _Pragma("unroll") for (int i = 0; i < 16; ++i) acc[i] = 0.f; \
                _Pragma("unroll") for (int kp2 = 0; kp2 < 4; ++kp2) { acc = __builtin_amdgcn_mfma_f32_32x32x16_fp8_fp8(pk_long(KF_[kp2].x, KF_[kp2].y), Qf[2 * kp2], acc, 0, 0, 0); \
                    acc = __builtin_amdgcn_mfma_f32_32x32x16_fp8_fp8(pk_long(KF_[kp2].z, KF_[kp2].w), Qf[2 * kp2 + 1], acc, 0, 0, 0); } \
                const int kt = kap0 + 32 * (tt_); float mloc = -__builtin_inff(); \
                if (!(kt >= full_lo && kt + 31 <= full_hi)) {            \
                    const unsigned dbase = (unsigned)(kt + 4 * h - wlo); \
                    _Pragma("unroll") for (int i = 0; i < 16; ++i) acc[i] = (dbase + (unsigned)((i & 3) + 8 * (i >> 2)) <= wrng) ? acc[i] : -__builtin_inff(); } \
                _Pragma("unroll") for (int i = 0; i < 16; ++i) mloc = __builtin_fmaxf(mloc, acc[i]); \
                mloc = swap32_max(mloc) * scale;                         \
                const float mnew = __builtin_fmaxf(m, mloc); const float alpha = __builtin_amdgcn_exp2f(m - mnew); const float off = 8.0f - mnew; float ls = 0.f; \
                _Pragma("unroll") for (int i = 0; i < 16; ++i) { acc[i] = __builtin_amdgcn_exp2f(__builtin_fmaf(acc[i], scale, off)); ls += acc[i]; } \
                ls = swap32_sum(ls); l = l * alpha + ls; m = mnew; \
                _Pragma("unroll") for (int dt = 0; dt < 4; ++dt) _Pragma("unroll") for (int i = 0; i < 16; ++i) O[dt][i] *= alpha; \
                _Pragma("unroll") for (int s2 = 0; s2 < 2; ++s2) Pf[s2] = pk_long(pk4_fp8(acc[8 * s2 + 0], acc[8 * s2 + 1], acc[8 * s2 + 2], acc[8 * s2 + 3]), pk4_fp8(acc[8 * s2 + 4], acc[8 * s2 + 5], acc[8 * s2 + 6], acc[8 * s2 + 7])); \
                _Pragma("unroll") for (int dt = 0; dt < 4; ++dt) { O[dt] = __builtin_amdgcn_mfma_f32_32x32x16_fp8_fp8(pk_long(VF_[dt].x, VF_[dt].y), Pf[0], O[dt], 0, 0, 0); \
                    O[dt] = __builtin_amdgcn_mfma_f32_32x32x16_fp8_fp8(pk_long(VF_[dt].z, VF_[dt].w), Pf[1], O[dt], 0, 0, 0); } } while (0)
            asm volatile("" : "+v"(Qf[0]), "+v"(Qf[1]), "+v"(Qf[2]), "+v"(Qf[3]), "+v"(Qf[4]), "+v"(Qf[5]), "+v"(Qf[6]), "+v"(Qf[7]) :: "memory");
            P9_LOAD(K0, V0, tt0); P9_LOAD(K1, V1, tt0 + 1); P9_LOAD(K2, V2, tt0 + 2);
            for (int tt = tt0; tt < ntile; tt += 3) {
                P9_WAIT(K0, V0); P9_BODY(K0, V0, tt); P9_LOAD(K0, V0, tt + 3);
                if (tt + 1 >= ntile) break;
                P9_WAIT(K1, V1); P9_BODY(K1, V1, tt + 1); P9_LOAD(K1, V1, tt + 4);
                if (tt + 2 >= ntile) break;
                P9_WAIT(K2, V2); P9_BODY(K2, V2, tt + 2); P9_LOAD(K2, V2, tt + 5);
            }
            asm volatile("s_waitcnt vmcnt(0)" : "+v"(K0[0]), "+v"(K0[1]), "+v"(K0[2]), "+v"(K0[3]), "+v"(V0[0]), "+v"(V0[1]), "+v"(V0[2]), "+v"(V0[3]), "+v"(K1[0]), "+v"(K1[1]), "+v"(K1[2]), "+v"(K1[3]),
                         "+v"(V1[0]), "+v"(V1[1]), "+v"(V1[2]), "+v"(V1[3]), "+v"(K2[0]), "+v"(K2[1]), "+v"(K2[2]), "+v"(K2[3]), "+v"(V2[0]), "+v"(V2[1]), "+v"(V2[2]), "+v"(V2[3]) :: "memory");
#undef P9_GLD
#undef P9_LOAD
#undef P9_WAIT
#undef P9_BODY
        }
        const float inv = 1.0f / l;
        bf16* op = O2 + ktm_off(t, (4 * kh + rep) * 128 + 4 * h);
#pragma unroll
        for (int dt = 0; dt < 4; ++dt)
#pragma unroll
            for (int q = 0; q < 4; ++q) {
                v2u w; w.x = pg8::cvt_pk_bf16(O[dt][4 * q] * inv, O[dt][4 * q + 1] * inv); w.y = pg8::cvt_pk_bf16(O[dt][4 * q + 2] * inv, O[dt][4 * q + 3] * inv);
                *(GAS v2u*)(op + (dt >> 1) * 16384 + 32 * (dt & 1) + 8 * q) = w;
            }
    }
}

__device__ __forceinline__ void p13_final(Frame& F, const Params& P) {
    const int gw = F.vcu * NWAVES + F.wave, NGW = F.G * NWAVES;
    const pg8::ssq_t* ss4 = (const pg8::ssq_t*)(F.ws + WS_SS) + 4 * S; const float* gn = P.in[12]; const bf16* hb = (const bf16*)(F.ws + WS_HB);
    f32x4 gv[4][2];
#pragma unroll
    for (int j = 0; j < 4; ++j) { gv[j][0] = *((const f32x4*)gn + 2 * (F.lane + 64 * j)); gv[j][1] = *((const f32x4*)gn + 2 * (F.lane + 64 * j) + 1); }
    for (int m = gw; m < S; m += NGW) {
        const float rs = pg8::rstd_of(ss4[m]);
        const GAS v4u* hr = (const GAS v4u*)(hb + (size_t)(m >> 8) * (256 * D) + (size_t)((F.lane >> 3) * 16384 + (m & 255) * 64 + 8 * (F.lane & 7)));
        GAS f32x4* xr = (GAS f32x4*)(P.out + (size_t)m * D);
#pragma unroll
        for (int j = 0; j < 4; ++j) {
            const v4u v = hr[(8 * 16384 / 8) * j];
            const f32x4 lo = (f32x4){__uint_as_float(v.x << 16), __uint_as_float(v.x & 0xffff0000u), __uint_as_float(v.y << 16), __uint_as_float(v.y & 0xffff0000u)};
            const f32x4 hi = (f32x4){__uint_as_float(v.z << 16), __uint_as_float(v.z & 0xffff0000u), __uint_as_float(v.w << 16), __uint_as_float(v.w & 0xffff0000u)};
            xr[2 * (F.lane + 64 * j)] = lo * rs * gv[j][0]; xr[2 * (F.lane + 64 * j) + 1] = hi * rs * gv[j][1];
        }
    }
}


__global__ void __launch_bounds__(NWAVES * 64, 2) yoco_fwd(Params P) {
    extern __shared__ __attribute__((aligned(16))) unsigned char lds[];
    Frame F;
    F.lds = (LAS unsigned char*)lds;
    F.tid = threadIdx.x; F.lane = F.tid & 63; F.wave = __builtin_amdgcn_readfirstlane(F.tid >> 6);
    F.G = gridDim.x; { const int bx = blockIdx.x; F.vcu = (F.G % 8 == 0) ? (bx % 8) * (F.G / 8) + bx / 8 : bx; }
    F.ws = P.ws; F.outb = (unsigned char*)P.out;
    volatile LAS unsigned* MISC = (volatile LAS unsigned*)(F.lds + MISC_OFF);
    for (int u = F.tid; u < (LDS_BYTES - LDSCTL_OFF) / 4; u += NWAVES * 64) ((LAS unsigned*)(F.lds + LDSCTL_OFF))[u] = 0u;
    __syncthreads();
    const int lo = P.ph_lo, hi = P.ph_hi;
    const bool multi = (hi - lo) > 1;
    XcdBarrier bar; bar.bar = (unsigned*)(P.ws + WS_CTL) + CW_BAR; bar.x = 0; bar.st = nullptr;
    if (multi) bar = xcd_barrier_post((unsigned*)(P.ws + WS_CTL) + CW_BAR, MISC + 8);
#define IN(k) (lo <= (k) && (k) < hi)
#define BOTH(k) (IN(k) && IN((k) + 1))
#define GRID_BAR(k) do { if (BOTH(k)) xcd_barrier(bar); } while (0)
#ifndef PROBE_MASK
#define PROBE_MASK 0
#endif
#define REP(k) _Pragma("unroll") for (int rep_ = 0; rep_ < ((((PROBE_MASK) >> (k)) & 1) ? 2 : 1); ++rep_)
    unsigned char* ws = P.ws;
    pg8::ssq_t* ss = (pg8::ssq_t*)(ws + WS_SS);
    const float* cosh = (const float*)(ws + WS_COSH); const float* sinh = (const float*)(ws + WS_SINH);
    const float* cosi = (const float*)(ws + WS_COSI); const float* sini = (const float*)(ws + WS_SINI);
    bf16* hb = (bf16*)(ws + WS_HB);
    const int bx = (int)blockIdx.x;

    if (IN(0)) { REP(0) { p0_prologue(F, P); } GRID_BAR(0); }
    if (IN(1)) {
        pg8::Gemm g{hb, (const bf16*)(ws + WS_WIN), S, 4096, D}; pg8::StaticOrder So; So.init(S, 4096, F.G, bx);
        pg8::EpiIn E{ss, cosh, sinh, cosi, sini, (bf16*)(ws + WS_QA), (bf16*)(ws + WS_KA), (bf16*)(ws + WS_VA), (bf16*)(ws + WS_QI), (bf16*)(ws + WS_KI), (float*)(ws + WS_WI)};
        REP(1) { p1_kiwi(F, cosi, sini); pg8::gemm_phase<pg8::EpiIn, pg8::StaticOrder, true, true, true>(F.lds + RING_OFF, g, So, E); }
        GRID_BAR(1);
    }
    if (IN(2)) {
#ifdef PROBE_P2MODE
        p2_indexer<PROBE_P2MODE>(F);
#endif
        REP(2) { p2_indexer<0>(F); } GRID_BAR(2); }
    if (IN(3)) { REP(3) { p3_sparse_fp8(F); } GRID_BAR(3); }
    if (IN(4)) {
        pg8::Gemm g{(const bf16*)(ws + WS_OA), (const bf16*)(ws + WS_WOA), S, D, D}; pg8::StaticOrder So; So.init(S, D, F.G, bx);
        pg8::EpiRes E{hb, ss + 1 * S};
        pg8::gemm_phase<pg8::EpiRes, pg8::StaticOrder, true, true, true>(F.lds + RING_OFF, g, So, E);
        GRID_BAR(4);
    }
    if (IN(5)) {
        pg8::Gemm g{hb, (const bf16*)(ws + WS_WUP), S, FF, D}; pg8::StaticOrder So; So.init(S, FF, F.G, bx);
        pg8::EpiUp E{ss + 1 * S, (bf16*)(ws + WS_U), FF, 0};
        REP(5) pg8::gemm_phase<pg8::EpiUp, pg8::StaticOrder, true, true, true>(F.lds + RING_OFF, g, So, E);
        GRID_BAR(5);
    }
    if (IN(6)) {
        pg8::Gemm g{(const bf16*)(ws + WS_U), (const bf16*)(ws + WS_WDN), S, D, FF}; pg8::StaticOrder So; So.init(S, D, F.G, bx);
        pg8::EpiRes E{hb, ss + 2 * S};
        if (pg8::RowOrder::usable(S, D, F.G)) { pg8::RowOrder Ro; Ro.init(S, D, F.G, bx); pg8::gemm_phase<pg8::EpiRes, pg8::RowOrder, true, true, true>(F.lds + RING_OFF, g, Ro, E); }
        else pg8::gemm_phase<pg8::EpiRes, pg8::StaticOrder, true, true, true>(F.lds + RING_OFF, g, So, E);
        GRID_BAR(6);
    }
    if (IN(7)) {
        pg8::Gemm g{hb, (const bf16*)(ws + WS_WKVQ), S, NKVQ, D}; pg8::StaticOrder So; So.init(S, NKVQ, F.G, bx);
        pg8::EpiKvq E{ss + 2 * S, cosh, sinh, (bf16*)(ws + WS_KS), (bf16*)(ws + WS_VS), (bf16*)(ws + WS_Q2)};
        REP(7) pg8::gemm_phase<pg8::EpiKvq, pg8::StaticOrder, true, true, true>(F.lds + RING_OFF, g, So, E);
        GRID_BAR(7);
    }
    if (IN(8)) { REP(8) { p7_convert_mlp2(F, P); p8_kv_copies(F); } GRID_BAR(8); }
    if (IN(9)) { REP(9) { p9_dilated_dense(F); } GRID_BAR(9); }
    if (IN(10)) {
        pg8::Gemm g{(const bf16*)(ws + WS_O2), (const bf16*)(ws + WS_WOB), S, D, D}; pg8::StaticOrder So; So.init(S, D, F.G, bx);
        pg8::EpiRes E{hb, ss + 3 * S};
        pg8::gemm_phase<pg8::EpiRes, pg8::StaticOrder, true, true, true>(F.lds + RING_OFF, g, So, E);
        GRID_BAR(10);
    }
    if (IN(11)) {
        pg8::Gemm g{hb, (const bf16*)(ws + WS_WUP), S, FF, D}; pg8::StaticOrder So; So.init(S, FF, F.G, bx);
        pg8::EpiUp E{ss + 3 * S, (bf16*)(ws + WS_U), FF, 0};
        REP(11) pg8::gemm_phase<pg8::EpiUp, pg8::StaticOrder, true, true, true>(F.lds + RING_OFF, g, So, E);
        GRID_BAR(11);
    }
    if (IN(12)) {
        pg8::Gemm g{(const bf16*)(ws + WS_U), (const bf16*)(ws + WS_WDN), S, D, FF}; pg8::StaticOrder So; So.init(S, D, F.G, bx);
        pg8::EpiRes E{hb, ss + 4 * S};
        if (pg8::RowOrder::usable(S, D, F.G)) { pg8::RowOrder Ro; Ro.init(S, D, F.G, bx); pg8::gemm_phase<pg8::EpiRes, pg8::RowOrder, true, true, true>(F.lds + RING_OFF, g, Ro, E); }
        else pg8::gemm_phase<pg8::EpiRes, pg8::StaticOrder, true, true, true>(F.lds + RING_OFF, g, So, E);
        GRID_BAR(12);
    }
    if (IN(13)) { p13_final(F, P); }
#undef IN
#undef BOTH
#undef GRID_BAR
}

extern "C" void kernel_launch(void* const* d_in, const int* in_sizes, int n_in, void* d_out, int out_size, void* d_ws, size_t ws_size, hipStream_t stream) {
    static int grid = 0;
    if (grid == 0) {
        if (n_in != 13 || in_sizes[0] != S * D || out_size != S * D || ws_size < WS_END) { fprintf(stderr, "kernel_launch: unexpected shapes / workspace (n_in %d, ws %zu, need %zu)\n", n_in, ws_size, (size_t)WS_END); grid = -1; return; }
        int dev = 0, cus = 0, per_cu = 0;
        if (hipGetDevice(&dev) != hipSuccess || hipDeviceGetAttribute(&cus, hipDeviceAttributeMultiprocessorCount, dev) != hipSuccess) { grid = -1; return; }
        if (hipFuncSetAttribute((const void*)yoco_fwd, hipFuncAttributeMaxDynamicSharedMemorySize, LDS_BYTES) != hipSuccess) { fprintf(stderr, "kernel_launch: hipFuncSetAttribute failed\n"); grid = -1; return; }
        if (hipOccupancyMaxActiveBlocksPerMultiprocessor(&per_cu, (const void*)yoco_fwd, NWAVES * 64, LDS_BYTES) != hipSuccess || per_cu < 1) fprintf(stderr, "kernel_launch: occupancy query reports %d\n", per_cu);
        (void)hipGetLastError();
        grid = cus;
    }
    if (grid < 0) return;
    (void)hipMemsetAsync((char*)d_ws + WS_CTL, 0, CTL_ZERO_BYTES, stream);
    Params p{};
    for (int i = 0; i < 13; ++i) p.in[i] = (const float*)d_in[i];
    p.out = (float*)d_out; p.ws = (unsigned char*)d_ws;
    for (int i = 0; i < 16; ++i) p.invh[i] = (float)std::pow(500000.0, (double)(-(float)(2 * i) / 32.0f));
    for (int i = 0; i < 8; ++i) p.invi[i] = (float)std::pow(500000.0, (double)(-(float)(2 * i) / 16.0f));
#if MK_ONE_LAUNCH
    p.ph_lo = 0; p.ph_hi = N_PHASES;
    hipLaunchKernelGGL(yoco_fwd, dim3(grid), dim3(NWAVES * 64), LDS_BYTES, stream, p);
#else
    for (int k = 0; k < N_PHASES; ++k) { p.ph_lo = k; p.ph_hi = k + 1; hipLaunchKernelGGL(yoco_fwd, dim3(grid), dim3(NWAVES * 64), LDS_BYTES, stream, p); }
#endif
}
```

```cpp
#include <hip/hip_runtime.h>
#include <cstdio>
#include <cstdint>
#include <cmath>
namespace pg8 {
#define PG8_LAS __attribute__((address_space(3)))
typedef unsigned short bf16_t;
typedef short bf16x8 __attribute__((ext_vector_type(8)));
typedef float f32x4 __attribute__((ext_vector_type(4)));
typedef unsigned u32x4 __attribute__((ext_vector_type(4)));
constexpr int BM = 256, BK = 64, HALF = 128, HTB = HALF * BK * 2  , STAGE_BYTES = 8 * HTB, NXCD = 8, WGM = 8;

__host__ __device__ __forceinline__ int lds_byte(int r, int c) { const int st = (r >> 4) * 2 + (c >> 5), rr = r & 15, cc = c & 31, ob = rr * 64 + cc * 2; return st * 1024 + (ob ^ (((ob >> 9) & 1) << 5)); }
__host__ __device__ __forceinline__ void stage_rc(int b, int& R, int& C) { const int st = b / 1024, sb = b % 1024, swz = sb ^ (((sb >> 9) & 1) << 5); R = (st >> 1) * 16 + swz / 64; C = (st & 1) * 32 + (swz % 64) / 2; }
__host__ __device__ __forceinline__ int perm32(int rho) { const int n = rho >> 4, i = rho & 15; return 8 * (i >> 2) + 4 * n + (i & 3); }

struct Unit { int pm, pn; };
struct Gemm { const bf16_t* A; const bf16_t* Bt; int M, N, K; };

struct StaticOrder {
    int nM, nN, nwg, G, c;
    __host__ __device__ void init(int M, int N, int G_, int c_) { nM = M / BM; nN = N / BM; nwg = nM * nN; G = G_; c = c_; }
    __host__ __device__ bool next(int i, Unit& u) const {
        const long L = (long)i * G + c; if (L >= nwg) return false;
        int wgid = (int)L; { const int q = nwg / NXCD, r = nwg % NXCD, xcd = wgid % NXCD, off = wgid / NXCD; wgid = (xcd < r ? xcd * (q + 1) : r * (q + 1) + (xcd - r) * q) + off; }
        const int nig = WGM * nN, gid = wgid / nig, fm = gid * WGM, gsz = (nM - fm) < WGM ? (nM - fm) : WGM;
        u.pm = fm + ((wgid % nig) % gsz); u.pn = (wgid % nig) / gsz; return true;
    }
    __device__ __forceinline__ void a_ready(const Unit&) const {}
    __device__ __forceinline__ void done(const Unit&) const {}
};


__device__ __forceinline__ unsigned cvt_pk_bf16(float lo, float hi) { unsigned r; asm volatile("v_cvt_pk_bf16_f32 %0, %1, %2" : "=v"(r) : "v"(lo), "v"(hi)); return r; }
typedef unsigned u32x2 __attribute__((ext_vector_type(2)));
constexpr float RMS_EPS = 1e-6f;
typedef unsigned long long ssq_t;
__device__ __forceinline__ ssq_t ss_fix(float q) { return (ssq_t)(q * 65536.0f + 0.5f); }
__device__ __forceinline__ float rstd_of(ssq_t ss) { return 1.0f / sqrtf((float)ss * (1.0f / (65536.0f * 2048.0f)) + RMS_EPS); }
__device__ __forceinline__ u32x2 pack4(f32x4 v) { u32x2 w; w.x = cvt_pk_bf16(v[0], v[1]); w.y = cvt_pk_bf16(v[2], v[3]); return w; }

__device__ __forceinline__ size_t tm_off(int t, int c, int ld) { return (size_t)((t >> 8) * (ld >> 8) + (c >> 8)) * (size_t)(BM * BM) + (size_t)((t & 255) * BM + (c & 255)); }

__device__ __forceinline__ void store_heads128(const f32x4 (&acc)[2][2][4][2], int row0, int wc, int fq, const ssq_t* ss, bf16_t* base, int ld, int colt, bool rope, const float* cosh, const float* sinh) {
    rope = rope && (wc == 0);
    const int col0 = colt + wc * 32 + 4 * fq;
#pragma unroll
    for (int ai = 0; ai < 2; ++ai)
#pragma unroll
        for (int m = 0; m < 4; ++m) {
            const int row = row0 + ai * HALF + m * 16;
            const float rs = rstd_of(ss[row]);
            f32x4 c4 = (f32x4){1.f, 1.f, 1.f, 1.f}, s4 = (f32x4){0.f, 0.f, 0.f, 0.f};
            if (rope) { c4 = *(const f32x4*)(cosh + (size_t)row * 16 + 4 * fq); s4 = *(const f32x4*)(sinh + (size_t)row * 16 + 4 * fq); }
            bf16_t* rowp = base + tm_off(row, col0, ld);
#pragma unroll
            for (int bj = 0; bj < 2; ++bj) {
                f32x4 v0 = acc[ai][bj][m][0] * rs, v1 = acc[ai][bj][m][1] * rs;
                if (rope) { const f32x4 a = v0 * c4 - v1 * s4, b = v1 * c4 + v0 * s4; v0 = a; v1 = b; }
                *(u32x2*)(rowp + bj * HALF) = pack4(v0); *(u32x2*)(rowp + bj * HALF + 16) = pack4(v1);
            }
        }
}

constexpr int SEQ = 16384;
__device__ __forceinline__ int pack4_fp8(f32x4 v) { int w = __builtin_amdgcn_cvt_pk_fp8_f32(v[0], v[1], 0, false); return __builtin_amdgcn_cvt_pk_fp8_f32(v[2], v[3], w, true); }
__device__ __forceinline__ void store_heads128_fp8(const f32x4 (&acc)[2][2][4][2], int row0, int wc, int fq, const ssq_t* ss, unsigned char* base, int head0, bool rope, const float* cosh, const float* sinh) {
    rope = rope && (wc == 0);
#pragma unroll
    for (int ai = 0; ai < 2; ++ai)
#pragma unroll
        for (int m = 0; m < 4; ++m) {
            const int row = row0 + ai * HALF + m * 16;
            const float rs = rstd_of(ss[row]);
            f32x4 c4 = (f32x4){1.f, 1.f, 1.f, 1.f}, s4 = (f32x4){0.f, 0.f, 0.f, 0.f};
            if (rope) { c4 = *(const f32x4*)(cosh + (size_t)row * 16 + 4 * fq); s4 = *(const f32x4*)(sinh + (size_t)row * 16 + 4 * fq); }
#pragma unroll
            for (int bj = 0; bj < 2; ++bj) {
                f32x4 v0 = acc[ai][bj][m][0] * rs, v1 = acc[ai][bj][m][1] * rs;
                if (rope) { const f32x4 a = v0 * c4 - v1 * s4, b = v1 * c4 + v0 * s4; v0 = a; v1 = b; }
                unsigned char* p = base + ((size_t)(head0 + bj) * SEQ + row) * 128 + wc * 32 + 4 * fq;
                *(int*)p = pack4_fp8(v0); *(int*)(p + 16) = pack4_fp8(v1);
            }
        }
}

__device__ __forceinline__ void store_heads128_q8(const f32x4 (&acc)[2][2][4][2], int row0, int wc, int fq, const ssq_t* ss, unsigned char* base, int ld, int colt, const float* cosh, const float* sinh) {
    const bool rope = (wc == 0);
    const int col0 = colt + wc * 32 + 4 * fq;
#pragma unroll
    for (int ai = 0; ai < 2; ++ai)
#pragma unroll
        for (int m = 0; m < 4; ++m) {
            const int row = row0 + ai * HALF + m * 16;
            const float rs = rstd_of(ss[row]);
            f32x4 c4 = (f32x4){1.f, 1.f, 1.f, 1.f}, s4 = (f32x4){0.f, 0.f, 0.f, 0.f};
            if (rope) { c4 = *(const f32x4*)(cosh + (size_t)row * 16 + 4 * fq); s4 = *(const f32x4*)(sinh + (size_t)row * 16 + 4 * fq); }
            unsigned char* rowp = base + tm_off(row, col0, ld);
#pragma unroll
            for (int bj = 0; bj < 2; ++bj) {
                f32x4 v0 = acc[ai][bj][m][0] * rs, v1 = acc[ai][bj][m][1] * rs;
                if (rope) { const f32x4 a = v0 * c4 - v1 * s4, b = v1 * c4 + v0 * s4; v0 = a; v1 = b; }
                *(int*)(rowp + bj * HALF) = pack4_fp8(v0); *(int*)(rowp + bj * HALF + 16) = pack4_fp8(v1);
            }
        }
}

struct EpiIn {
    static constexpr bool PERM = false, AFTER_DRAIN = false;
    const ssq_t* ss;
    const float *cosh, *sinh, *cosi, *sini;
    bf16_t *Q, *K, *V, *QI, *KI; float* WI;
    __device__ __forceinline__ void operator()(const f32x4 (&acc)[2][2][4][2], const Unit& u, int wr, int wc, int fr, int fq) const {
        const int row0 = u.pm * BM + wr * 64 + fr, pn = u.pn;
        if (pn < 12) {
            if (pn < 8) store_heads128_q8(acc, row0, wc, fq, ss, (unsigned char*)Q, 2048, pn * 256, cosh, sinh);
            else if (pn < 10) store_heads128_fp8(acc, row0, wc, fq, ss, (unsigned char*)K, 2 * (pn - 8), true, cosh, sinh);
            else store_heads128_fp8(acc, row0, wc, fq, ss, (unsigned char*)V, 2 * (pn - 10), false, cosh, sinh);
        } else if (pn < 16) {
            const int col0 = (pn - 12) * 256 + wc * 32 + 4 * fq; const bool rope = (wc & 1) == 0;
#pragma unroll
            for (int ai = 0; ai < 2; ++ai)
#pragma unroll
                for (int m = 0; m < 4; ++m) {
                    const int row = row0 + ai * HALF + m * 16; const float rs = rstd_of(ss[row]);
                    const f32x4 c4 = *(const f32x4*)(cosi + (size_t)row * 8 + 4 * (fq & 1)), s4 = *(const f32x4*)(sini + (size_t)row * 8 + 4 * (fq & 1));
                    bf16_t* rowp = QI + tm_off(row, col0, 1024);
#pragma unroll
                    for (int bj = 0; bj < 2; ++bj) {
                        f32x4 v0 = acc[ai][bj][m][0] * rs; const f32x4 v1 = acc[ai][bj][m][1] * rs;
                        f32x4 p; p[0] = __shfl_xor(v0[0], 32); p[1] = __shfl_xor(v0[1], 32); p[2] = __shfl_xor(v0[2], 32); p[3] = __shfl_xor(v0[3], 32);
                        if (rope) v0 = (fq < 2) ? (v0 * c4 - p * s4) : (v0 * c4 + p * s4);
                        *(u32x2*)(rowp + bj * HALF) = pack4(v0); *(u32x2*)(rowp + bj * HALF + 16) = pack4(v1);
                    }
                }
        }
    }
};

struct EpiKvq {
    static constexpr bool PERM = false, AFTER_DRAIN = false;
    const ssq_t* ss; const float *cosh, *sinh; bf16_t *K, *V, *Q;
    __device__ __forceinline__ void operator()(const f32x4 (&acc)[2][2][4][2], const Unit& u, int wr, int wc, int fr, int fq) const {
        const int row0 = u.pm * BM + wr * 64 + fr, pn = u.pn;
        if (pn < 2) store_heads128(acc, row0, wc, fq, ss, K, 512, pn * 256, true, cosh, sinh);
        else if (pn < 4) store_heads128(acc, row0, wc, fq, ss, V, 512, (pn - 2) * 256, false, cosh, sinh);
        else store_heads128_q8(acc, row0, wc, fq, ss, (unsigned char*)Q, 6144, (pn - 4) * 256, cosh, sinh);
    }
};

struct EpiRes {
    static constexpr bool PERM = true, AFTER_DRAIN = false;
    bf16_t* hb; ssq_t* ssq;
    __device__ __forceinline__ void operator()(const f32x4 (&acc)[2][2][4][2], const Unit& u, int wr, int wc, int fr, int fq) const {
        const int row0 = u.pm * BM + wr * 64 + fr, col0 = u.pn * BM + wc * 32 + 8 * fq;
#pragma unroll
        for (int ai = 0; ai < 2; ++ai)
#pragma unroll
            for (int m = 0; m < 4; ++m) {
                const int row = row0 + ai * HALF + m * 16; float q = 0.f;
                bf16_t* rowp = hb + ((size_t)(u.pm * 8 + u.pn) * (size_t)(BM * BM) + (size_t)((wc >> 1) * (BM * BK) + (row - u.pm * BM) * BK + (wc & 1) * 32 + 8 * fq));
                u32x4 b[2];
#pragma unroll
                for (int bj = 0; bj < 2; ++bj) b[bj] = *(const u32x4*)(rowp + bj * (2 * BM * BK));
#pragma unroll
                for (int bj = 0; bj < 2; ++bj) {
                    u32x4 w;
#pragma unroll
                    for (int i = 0; i < 4; ++i) {
                        const f32x4& a = acc[ai][bj][m][i >> 1];
                        const float lo = __uint_as_float(b[bj][i] << 16) + a[(i & 1) * 2], hi = __uint_as_float(b[bj][i] & 0xffff0000u) + a[(i & 1) * 2 + 1];
                        const unsigned pk = cvt_pk_bf16(lo, hi); w[i] = pk;
                        const float rl = __uint_as_float(pk << 16), rh = __uint_as_float(pk & 0xffff0000u);
                        q += rl * rl + rh * rh;
                    }
                    *(u32x4*)(rowp + bj * (2 * BM * BK)) = w;
                }
                q += __shfl_xor(q, 16); q += __shfl_xor(q, 32);
                if (fq == 0) atomicAdd(ssq + row, ss_fix(q));
            }
    }
};

struct RowOrder {
    int nN, nwg, G, c;
    __host__ __device__ void init(int M, int N, int G_, int c_) { nN = N / BM; nwg = (M / BM) * nN; G = G_; c = c_; }
    __host__ __device__ static bool usable(int M, int N, int G_) { const int n = N / BM; return G_ % (NXCD * n) == 0 && ((M / BM) * n) % G_ == 0; }
    __host__ __device__ bool next(int i, Unit& u) const {
        if ((long)i * G + c >= nwg) return false;
        const int ppx = G / NXCD / nN, x = c % NXCD, j = c / NXCD;
        u.pm = i * (G / nN) + x * ppx + (j % ppx); u.pn = j / ppx; return true;
    }
    __device__ __forceinline__ void a_ready(const Unit&) const {}
    __device__ __forceinline__ void done(const Unit&) const {}
};

struct EpiUp {
    static constexpr bool PERM = true, AFTER_DRAIN = false;
    const ssq_t* ss; bf16_t* O; int ldc; int dry;
    __device__ __forceinline__ void operator()(const f32x4 (&acc)[2][2][4][2], const Unit& u, int wr, int wc, int fr, int fq) const {
        const int row0 = u.pm * BM + wr * 64 + fr, col0 = u.pn * BM + wc * 32 + 8 * fq;
#pragma unroll
        for (int ai = 0; ai < 2; ++ai)
#pragma unroll
            for (int m = 0; m < 4; ++m) {
                const int row = row0 + ai * HALF + m * 16; const float rs = rstd_of(ss[row]);
                bf16_t* rowp = O + ((size_t)(u.pm * (ldc / BM) + u.pn) * (size_t)(BM * BM) + (size_t)((wc >> 1) * (BM * BK) + (row - u.pm * BM) * BK + (wc & 1) * 32 + 8 * fq));
#pragma unroll
                for (int bj = 0; bj < 2; ++bj) {
                    f32x4 v0 = acc[ai][bj][m][0] * rs, v1 = acc[ai][bj][m][1] * rs;
                    v0 = __builtin_elementwise_max(v0, (f32x4){0.f, 0.f, 0.f, 0.f}); v1 = __builtin_elementwise_max(v1, (f32x4){0.f, 0.f, 0.f, 0.f});
                    v0 = v0 * v0; v1 = v1 * v1;
                    u32x4 w; w.x = cvt_pk_bf16(v0[0], v0[1]); w.y = cvt_pk_bf16(v0[2], v0[3]); w.z = cvt_pk_bf16(v1[0], v1[1]); w.w = cvt_pk_bf16(v1[2], v1[3]);
                    if (dry) asm volatile("" :: "v"(w.x), "v"(w.y), "v"(w.z), "v"(w.w)); else *(u32x4*)(rowp + bj * (2 * BM * BK)) = w;
                }
            }
    }
};
template <class Epi, class Sched, bool ALIGN_EPI = false, bool SP2 = false, bool ATILED = false>
__device__ __forceinline__ void gemm_phase(PG8_LAS unsigned char* lds, const Gemm g, const Sched& S, const Epi& E) {
    const int tid = threadIdx.x, wid = __builtin_amdgcn_readfirstlane(tid >> 6), lane = tid & 63, wr = wid >> 2, wc = wid & 3, fr = lane & 15, fq = lane >> 4;
    const int K = g.K, nt = K / BK;
    const int LDA = ATILED ? BK : K;
    unsigned voffA[2], voffB[2];
#pragma unroll
    for (int i = 0; i < 2; ++i) { int R, C; stage_rc(tid * 16 + i * 8192, R, C); const int Rb = Epi::PERM ? ((R & ~31) + perm32(R & 31)) : R;
        voffA[i] = (unsigned)(R * LDA + C) * 2u; voffB[i] = (unsigned)(Rb * LDA + C) * 2u; }
    const size_t kstep = (size_t)(BK * 2);
    const size_t hstepA = (size_t)HALF * LDA * 2, hstepB = hstepA;
    const size_t tstep = (size_t)BM * K * 2;
    const unsigned ldsw = (unsigned)wid * 1024u;
    const int aoff = lds_byte(wr * 64 + fr, fq * 8), boff = lds_byte(wc * 32 + fr, fq * 8);
#define PG8_SA(b, h) (((b) * 2 + (h)) * HTB)
#define PG8_SB(b, h) ((4 + (b) * 2 + (h)) * HTB)
#define PG8_STAGE(bufoff, gbase, voff) do { _Pragma("unroll") for (int _i = 0; _i < 2; ++_i) \
        __builtin_amdgcn_global_load_lds((const unsigned*)((const char*)(gbase) + (voff)[_i]), (PG8_LAS unsigned*)(lds + (bufoff) + ldsw + _i * 8192), 16, 0, 0); } while (0)
#define PG8_LDA(dst, b, h) do { _Pragma("unroll") for (int m = 0; m < 4; ++m) _Pragma("unroll") for (int k = 0; k < 2; ++k) dst[m][k] = *(const PG8_LAS bf16x8*)(lds + PG8_SA(b, h) + aoff + m * 2048 + k * 1024); } while (0)
#define PG8_LDB(dst, b, h) do { _Pragma("unroll") for (int n = 0; n < 2; ++n) _Pragma("unroll") for (int k = 0; k < 2; ++k) dst[n][k] = *(const PG8_LAS bf16x8*)(lds + PG8_SB(b, h) + boff + n * 2048 + k * 1024); } while (0)
#define PG8_MMA(ai, bj, At, Bt) do { __builtin_amdgcn_s_setprio(1); _Pragma("unroll") for (int m = 0; m < 4; ++m) _Pragma("unroll") for (int n = 0; n < 2; ++n) _Pragma("unroll") for (int k = 0; k < 2; ++k) \
        acc[ai][bj][m][n] = __builtin_amdgcn_mfma_f32_16x16x32_bf16(Bt[n][k], At[m][k], acc[ai][bj][m][n], 0, 0, 0); __builtin_amdgcn_s_setprio(0); } while (0)
#define PG8_WAIT_V(n) asm volatile("s_waitcnt vmcnt(" #n ")" ::: "memory")
#define PG8_WAIT_L(n) asm volatile("s_waitcnt lgkmcnt(" #n ")" ::: "memory")
#define PG8_BAR __builtin_amdgcn_s_barrier()
#define PG8_SCHED __builtin_amdgcn_sched_barrier(0)
    auto akt = [&](int t) -> size_t { return ATILED ? (size_t)t * (size_t)(BM * BK * 2) : (size_t)t * kstep; };
    const size_t akt1 = akt(1);
    Unit cur, nxt; int ui = 0;
    if (!S.next(0, cur)) return;
    f32x4 acc[2][2][4][2];
#pragma unroll
    for (int a = 0; a < 2; ++a)
#pragma unroll
        for (int b = 0; b < 2; ++b)
#pragma unroll
            for (int m = 0; m < 4; ++m)
#pragma unroll
                for (int n = 0; n < 2; ++n) acc[a][b][m][n] = (f32x4){0.f, 0.f, 0.f, 0.f};
    bf16x8 At[4][2], B0[2][2], B1[2][2];
    const char* cA = (const char*)g.A + (size_t)cur.pm * tstep; const char* cB = (const char*)g.Bt + (size_t)cur.pn * tstep;
    S.a_ready(cur);
    if constexpr (SP2) {
        PG8_STAGE(PG8_SB(0, 0), cB, voffB); PG8_STAGE(PG8_SB(0, 1), cB + hstepB, voffB); PG8_STAGE(PG8_SA(0, 0), cA, voffA); PG8_STAGE(PG8_SA(0, 1), cA + hstepA, voffA);
        if (wr == 1) PG8_BAR;
        PG8_WAIT_V(2); PG8_BAR;
        PG8_STAGE(PG8_SB(1, 0), cB + akt1, voffB); PG8_STAGE(PG8_SA(1, 0), cA + akt1, voffA); PG8_STAGE(PG8_SB(1, 1), cB + hstepB + akt1, voffB);
        PG8_WAIT_V(6); PG8_BAR;
    } else {
        PG8_STAGE(PG8_SB(0, 0), cB, voffB); PG8_STAGE(PG8_SA(0, 0), cA, voffA); PG8_STAGE(PG8_SB(0, 1), cB + hstepB, voffB); PG8_STAGE(PG8_SA(0, 1), cA + hstepA, voffA);
        if (wr == 1) PG8_BAR;
        PG8_WAIT_V(4); PG8_BAR;
        PG8_STAGE(PG8_SB(1, 0), cB + akt1, voffB); PG8_STAGE(PG8_SA(1, 0), cA + akt1, voffA); PG8_STAGE(PG8_SB(1, 1), cB + hstepB + akt1, voffB);
        PG8_WAIT_V(6); PG8_BAR;
    }
    for (;;) {
        const bool has_next = S.next(ui + 1, nxt);
        const char* nA = has_next ? (const char*)g.A + (size_t)nxt.pm * tstep : cA; const char* nB = has_next ? (const char*)g.Bt + (size_t)nxt.pn * tstep : cB;
        for (int t = 0; t < nt; t += 2) {
            const bool last = (t == nt - 2);
            const char* a1 = cA + akt(t + 1);
            const char* a2 = last ? nA : cA + akt(t + 2); const char* b2 = last ? nB : cB + akt(t + 2);
            const char* a3 = a2 + akt1; const char* b3 = b2 + akt1;
            if (last && has_next) S.a_ready(nxt);
            if constexpr (SP2) {
            PG8_LDB(B0, 0, 0); PG8_LDB(B1, 0, 1); PG8_SCHED; PG8_LDA(At, 0, 0); PG8_STAGE(PG8_SA(1, 1), a1 + hstepA, voffA);
            PG8_WAIT_V(8); PG8_WAIT_L(0); PG8_BAR; PG8_MMA(0, 0, At, B0); PG8_MMA(0, 1, At, B1); PG8_BAR; PG8_SCHED;
            PG8_LDA(At, 0, 1); PG8_STAGE(PG8_SB(0, 0), b2, voffB); PG8_STAGE(PG8_SB(0, 1), b2 + hstepB, voffB); PG8_STAGE(PG8_SA(0, 0), a2, voffA);
            PG8_WAIT_V(8); PG8_WAIT_L(0); PG8_BAR; PG8_MMA(1, 0, At, B0); PG8_MMA(1, 1, At, B1); PG8_BAR; PG8_SCHED;
            PG8_LDB(B0, 1, 0); PG8_LDB(B1, 1, 1); PG8_SCHED; PG8_LDA(At, 1, 0); PG8_STAGE(PG8_SA(0, 1), a2 + hstepA, voffA);
            PG8_WAIT_V(8); PG8_WAIT_L(0); PG8_BAR; PG8_MMA(0, 0, At, B0); PG8_MMA(0, 1, At, B1); PG8_BAR; PG8_SCHED;
            PG8_LDA(At, 1, 1); PG8_STAGE(PG8_SB(1, 0), b3, voffB); PG8_STAGE(PG8_SB(1, 1), b3 + hstepB, voffB); PG8_STAGE(PG8_SA(1, 0), a3, voffA);
            PG8_WAIT_V(8); PG8_WAIT_L(0); PG8_BAR; PG8_MMA(1, 0, At, B0); PG8_MMA(1, 1, At, B1); PG8_BAR; PG8_SCHED;
            } else {
            PG8_LDB(B0, 0, 0); PG8_SCHED; PG8_LDA(At, 0, 0); PG8_STAGE(PG8_SA(1, 1), a1 + hstepA, voffA);
            PG8_WAIT_L(8); PG8_BAR; PG8_WAIT_L(0); PG8_MMA(0, 0, At, B0); PG8_BAR; PG8_SCHED;
            PG8_LDB(B1, 0, 1); PG8_STAGE(PG8_SB(0, 0), b2, voffB);
            PG8_BAR; PG8_WAIT_L(0); PG8_MMA(0, 1, At, B1); PG8_BAR;
            PG8_LDA(At, 0, 1); PG8_STAGE(PG8_SA(0, 0), a2, voffA);
            PG8_BAR; PG8_WAIT_L(0); PG8_MMA(1, 0, At, B0); PG8_BAR; PG8_SCHED;
            PG8_STAGE(PG8_SB(0, 1), b2 + hstepB, voffB);
            PG8_WAIT_V(6); PG8_BAR; PG8_MMA(1, 1, At, B1); PG8_BAR;
            PG8_LDB(B0, 1, 0); PG8_SCHED; PG8_LDA(At, 1, 0); PG8_STAGE(PG8_SA(0, 1), a2 + hstepA, voffA);
            PG8_WAIT_L(8); PG8_BAR; PG8_WAIT_L(0); PG8_MMA(0, 0, At, B0); PG8_BAR; PG8_SCHED;
            PG8_LDB(B1, 1, 1); PG8_STAGE(PG8_SB(1, 0), b3, voffB);
            PG8_BAR; PG8_WAIT_L(0); PG8_MMA(0, 1, At, B1); PG8_BAR;
            PG8_LDA(At, 1, 1); PG8_STAGE(PG8_SA(1, 0), a3, voffA);
            PG8_BAR; PG8_WAIT_L(0); PG8_MMA(1, 0, At, B0); PG8_BAR; PG8_SCHED;
            PG8_STAGE(PG8_SB(1, 1), b3 + hstepB, voffB);
            PG8_WAIT_V(6); PG8_BAR; PG8_MMA(1, 1, At, B1); PG8_BAR;
            }
        }
        if constexpr (ALIGN_EPI) { if (wr == 0) PG8_BAR; }
        if constexpr (!Epi::AFTER_DRAIN) { E(acc, cur, wr, wc, fr, fq); S.done(cur); }
        if (!has_next) break;
#pragma unroll
        for (int a = 0; a < 2; ++a)
#pragma unroll
            for (int b = 0; b < 2; ++b)
#pragma unroll
                for (int m = 0; m < 4; ++m)
#pragma unroll
                    for (int n = 0; n < 2; ++n) acc[a][b][m][n] = (f32x4){0.f, 0.f, 0.f, 0.f};
        cur = nxt; cA = nA; cB = nB; ++ui;
        if constexpr (ALIGN_EPI) { if (wr == 1) PG8_BAR; }
    }
    PG8_WAIT_V(0);
    if constexpr (!ALIGN_EPI) { if (wr == 0) PG8_BAR; }
    PG8_BAR;
    if constexpr (Epi::AFTER_DRAIN) { E.fused(acc, cur, wr, wc, fr, fq, lds, wid, lane); S.done(cur); }
#undef PG8_SA
#undef PG8_SB
#undef PG8_STAGE
#undef PG8_LDA
#undef PG8_LDB
#undef PG8_MMA
#undef PG8_WAIT_V
#undef PG8_WAIT_L
#undef PG8_BAR
#undef PG8_SCHED
}
}

constexpr int S = 16384, D = 2048, FF = 8192;
constexpr int NIN = 4176, NIN_PAD = 4352;
constexpr int NKVQ = 7168;
constexpr int TOPK = 256;
constexpr int NWAVES = 8;
constexpr int N_PHASES = 14;
#ifndef MK_ONE_LAUNCH
#define MK_ONE_LAUNCH 1
#endif

constexpr size_t MiB = 1u << 20;
constexpr size_t WS_CTL = 0, CTL_ZERO_BYTES = 16384;
constexpr size_t WS_COSH = 1 * MiB, WS_SINH = 2 * MiB, WS_COSI = 3 * MiB, WS_SINI = 3 * MiB + 512 * 1024;
constexpr size_t WS_SS = 4 * MiB;
constexpr size_t WS_SEL = 5 * MiB;
constexpr size_t WS_WIN = 13 * MiB, WS_WOA = 30 * MiB, WS_WOB = 38 * MiB, WS_WKVQ = 46 * MiB, WS_WUP = 74 * MiB, WS_WDN = 106 * MiB;
constexpr size_t WS_HB = 138 * MiB;
constexpr size_t WS_R = 202 * MiB;
constexpr size_t WS_QA = WS_R, WS_KA = WS_R + 64 * MiB, WS_VA = WS_R + 80 * MiB, WS_QI = WS_R + 96 * MiB, WS_KI = WS_R + 128 * MiB, WS_WI = WS_R + 130 * MiB, WS_OA = WS_R + 132 * MiB;
constexpr size_t WS_U = WS_R;
constexpr size_t WS_Q2 = WS_R, WS_KS = WS_R + 192 * MiB, WS_VS = WS_R + 208 * MiB, WS_O2 = WS_R + 224 * MiB;
constexpr size_t WS_END = WS_R + 288 * MiB;
constexpr size_t WS_VT0 = 5 * MiB, WS_VT1 = 21 * MiB, WS_VT2 = 46 * MiB;
static_assert(WS_OA + 64 * MiB <= WS_END && WS_U + 256 * MiB <= WS_END && WS_O2 + 64 * MiB <= WS_END, "ws map");
constexpr int CW_BAR = 0;

constexpr int RING_OFF = 0, RING_BYTES = 131072;
constexpr int LDSCTL_OFF = RING_BYTES, MISC_OFF = LDSCTL_OFF + 320;
constexpr int LDS_BYTES = 147456;

#define GAS __attribute__((address_space(1)))
#define LAS __attribute__((address_space(3)))
typedef unsigned short bf16;
typedef unsigned v4u __attribute__((ext_vector_type(4)));
typedef unsigned v2u __attribute__((ext_vector_type(2)));
typedef float f32x4 __attribute__((ext_vector_type(4)));
typedef float f32x16 __attribute__((ext_vector_type(16)));
typedef short bf16x8 __attribute__((ext_vector_type(8)));
typedef GAS unsigned gu32;
#define LDS_WAIT() asm volatile("s_waitcnt lgkmcnt(0)" ::: "memory")
#define VM_WAIT() asm volatile("s_waitcnt vmcnt(0)" ::: "memory")
__device__ __forceinline__ unsigned f2bf(float f) { unsigned u = __builtin_bit_cast(unsigned, f); return (u + 0x7fffu + ((u >> 16) & 1u)) >> 16; }
__device__ __forceinline__ unsigned pk2(float lo, float hi) { return f2bf(lo) | (f2bf(hi) << 16); }
__device__ __forceinline__ float bf2f(short v) { return __uint_as_float(((unsigned)(unsigned short)v) << 16); }
#define XB_TMO      128
#define XB_XCNT(j)  (256  + 64 * (j))
#define XB_XSUB(j)  (1280 + 64 * (j))
#define XB_XGEN(j)  (2304 + 64 * (j))
#define XB_TOP      3328
#define XB_TOPGEN   3392
#define XCD_BAR_WORDS 3456
#define XB_SPIN_CAP (1u << 18)

__device__ __forceinline__ unsigned xb_ld(unsigned* p)              { return __hip_atomic_load(p, __ATOMIC_RELAXED, __HIP_MEMORY_SCOPE_AGENT); }
__device__ __forceinline__ unsigned xb_add(unsigned* p, unsigned v) { return __hip_atomic_fetch_add(p, v, __ATOMIC_RELAXED, __HIP_MEMORY_SCOPE_AGENT); }
__device__ __forceinline__ unsigned xb_xcc_id() { return (unsigned)__builtin_amdgcn_s_getreg((3 << 11) | 20) & 0xFu; }
#define XB_SPIN(cond, bar) do { unsigned _sp = 0; while (cond) { __builtin_amdgcn_s_sleep(1); \
    if ((++_sp & 255u) == 0u) { if (xb_ld(&(bar)[XB_TMO])) break; if (_sp > XB_SPIN_CAP) { atomicAdd(&(bar)[XB_TMO], 1u); break; } } } } while (0)

struct XcdBarrier {
    unsigned* bar; unsigned x;
    volatile LAS unsigned* st;
};

__device__ __forceinline__ XcdBarrier xcd_barrier_post(unsigned* bar, volatile LAS unsigned* st) {
    XcdBarrier b; b.bar = bar; b.x = xb_xcc_id(); b.st = st;
    if (threadIdx.x == 0) (void)xb_add(&bar[XB_XCNT(b.x)], 1u);
    return b;
}
__device__ __forceinline__ void xcd_barrier_complete(unsigned* bar, unsigned x, unsigned& nloc, unsigned& nx) {
    const unsigned G = gridDim.x * gridDim.y * gridDim.z;
    unsigned sum, cnt, mine, sp = 0u;
    for (;;) {
        sum = 0u; cnt = 0u; mine = 0u;
#pragma unroll
        for (unsigned j = 0; j < 16; ++j) { const unsigned c = xb_ld(&bar[XB_XCNT(j)]); sum += c; cnt += (c > 0u) ? 1u : 0u; mine = (j == x) ? c : mine; }
        if (sum == G) break;
        __builtin_amdgcn_s_sleep(1);
        if ((++sp & 255u) == 0u) { if (xb_ld(&bar[XB_TMO])) break; if (sp > XB_SPIN_CAP) { atomicAdd(&bar[XB_TMO], 1u); break; } }
    }
    nloc = mine > 0u ? mine : 1u; nx = cnt > 0u ? cnt : 1u;
}

__device__ __forceinline__ void xcd_barrier(const XcdBarrier& b) {
    asm volatile("s_waitcnt vmcnt(0)" ::: "memory");
    __syncthreads();
    if (threadIdx.x == 0) {
        unsigned* bar = b.bar;
        __builtin_amdgcn_s_waitcnt(0);
        unsigned nloc = b.st[0], nx = b.st[1];
        if (nloc == 0u) { xcd_barrier_complete(bar, b.x, nloc, nx); b.st[0] = nloc; b.st[1] = nx; }
        const unsigned old = xb_add(&bar[XB_XSUB(b.x)], 1u);
        const unsigned gen = old / nloc;
        if (old + 1u == (gen + 1u) * nloc) {
            __builtin_amdgcn_fence(__ATOMIC_RELEASE, "agent");
            asm volatile("s_waitcnt vmcnt(0)" ::: "memory");
            const unsigned og = xb_add(&bar[XB_TOP], 1u);
            const unsigned tg = og / nx;
            if (og + 1u == (tg + 1u) * nx) xb_add(&bar[XB_TOPGEN], 1u);
            else XB_SPIN(xb_ld(&bar[XB_TOPGEN]) == tg, bar);
            __builtin_amdgcn_fence(__ATOMIC_ACQUIRE, "agent");
            xb_add(&bar[XB_XGEN(b.x)], 1u);
            asm volatile("s_waitcnt vmcnt(0)" ::: "memory");
        } else {
            XB_SPIN(xb_ld(&bar[XB_XGEN(b.x)]) == gen, bar);
            __builtin_amdgcn_fence(__ATOMIC_ACQUIRE, "agent");
            asm volatile("s_waitcnt vmcnt(0)" ::: "memory");
        }
    }
    __syncthreads();
}

struct Params { const float* in[13]; float* out; unsigned char* ws; float invh[16]; float invi[8]; int ph_lo, ph_hi; };
struct Frame {
    LAS unsigned char* lds;
    int tid, lane, wave, vcu, G;
    unsigned char* ws; unsigned char* outb;
};
template <int CTRL> __device__ __forceinline__ float dpp_mov(float v) { return __uint_as_float(__builtin_amdgcn_update_dpp(0u, __float_as_uint(v), CTRL, 0xf, 0xf, false)); }
__device__ __forceinline__ float row_sum16(float v) { v += dpp_mov<0x128>(v); v += dpp_mov<0x124>(v); v += dpp_mov<0x122>(v); v += dpp_mov<0x121>(v); return v; }
__device__ __forceinline__ float row_max16(float v) { v = __builtin_fmaxf(v, dpp_mov<0x128>(v)); v = __builtin_fmaxf(v, dpp_mov<0x124>(v)); v = __builtin_fmaxf(v, dpp_mov<0x122>(v)); v = __builtin_fmaxf(v, dpp_mov<0x121>(v)); return v; }
__device__ __forceinline__ float swap16_sum(float v) { const auto r = __builtin_amdgcn_permlane16_swap(__float_as_uint(v), __float_as_uint(v), false, false); return __uint_as_float(r[0]) + __uint_as_float(r[1]); }
__device__ __forceinline__ float swap32_sum(float v) { const auto r = __builtin_amdgcn_permlane32_swap(__float_as_uint(v), __float_as_uint(v), false, false); return __uint_as_float(r[0]) + __uint_as_float(r[1]); }
__device__ __forceinline__ float swap32_max(float v) { const auto r = __builtin_amdgcn_permlane32_swap(__float_as_uint(v), __float_as_uint(v), false, false); return __builtin_fmaxf(__uint_as_float(r[0]), __uint_as_float(r[1])); }
__device__ __forceinline__ float bcast_row0(float v) {
    const auto r = __builtin_amdgcn_permlane16_swap(__float_as_uint(v), __float_as_uint(v), false, false);
    const auto q = __builtin_amdgcn_permlane32_swap(r[0], r[0], false, false);
    return __uint_as_float(q[0]);
}
__device__ __forceinline__ float wave_sum(float v) { return swap32_sum(swap16_sum(row_sum16(v))); }

__device__ __forceinline__ size_t ktm_off(int t, int c) { return (size_t)(t >> 8) * (size_t)(256 * 2048) + (size_t)((c >> 6) * 16384 + (t & 255) * 64 + (c & 63)); }
__device__ __forceinline__ void tr_item(const float* W, int K, int N, int Npad, const float* gain, bf16* WT, int row_off, LAS float* scr, int item, int lane) {
    const int nblk = Npad / 32, kb = item / nblk, nb = item - kb * nblk, k0 = 64 * kb, n0 = 32 * nb;
    const int kr = lane >> 3, c = lane & 7, n = n0 + 4 * c;
    f32x4 v[8];
#pragma unroll
    for (int i = 0; i < 8; ++i) {
        const float* src = W + (size_t)(k0 + kr + 8 * i) * N + n;
        if (n + 3 < N) v[i] = *(const GAS f32x4*)src;
        else { v[i] = (f32x4){0.f, 0.f, 0.f, 0.f}; if (n < N) v[i].x = src[0]; if (n + 1 < N) v[i].y = src[1]; if (n + 2 < N) v[i].z = src[2]; }
    }
#pragma unroll
    for (int i = 0; i < 8; ++i) {
        const int kk = kr + 8 * i; const float gsc = gain ? gain[k0 + kk] : 1.0f;
        LAS float* d = scr + kk * 33 + 4 * c;
        d[0] = v[i].x * gsc; d[1] = v[i].y * gsc; d[2] = v[i].z * gsc; d[3] = v[i].w * gsc;
    }
    LDS_WAIT(); asm volatile("" ::: "memory");
    const int c8 = lane & 7;
#pragma unroll
    for (int j = 0; j < 4; ++j) { const int nn = (lane >> 3) + 8 * j; const LAS float* s = scr + (8 * c8) * 33 + nn;
        v4u o; o.x = pk2(s[0 * 33], s[1 * 33]); o.y = pk2(s[2 * 33], s[3 * 33]); o.z = pk2(s[4 * 33], s[5 * 33]); o.w = pk2(s[6 * 33], s[7 * 33]);
        const int row = row_off + n0 + nn;
        *(GAS v4u*)(WT + (size_t)(row >> 8) * ((size_t)256 * K) + (size_t)(kb * 16384 + (row & 255) * 64 + 8 * c8)) = o; }
    LDS_WAIT(); asm volatile("" ::: "memory");
}
__device__ __forceinline__ void sincos_acc(float angf, float& sn_, float& cs_) {
    const double a = (double)angf;
    const double k = __builtin_rint(a * 0.15915494309189535);
    double r = __builtin_fma(-k, 6.283185307179586, a); r = __builtin_fma(-k, 2.4492935982947064e-16, r);
    const double x = r * 0.25, x2 = x * x;
    const double sn = x * (1.0 + x2 * (-1.0 / 6.0 + x2 * (1.0 / 120.0 + x2 * (-1.0 / 5040.0 + x2 * (1.0 / 362880.0 + x2 * (-1.0 / 39916800.0 + x2 * (1.0 / 6227020800.0)))))));
    const double cs = 1.0 + x2 * (-0.5 + x2 * (1.0 / 24.0 + x2 * (-1.0 / 720.0 + x2 * (1.0 / 40320.0 + x2 * (-1.0 / 3628800.0 + x2 * (1.0 / 479001600.0 + x2 * (-1.0 / 87178291200.0)))))));
    const double s2 = 2.0 * sn * cs, c2 = 1.0 - 2.0 * sn * sn;
    const double s4 = 2.0 * s2 * c2, c4 = 1.0 - 2.0 * s2 * s2;
    sn_ = (float)s4; cs_ = (float)c4;
}

__device__ __forceinline__ void p0_prologue(Frame& F, const Params& P) {
    LAS float* scr = (LAS float*)(F.lds + RING_OFF + F.wave * 16384);
    const int gw = F.vcu * NWAVES + F.wave, NGW = F.G * NWAVES;
    bf16* WinT = (bf16*)(F.ws + WS_WIN); bf16* WoaT = (bf16*)(F.ws + WS_WOA); bf16* WobT = (bf16*)(F.ws + WS_WOB); bf16* WkvqT = (bf16*)(F.ws + WS_WKVQ);
    bf16* WupT = (bf16*)(F.ws + WS_WUP); bf16* WdnT = (bf16*)(F.ws + WS_WDN);
    constexpr int I0 = (D / 64) * (NIN_PAD / 32), I1 = (D / 64) * (D / 32), I2 = I1, I3 = (D / 64) * (1024 / 32), I4 = (D / 64) * (6144 / 32), I5 = (D / 64) * (FF / 32), I6 = (FF / 64) * (D / 32);
    constexpr int NITEMS = I0 + I1 + I2 + I3 + I4 + I5 + I6;
    for (int it = gw; it < NITEMS; it += NGW) {
        int r = it;
        if (r < I0) { tr_item(P.in[2], D, NIN, NIN_PAD, P.in[1], WinT, 0, scr, r, F.lane); continue; } r -= I0;
        if (r < I1) { tr_item(P.in[3], D, D, D, nullptr, WoaT, 0, scr, r, F.lane); continue; } r -= I1;
        if (r < I2) { tr_item(P.in[8], D, D, D, nullptr, WobT, 0, scr, r, F.lane); continue; } r -= I2;
        if (r < I3) { tr_item(P.in[5], D, 1024, 1024, P.in[4], WkvqT, 0, scr, r, F.lane); continue; } r -= I3;
        if (r < I4) { tr_item(P.in[7], D, 6144, 6144, P.in[6], WkvqT, 1024, scr, r, F.lane); continue; } r -= I4;
        if (r < I5) { tr_item(P.in[10], D, FF, FF, P.in[9], WupT, 0, scr, r, F.lane); continue; } r -= I5;
        tr_item(P.in[11], FF, D, D, nullptr, WdnT, 0, scr, r, F.lane);
    }
    bf16* hb = (bf16*)(F.ws + WS_HB); pg8::ssq_t* ss = (pg8::ssq_t*)(F.ws + WS_SS);
    for (int m = gw; m < S; m += NGW) {
        const GAS f32x4* xr = (const GAS f32x4*)(P.in[0] + (size_t)m * D) + F.lane;
        f32x4 v[8]; float s = 0.f;
#pragma unroll
        for (int j = 0; j < 8; ++j) { v[j] = xr[64 * j]; s += (v[j].x * v[j].x + v[j].y * v[j].y) + (v[j].z * v[j].z + v[j].w * v[j].w); }
        s = wave_sum(s);
        GAS v2u* o8 = (GAS v2u*)(hb + (size_t)(m >> 8) * (256 * D) + (size_t)((F.lane >> 4) * 16384 + (m & 255) * 64 + 4 * (F.lane & 15)));
#pragma unroll
        for (int j = 0; j < 8; ++j) { v2u w; w.x = pk2(v[j].x, v[j].y); w.y = pk2(v[j].z, v[j].w); o8[(4 * 16384 / 4) * j] = w; }
        if (F.lane == 0) ss[m] = pg8::ss_fix(s);
    }
    { const int gt = gw * 64 + F.lane, NT = NGW * 64; for (int i = gt; i < 4 * S; i += NT) ss[S + i] = 0ull; }
    { float* cosh = (float*)(F.ws + WS_COSH); float* sinh = (float*)(F.ws + WS_SINH); float* cosi = (float*)(F.ws + WS_COSI); float* sini = (float*)(F.ws + WS_SINI);
      const int gt = gw * 64 + F.lane, NT = NGW * 64;
      float ivh = P.invh[0], ivi = P.invi[0];
#pragma unroll
      for (int kk = 1; kk < 16; ++kk) ivh = ((gt & 15) == kk) ? P.invh[kk] : ivh;
#pragma unroll
      for (int kk = 1; kk < 8; ++kk) ivi = ((gt & 7) == kk) ? P.invi[kk] : ivi;
      for (int i = gt; i < S * 16; i += NT) { const int pos = i >> 4; float sn, cs; sincos_acc((float)pos * ivh, sn, cs); cosh[i] = cs; sinh[i] = sn; }
      for (int i = gt; i < S * 8; i += NT) { const int pos = i >> 3; float sn, cs; sincos_acc((float)pos * ivi, sn, cs); cosi[i] = cs; sini[i] = sn; }
    }
}
__device__ __forceinline__ void p7_convert_mlp2(Frame& F, const Params& P) {
    LAS float* scr = (LAS float*)(F.lds + RING_OFF + F.wave * 16384);
    const int gw = F.vcu * NWAVES + F.wave, NGW = F.G * NWAVES;
    bf16* WupT = (bf16*)(F.ws + WS_WUP); bf16* WdnT = (bf16*)(F.ws + WS_WDN);
    constexpr int I5 = (D / 64) * (FF / 32), I6 = (FF / 64) * (D / 32);
    for (int it = gw; it < I5 + I6; it += NGW) {
        int r = it;
        if (r < I5) { tr_item(P.in[10] + (size_t)D * FF, D, FF, FF, P.in[9] + D, WupT, 0, scr, r, F.lane); continue; } r -= I5;
        tr_item(P.in[11] + (size_t)FF * D, FF, D, D, nullptr, WdnT, 0, scr, r, F.lane);
    }
}

__device__ __forceinline__ void p1_kiwi(Frame& F, const float* cosi, const float* sini) {
    const bf16* hb = (const bf16*)(F.ws + WS_HB); const bf16* Wt = (const bf16*)(F.ws + WS_WIN) + (size_t)16 * 256 * D;
    const pg8::ssq_t* ss = (const pg8::ssq_t*)(F.ws + WS_SS); bf16* KI = (bf16*)(F.ws + WS_KI); float* WI = (float*)(F.ws + WS_WI);
    LAS f32x4* red = (LAS f32x4*)(F.lds + RING_OFF);
    const int lane = F.lane, fr = lane & 15, fq = lane >> 4, w = F.wave;
    for (int blk = (int)blockIdx.x; blk < S / 64; blk += F.G) {
        const int row0 = blk * 64;
        const bf16* ap = hb + (size_t)(row0 >> 8) * (256 * D) + (size_t)(((row0 & 255) + fr) * 64 + 8 * fq);
        const bf16* wp = Wt + fr * 64 + 8 * fq;
        f32x4 acc[4][5];
#pragma unroll
        for (int rb = 0; rb < 4; ++rb)
#pragma unroll
            for (int cb = 0; cb < 5; ++cb) acc[rb][cb] = (f32x4){0.f, 0.f, 0.f, 0.f};
        bf16x8 a0[4], b0[5], a1[4], b1[5];
#define KIWI_LOAD(a, b, st) do { const int k = w * 256 + (st) * 32, ko = (k >> 6) * 16384 + (k & 63); _Pragma("unroll") for (int rb = 0; rb < 4; ++rb) a[rb] = *(const bf16x8*)(ap + rb * 1024 + ko); \
            _Pragma("unroll") for (int cb = 0; cb < 5; ++cb) b[cb] = *(const bf16x8*)(wp + cb * 1024 + ko); __builtin_amdgcn_sched_barrier(0); } while (0)
#define KIWI_MMA(a, b) do { _Pragma("unroll") for (int rb = 0; rb < 4; ++rb) _Pragma("unroll") for (int cb = 0; cb < 5; ++cb) acc[rb][cb] = __builtin_amdgcn_mfma_f32_16x16x32_bf16(b[cb], a[rb], acc[rb][cb], 0, 0, 0); \
            __builtin_amdgcn_sched_barrier(0); } while (0)
        KIWI_LOAD(a0, b0, 0);
#pragma unroll 1
        for (int it = 0; it < 4; ++it) {
            KIWI_LOAD(a1, b1, 2 * it + 1); KIWI_MMA(a0, b0);
            if (it < 3) KIWI_LOAD(a0, b0, 2 * it + 2);
            KIWI_MMA(a1, b1);
        }
#undef KIWI_LOAD
#undef KIWI_MMA
#pragma unroll
        for (int r = 0; r < 2; ++r) {
#pragma unroll
            for (int jb = 0; jb < 2; ++jb)
#pragma unroll
                for (int cb = 0; cb < 5; ++cb) red[(w * 10 + jb * 5 + cb) * 64 + lane] = acc[2 * r + jb][cb];
            __syncthreads();
            for (int item = w; item < 10; item += 8) {
                f32x4 v = red[item * 64 + lane];
#pragma unroll
                for (int ww = 1; ww < 8; ++ww) v += red[(ww * 10 + item) * 64 + lane];
                const int jb = item / 5, cb = item - 5 * jb, row = row0 + 16 * (2 * r + jb) + fr;
                const float rs = pg8::rstd_of(ss[row]);
                if (cb < 4) {
                    v = v * rs;
                    if (cb == 0) { const f32x4 c4 = *(const f32x4*)(cosi + (size_t)row * 8 + 4 * (fq & 1)), s4 = *(const f32x4*)(sini + (size_t)row * 8 + 4 * (fq & 1));
                                   f32x4 p; p[0] = __shfl_xor(v[0], 32); p[1] = __shfl_xor(v[1], 32); p[2] = __shfl_xor(v[2], 32); p[3] = __shfl_xor(v[3], 32);
                                   v = (fq < 2) ? (v * c4 - p * s4) : (v * c4 + p * s4); }
                    bf16* dst = KI + ((size_t)(((row >> 5) * 4 + cb) * 32 + (row & 31)) * 2 + (fq >> 1)) * 8 + 4 * (fq & 1);
                    *(pg8::u32x2*)dst = pg8::pack4(v);
                } else {
                    *(f32x4*)(WI + (size_t)row * 16 + 4 * fq) = v * (rs * 0.03125f);
                }
            }
            __syncthreads();
        }
    }
}

constexpr int CAP = 512;
__device__ __forceinline__ unsigned f2ord(float f) { const unsigned u = __float_as_uint(f); return (u & 0x80000000u) ? ~u : (u | 0x80000000u); }
__device__ __forceinline__ float ord2f(unsigned k) { const unsigned u = (k & 0x80000000u) ? (k & 0x7fffffffu) : ~k; return __uint_as_float(u); }
template <int CTRL> __device__ __forceinline__ unsigned dpp_movu(unsigned v) { return (unsigned)__builtin_amdgcn_update_dpp(0u, v, CTRL, 0xf, 0xf, false); }
__device__ __forceinline__ unsigned umax2(unsigned a, unsigned b) { return a > b ? a : b; }
__device__ __forceinline__ unsigned wave_max_u32(unsigned v) {
    v = umax2(v, dpp_movu<0x128>(v)); v = umax2(v, dpp_movu<0x124>(v)); v = umax2(v, dpp_movu<0x122>(v)); v = umax2(v, dpp_movu<0x121>(v));
    { const auto r = __builtin_amdgcn_permlane16_swap(v, v, false, false); v = umax2(r[0], r[1]); }
    { const auto r = __builtin_amdgcn_permlane32_swap(v, v, false, false); v = umax2(r[0], r[1]); }
    return v;
}
template <bool EXACT> __device__ __forceinline__ void topk_select(LAS float* s_, LAS unsigned* i_, int& cnt, float& tau, int lane) {
    const int n = cnt;
    unsigned k[8], ix[8];
#pragma unroll
    for (int j = 0; j < 8; ++j) { const int e = lane + 64 * j; const bool v = e < n; k[j] = v ? f2ord(s_[e]) : 0u; ix[j] = i_[e]; }
    unsigned mxk = k[0], mnk = ~k[0];
#pragma unroll
    for (int j = 1; j < 8; ++j) { mxk = umax2(mxk, k[j]); mnk = umax2(mnk, (lane + 64 * j < n) ? ~k[j] : 0u); }
    mxk = (unsigned)__builtin_amdgcn_readfirstlane((int)wave_max_u32(mxk)); mnk = ~(unsigned)__builtin_amdgcn_readfirstlane((int)wave_max_u32(mnk));
    const unsigned diff = mxk ^ mnk;
    unsigned T = mnk; int need_eq = TOPK;
    if (diff != 0u) {
        const int top = 31 - __builtin_clz(diff);
        T = (top == 31) ? 0u : ((mxk >> (top + 1)) << (top + 1));
        bool coarse_done = false;
        for (int bit = top; bit >= 0; --bit) {
            const unsigned cand = T | (1u << bit);
            int c = 0;
#pragma unroll
            for (int j = 0; j < 8; ++j) c += __popcll(__ballot(k[j] >= cand));
            if (c >= TOPK) { T = cand; if (c == TOPK || (!EXACT && c <= TOPK + 64)) { coarse_done = true; break; } }
        }
        if (!EXACT && coarse_done) need_eq = 1 << 20;
    }
    int ngt = 0;
#pragma unroll
    for (int j = 0; j < 8; ++j) ngt += __popcll(__ballot(k[j] > T));
    if (need_eq == TOPK) need_eq = TOPK - ngt;
    int offg = 0, offe = 0;
    const unsigned long long lm = (1ull << lane) - 1ull;
#pragma unroll
    for (int j = 0; j < 8; ++j) {
        const bool g = k[j] > T, e = k[j] == T;
        const unsigned long long bg = __ballot(g), be = __ballot(e);
        const int pg = offg + __popcll(bg & lm), pe = offe + __popcll(be & lm);
        if (g) { s_[pg] = ord2f(k[j]); i_[pg] = ix[j]; }
        else if (e && pe < need_eq) { s_[ngt + pe] = ord2f(k[j]); i_[ngt + pe] = ix[j]; }
        offg += __popcll(bg); offe += __popcll(be);
    }
    cnt = ngt + (offe < need_eq ? offe : need_eq); tau = ord2f(T);
    LDS_WAIT();
}
__device__ __forceinline__ float relu_f(float x) { const int b = __float_as_int(x); return __int_as_float(b > 0 ? b : 0); }
__device__ __forceinline__ float idx_score(const f32x16& acc, const float (&w)[16]) {
    float sc = 0.f;
#pragma unroll
    for (int i = 0; i < 16; ++i) sc = __builtin_fmaf(w[i], relu_f(acc[i]), sc);
    return sc;
}
__device__ __forceinline__ void idx_tile_tail(float sc, int (&cnt)[2], float (&tau)[2], LAS float* bs, LAS unsigned* bi, int key, int tq0, int r, int hh, int lane) {
    const float mytau = hh ? tau[1] : tau[0];
    const bool pass = (key <= tq0 + hh) && (sc > mytau);
    const unsigned long long mk = __ballot(pass);
    if (mk) {
        const unsigned m0 = (unsigned)mk, m1 = (unsigned)(mk >> 32);
        const unsigned mym = hh ? m1 : m0;
        const int pos = (hh ? cnt[1] : cnt[0]) + __popc(mym & ((1u << r) - 1u));
        if (pass) { bs[hh * CAP + pos] = sc; bi[hh * CAP + pos] = (unsigned)key; }
        cnt[0] += __popc(m0); cnt[1] += __popc(m1);
    }
}
__device__ __forceinline__ void idx_tile_tail2(float s0, float s1, int (&cnt)[2][2], float (&tau)[2][2], LAS float* bs, LAS unsigned* bi, int key, int q0, int r, int hh, int lane) {
    const float t0 = hh ? tau[0][1] : tau[0][0], t1 = hh ? tau[1][1] : tau[1][0];
    const bool p0 = (key <= q0 + hh) && (s0 > t0), p1 = (key <= q0 + 2 + hh) && (s1 > t1);
    const unsigned long long k0 = __ballot(p0), k1 = __ballot(p1);
    if (k0 | k1) {
        const unsigned a0 = (unsigned)k0, a1 = (unsigned)(k0 >> 32), b0 = (unsigned)k1, b1 = (unsigned)(k1 >> 32);
        const int na0 = __popc(a0), na1 = __popc(a1), nb0 = __popc(b0), nb1 = __popc(b1);
        const int pa = (int)__builtin_amdgcn_mbcnt_hi(a1, __builtin_amdgcn_mbcnt_lo(a0, 0u)) - (hh ? na0 : 0) + (hh ? cnt[0][1] : cnt[0][0]);
        const int pb = (int)__builtin_amdgcn_mbcnt_hi(b1, __builtin_amdgcn_mbcnt_lo(b0, 0u)) - (hh ? nb0 : 0) + (hh ? cnt[1][1] : cnt[1][0]);
        if (p0) { bs[hh * CAP + pa] = s0; bi[hh * CAP + pa] = (unsigned)key; }
        if (p1) { bs[(2 + hh) * CAP + pb] = s1; bi[(2 + hh) * CAP + pb] = (unsigned)key; }
        cnt[0][0] += na0; cnt[0][1] += na1; cnt[1][0] += nb0; cnt[1][1] += nb1;
    }
}
template <bool EXACT> __device__ __forceinline__ void idx_reselect(int (&cnt)[2][2], float (&tau)[2][2], LAS float* bs, LAS unsigned* bi, int limit, int lane) {
#pragma unroll 1
    for (int qs = 0; qs < 4; ++qs) {
        int c = qs == 0 ? cnt[0][0] : (qs == 1 ? cnt[0][1] : (qs == 2 ? cnt[1][0] : cnt[1][1]));
        if (c > limit) {
            float t = 0.f;
            topk_select<EXACT>(bs + qs * CAP, bi + qs * CAP, c, t, lane);
            cnt[0][0] = qs == 0 ? c : cnt[0][0]; cnt[0][1] = qs == 1 ? c : cnt[0][1]; cnt[1][0] = qs == 2 ? c : cnt[1][0]; cnt[1][1] = qs == 3 ? c : cnt[1][1];
            tau[0][0] = qs == 0 ? t : tau[0][0]; tau[0][1] = qs == 1 ? t : tau[0][1]; tau[1][0] = qs == 2 ? t : tau[1][0]; tau[1][1] = qs == 3 ? t : tau[1][1];
        }
    }
}
template <int PMODE> __device__ __forceinline__ void p2_indexer(Frame& F) {
    const bf16* QI = (const bf16*)(F.ws + WS_QI); const bf16* KI = (const bf16*)(F.ws + WS_KI); const float* WI = (const float*)(F.ws + WS_WI);
    unsigned short* sel = (unsigned short*)(F.ws + WS_SEL);
    const int lane = F.lane, r = lane & 31, hh = lane >> 5;
    LAS float* bs = (LAS float*)(F.lds + RING_OFF + F.wave * 16384);
    LAS unsigned* bi = (LAS unsigned*)(F.lds + RING_OFF + F.wave * 16384 + 8192);
    const int gw = F.vcu * NWAVES + F.wave, NGW = F.G * NWAVES;
    constexpr int NT = S / 4;
    for (int it = 0;; ++it) {
        const int kk = it * NGW + ((it & 1) ? (NGW - 1 - gw) : gw);
        if (it * NGW >= NT) break;
        if (kk >= NT) continue;
        const int task = NT - 1 - kk, q0 = task * 4;
        bf16x8 Af[2][4]; float w[2][16];
#pragma unroll
        for (int pi = 0; pi < 2; ++pi) {
            const int qa = q0 + 2 * pi + ((r >> 2) & 1), head = (r & 3) + 4 * (r >> 3);
#pragma unroll
            for (int ks = 0; ks < 4; ++ks) Af[pi][ks] = *(const bf16x8*)(QI + pg8::tm_off(qa, head * 64 + 16 * ks + 8 * hh, 1024));
#pragma unroll
            for (int i = 0; i < 4; ++i) { const f32x4 t = *(const f32x4*)(WI + (size_t)(q0 + 2 * pi + hh) * 16 + 4 * i); w[pi][4 * i] = t[0]; w[pi][4 * i + 1] = t[1]; w[pi][4 * i + 2] = t[2]; w[pi][4 * i + 3] = t[3]; }
        }
        int cnt[2][2] = {{0, 0}, {0, 0}}; float tau[2][2];
        tau[0][0] = tau[0][1] = tau[1][0] = tau[1][1] = -__builtin_inff();
        const int ntile = (q0 + 3) / 32 + 1;
        const bf16* kb = KI + (size_t)(r * 2 + hh) * 8;
        bf16x8 Bf[4];
#define P2_LOADB(t_) do { const int tc_ = (t_) < ntile ? (t_) : ntile - 1; const bf16* kn_ = kb + (size_t)tc_ * 2048; \
            _Pragma("unroll") for (int ks = 0; ks < 4; ++ks) Bf[ks] = *(const bf16x8*)(kn_ + ks * 512); } while (0)
#define P2_MFMA(x0_, x1_) do { _Pragma("unroll") for (int i = 0; i < 16; ++i) { x0_[i] = 0.f; x1_[i] = 0.f; } \
            _Pragma("unroll") for (int ks = 0; ks < 4; ++ks) x0_ = __builtin_amdgcn_mfma_f32_32x32x16_bf16(Af[0][ks], Bf[ks], x0_, 0, 0, 0); \
            _Pragma("unroll") for (int ks = 0; ks < 4; ++ks) x1_ = __builtin_amdgcn_mfma_f32_32x32x16_bf16(Af[1][ks], Bf[ks], x1_, 0, 0, 0); } while (0)
#define P2_TAIL(x0_, x1_, t_) do { const int key = (t_) * 32 + r; \
            if (PMODE == 0) { const float s0 = idx_score(x0_, w[0]), s1 = idx_score(x1_, w[1]); \
                idx_tile_tail2(s0, s1, cnt, tau, bs, bi, key, q0, r, hh, lane); \
                if ((cnt[0][0] > CAP - 32) | (cnt[0][1] > CAP - 32) | (cnt[1][0] > CAP - 32) | (cnt[1][1] > CAP - 32)) idx_reselect<false>(cnt, tau, bs, bi, CAP - 32, lane); } \
            else if (PMODE == 1) { const float s0 = idx_score(x0_, w[0]), s1 = idx_score(x1_, w[1]); asm volatile("" :: "v"(s0), "v"(s1), "v"(key)); } \
            else { asm volatile("" :: "v"(x0_[0]), "v"(x1_[0]), "v"(x0_[15]), "v"(x1_[15]), "v"(key)); } } while (0)
        f32x16 a0, a1, b0, b1;
        P2_LOADB(0); P2_MFMA(a0, a1); P2_LOADB(1);
        for (int tile = 0; tile < ntile; tile += 2) {
            P2_MFMA(b0, b1); P2_LOADB(tile + 2);
            P2_TAIL(a0, a1, tile);
            if (tile + 1 >= ntile) break;
            P2_MFMA(a0, a1); P2_LOADB(tile + 3);
            P2_TAIL(b0, b1, tile + 1);
        }
#undef P2_LOADB
#undef P2_MFMA
#undef P2_TAIL
        if (PMODE == 0) {
            idx_reselect<true>(cnt, tau, bs, bi, TOPK, lane);
            LDS_WAIT();
#pragma unroll 1
            for (int qs = 0; qs < 4; ++qs) {
                const int n = qs == 0 ? cnt[0][0] : (qs == 1 ? cnt[0][1] : (qs == 2 ? cnt[1][0] : cnt[1][1]));
#pragma unroll
                for (int j = 0; j < 4; ++j) { const int e = lane + 64 * j; if (e < n) sel[(size_t)(q0 + qs) * TOPK + e] = (unsigned short)bi[qs * CAP + e]; }
            }
        }
        LDS_WAIT();
    }
}

__device__ __forceinline__ long pk_long(unsigned lo, unsigned hi) { return (long)(((unsigned long long)hi << 32) | (unsigned long long)lo); }
typedef int v2i __attribute__((ext_vector_type(2)));
__device__ __forceinline__ void p3_sparse_fp8(Frame& F) {
    const unsigned char* Qp = F.ws + WS_QA; const unsigned char* K8 = F.ws + WS_KA; const unsigned char* V8 = F.ws + WS_VA;
    const unsigned short* sel = (const unsigned short*)(F.ws + WS_SEL); bf16* Op = (bf16*)(F.ws + WS_OA);
    LAS float* Pt = (LAS float*)(F.lds + RING_OFF + F.wave * 16384);
    LAS unsigned* Sl = (LAS unsigned*)(F.lds + RING_OFF + F.wave * 16384 + 4096);
    LAS unsigned char* Kst = F.lds + RING_OFF + F.wave * 16384 + 8192;
    const int lane = F.lane, c16 = lane & 15, kg = lane >> 4, e8 = lane >> 3, ch = lane & 7;
    const int gw = F.vcu * NWAVES + F.wave, NGW = F.G * NWAVES;
    const float scale = 0.08838834764831845f * 1.4426950408889634f;
    unsigned short selv[4]; v4u qv[2];
    { const int task = gw; if (task < 4 * S) { const int g = task / S, t = task - g * S;
#pragma unroll
        for (int i = 0; i < 4; ++i) selv[i] = sel[(size_t)t * TOPK + lane + 64 * i];
        { const unsigned char* q8 = Qp + pg8::tm_off(t, (4 * g + (c16 & 3)) * 128 + 32 * kg, 2048); qv[0] = *(const GAS v4u*)q8; qv[1] = *(const GAS v4u*)(q8 + 16); } } }
    for (int task = gw; task < 4 * S; task += NGW) {
        const int g = task / S, t = task - g * S;
        const int n = t + 1 < TOPK ? t + 1 : TOPK;
#pragma unroll
        for (int i = 0; i < 4; ++i) { const int e = lane + 64 * i; Sl[e] = e < n ? (unsigned)selv[i] : 0x80000000u; }
        long Aq[4];
        Aq[0] = (c16 < 4) ? pk_long(qv[0].x, qv[0].y) : 0l; Aq[1] = (c16 < 4) ? pk_long(qv[0].z, qv[0].w) : 0l;
        Aq[2] = (c16 < 4) ? pk_long(qv[1].x, qv[1].y) : 0l; Aq[3] = (c16 < 4) ? pk_long(qv[1].z, qv[1].w) : 0l;
        LDS_WAIT();
        const unsigned char* kb2 = K8 + (size_t)g * S * 128 + 16 * ch;
        const unsigned char* vb2 = V8 + (size_t)g * S * 128 + 16 * ch;
        float mx[4] = {-__builtin_inff(), -__builtin_inff(), -__builtin_inff(), -__builtin_inff()};
#pragma unroll
        for (int half = 0; half < 2; ++half) {
            v4u kq[16];
#pragma unroll
            for (int u = 0; u < 16; ++u) { const unsigned pos = Sl[128 * half + 8 * u + e8] & 0x7fffffffu; kq[u] = *(const GAS v4u*)(kb2 + (size_t)pos * 128); }
            __builtin_amdgcn_sched_barrier(0);
#pragma unroll
            for (int r2 = 0; r2 < 2; ++r2) {
#pragma unroll
                for (int uu = 0; uu < 8; ++uu) { const int ksl = 8 * uu + e8; *(LAS v4u*)(Kst + ksl * 128 + 16 * (ch ^ ((ksl >> 1) & 7))) = kq[8 * r2 + uu]; }
#pragma unroll
                for (int g4 = 0; g4 < 4; ++g4) {
                    const int ksl = 16 * g4 + c16, e = 128 * half + 64 * r2 + ksl, f = (ksl >> 1) & 7;
                    const v4u k0 = *(const LAS v4u*)(Kst + ksl * 128 + 16 * ((2 * kg) ^ f)), k1 = *(const LAS v4u*)(Kst + ksl * 128 + 16 * ((2 * kg + 1) ^ f));
                    const bool valid = (Sl[e] >> 31) == 0u;
                    f32x4 a = (f32x4){0.f, 0.f, 0.f, 0.f};
                    a = __builtin_amdgcn_mfma_f32_16x16x32_fp8_fp8(Aq[0], pk_long(k0.x, k0.y), a, 0, 0, 0);
                    a = __builtin_amdgcn_mfma_f32_16x16x32_fp8_fp8(Aq[1], pk_long(k0.z, k0.w), a, 0, 0, 0);
                    a = __builtin_amdgcn_mfma_f32_16x16x32_fp8_fp8(Aq[2], pk_long(k1.x, k1.y), a, 0, 0, 0);
                    a = __builtin_amdgcn_mfma_f32_16x16x32_fp8_fp8(Aq[3], pk_long(k1.z, k1.w), a, 0, 0, 0);
#pragma unroll
                    for (int j = 0; j < 4; ++j) { const float sv = valid ? a[j] * scale : -__builtin_inff(); mx[j] = __builtin_fmaxf(mx[j], sv); if (kg == 0) Pt[j * 256 + e] = sv; }
                }
            }
            __builtin_amdgcn_sched_barrier(0);
        }
        v4u vA[8], vB[8];
#pragma unroll
        for (int u = 0; u < 8; ++u) { const unsigned pos = Sl[8 * u + e8] & 0x7fffffffu; vA[u] = *(const GAS v4u*)(vb2 + (size_t)pos * 128); }
#pragma unroll
        for (int j = 0; j < 4; ++j) {
            float v = mx[j];
            mx[j] = bcast_row0(row_max16(v));
        }
        LDS_WAIT();
        float sum[4] = {0.f, 0.f, 0.f, 0.f};
#pragma unroll
        for (int j = 0; j < 4; ++j)
#pragma unroll
            for (int i = 0; i < 4; ++i) {
                const int e = lane + 64 * i;
                const float pr = __builtin_amdgcn_exp2f(Pt[j * 256 + e] - mx[j] + 8.0f);
                sum[j] += pr; Pt[j * 256 + e] = pr;
            }
#pragma unroll
        for (int j = 0; j < 4; ++j) sum[j] = wave_sum(sum[j]);
        { const int tn = task + NGW; if (tn < 4 * S) { const int g2 = tn / S, t2 = tn - g2 * S;
#pragma unroll
            for (int i = 0; i < 4; ++i) selv[i] = sel[(size_t)t2 * TOPK + lane + 64 * i];
            { const unsigned char* q8 = Qp + pg8::tm_off(t2, (4 * g2 + (c16 & 3)) * 128 + 32 * kg, 2048); qv[0] = *(const GAS v4u*)q8; qv[1] = *(const GAS v4u*)(q8 + 16); } } }
        LDS_WAIT();
        f32x4 oacc[8];
#pragma unroll
        for (int dt = 0; dt < 8; ++dt) oacc[dt] = (f32x4){0.f, 0.f, 0.f, 0.f};
#pragma unroll
        for (int c4 = 0; c4 < 4; ++c4) {
#pragma unroll
            for (int uu = 0; uu < 8; ++uu) { const int ksl = 8 * uu + e8; *(LAS v4u*)(Kst + ksl * 128 + 16 * (ch ^ ((ksl >> 1) & 7))) = (c4 & 1) ? vB[uu] : vA[uu]; }
            if (c4 < 3) {
#pragma unroll
                for (int u = 0; u < 8; ++u) { const unsigned pos = Sl[64 * (c4 + 1) + 8 * u + e8] & 0x7fffffffu; const v4u vv = *(const GAS v4u*)(vb2 + (size_t)pos * 128); if (c4 & 1) vA[u] = vv; else vB[u] = vv; }
            }
#pragma unroll
            for (int ks2 = 0; ks2 < 2; ++ks2) {
                const LAS float* pp = Pt + (c16 & 3) * 256 + 64 * c4 + 32 * ks2 + 8 * kg;
                const f32x4 p0 = *(const LAS f32x4*)pp, p1 = *(const LAS f32x4*)(pp + 4);
                int w0 = __builtin_amdgcn_cvt_pk_fp8_f32(p0[0], p0[1], 0, false); w0 = __builtin_amdgcn_cvt_pk_fp8_f32(p0[2], p0[3], w0, true);
                int w1 = __builtin_amdgcn_cvt_pk_fp8_f32(p1[0], p1[1], 0, false); w1 = __builtin_amdgcn_cvt_pk_fp8_f32(p1[2], p1[3], w1, true);
                const long Ap = (c16 < 4) ? pk_long((unsigned)w0, (unsigned)w1) : 0l;
                const int ksl = 32 * ks2 + 8 * kg + (c16 >> 1), f = (ksl >> 1) & 7;
                const LAS unsigned char* vrow = Kst + ksl * 128 + 8 * (c16 & 1);
#pragma unroll
                for (int dt = 0; dt < 8; ++dt) {
                    const v2i bv = __builtin_amdgcn_ds_read_tr8_b64_v2i32((LAS v2i*)(vrow + 16 * (dt ^ f)));
                    oacc[dt] = __builtin_amdgcn_mfma_f32_16x16x32_fp8_fp8(Ap, pk_long((unsigned)bv.x, (unsigned)bv.y), oacc[dt], 0, 0, 0);
                }
            }
        }
        LDS_WAIT();
        if (kg == 0) {
#pragma unroll
            for (int j = 0; j < 4; ++j) { const float inv = 1.0f / sum[j];
#pragma unroll
                for (int dt = 0; dt < 8; ++dt) Pt[j * 128 + 16 * dt + c16] = oacc[dt][j] * inv; }
        }
        LDS_WAIT();
        { const LAS float* op = Pt + (lane >> 4) * 128 + 8 * (lane & 15);
          const f32x4 a = *(const LAS f32x4*)op, b = *(const LAS f32x4*)(op + 4);
          v4u w; w.x = pk2(a[0], a[1]); w.y = pk2(a[2], a[3]); w.z = pk2(b[0], b[1]); w.w = pk2(b[2], b[3]);
          *(GAS v4u*)(Op + ktm_off(t, (4 * g + (lane >> 4)) * 128 + 8 * (lane & 15))) = w; }
        LDS_WAIT();
    }
}

constexpr size_t KC8_BYTES = (size_t)4 * 512 * 4096;
__device__ __forceinline__ unsigned pk4_fp8(float a, float b, float c, float d) { int w = __builtin_amdgcn_cvt_pk_fp8_f32(a, b, 0, false); return (unsigned)__builtin_amdgcn_cvt_pk_fp8_f32(c, d, w, true); }
__device__ __forceinline__ float bfu(unsigned short v) { return __uint_as_float(((unsigned)v) << 16); }
__device__ __forceinline__ void p8_kv_copies(Frame& F) {
    const bf16* Ks = (const bf16*)(F.ws + WS_KS); const bf16* Vs = (const bf16*)(F.ws + WS_VS);
    LAS unsigned short* scr = (LAS unsigned short*)(F.lds + RING_OFF + F.wave * 16384);
    const int gw = F.vcu * NWAVES + F.wave, NGW = F.G * NWAVES, lane = F.lane;
    constexpr int NITEM = 3 * 4 * (S / 32);
    for (int it = gw; it < NITEM; it += NGW) {
        const int tile = it & 511, kh = (it >> 9) & 3, g = it >> 11;
        const int sh = 2 * g, per = S >> sh;
        const int idx0 = tile * 32, rho = idx0 / per, kap0 = idx0 - rho * per;
        unsigned char* Kc = F.outb + (size_t)g * KC8_BYTES + (size_t)(kh * 512 + tile) * 4096;
        unsigned char* Vc = F.ws + (g == 0 ? WS_VT0 : (g == 1 ? WS_VT1 : WS_VT2)) + (size_t)(kh * 512 + tile) * 4096;
#pragma unroll
        for (int q = 0; q < 8; ++q) {
            const int ch = q * 64 + lane, key = ch >> 4, cc = ch & 15;
            const int pos = rho + ((kap0 + key) << sh);
            const v4u kv = *(const GAS v4u*)(Ks + pg8::tm_off(pos, kh * 128 + 8 * cc, 512));
            const v4u vv = *(const GAS v4u*)(Vs + pg8::tm_off(pos, kh * 128 + 8 * cc, 512));
            *(LAS v4u*)(scr + key * 128 + 8 * cc) = kv;
            *(LAS v4u*)(scr + 4096 + key * 128 + 8 * cc) = vv;
        }
        LDS_WAIT(); asm volatile("" ::: "memory");
#pragma unroll
        for (int q = 0; q < 4; ++q) {
            const int co = q * 64 + lane;
            { const int hh = co & 1, key = (co >> 1) & 31, ksp = co >> 6;
              const LAS unsigned short* s0 = scr + key * 128 + 32 * ksp + 8 * hh;
              v4u w; w.x = pk4_fp8(bfu(s0[0]), bfu(s0[1]), bfu(s0[2]), bfu(s0[3])); w.y = pk4_fp8(bfu(s0[4]), bfu(s0[5]), bfu(s0[6]), bfu(s0[7]));
              w.z = pk4_fp8(bfu(s0[16]), bfu(s0[17]), bfu(s0[18]), bfu(s0[19])); w.w = pk4_fp8(bfu(s0[20]), bfu(s0[21]), bfu(s0[22]), bfu(s0[23]));
              *(GAS v4u*)(Kc + 16 * co) = w; }
            { const int hh = co & 1, dimt = (co >> 1) & 31, dt = co >> 6, dim = 32 * dt + dimt;
              float e[16];
#pragma unroll
              for (int s2 = 0; s2 < 2; ++s2)
#pragma unroll
                  for (int j = 0; j < 8; ++j) e[8 * s2 + j] = bfu(scr[4096 + (16 * s2 + 8 * (j >> 2) + 4 * hh + (j & 3)) * 128 + dim]);
              v4u w; w.x = pk4_fp8(e[0], e[1], e[2], e[3]); w.y = pk4_fp8(e[4], e[5], e[6], e[7]); w.z = pk4_fp8(e[8], e[9], e[10], e[11]); w.w = pk4_fp8(e[12], e[13], e[14], e[15]);
              *(GAS v4u*)(Vc + 16 * co) = w; }
        }
        LDS_WAIT(); asm volatile("" ::: "memory");
    }
}

__device__ __forceinline__ void p9_dilated_dense(Frame& F) {
    const unsigned char* Q2 = F.ws + WS_Q2; bf16* O2 = (bf16*)(F.ws + WS_O2);
    const int lane = F.lane, ar = lane & 31, h = lane >> 5, qi = ar >> 2, rep = ar & 3;
    const int gw = F.vcu * NWAVES + F.wave, NGW = F.G * NWAVES;
    const float scale = 0.08838834764831845f * 1.4426950408889634f;
    for (int uid = gw; uid < 8192; uid += NGW) {
        const int c = uid & 15, b = (uid >> 4) & 127, kh = uid >> 11;
        const int t = c + 16 * (8 * b + qi);
        f32x16 O[4];
#pragma unroll
        for (int dt = 0; dt < 4; ++dt)
#pragma unroll
            for (int i = 0; i < 16; ++i) O[dt][i] = 0.f;
        float m = -1e30f, l = 0.f;
#pragma unroll 1
        for (int g = 0; g < 3; ++g) {
            const int sh = 2 * g, per = S >> sh;
            const int rho = (g == 0) ? 0 : ((g == 1) ? (c & 3) : c);
            const int tau = (t - rho) >> sh;
            const int wlo = tau > 128 ? tau - 128 : 0; const unsigned wrng = (unsigned)(tau - wlo);
            const int tau0 = (c + 128 * b - rho) >> sh, tau7 = tau0 + 7 * (16 >> sh);
            const int full_lo = tau7 > 128 ? tau7 - 128 : 0, full_hi = tau0;
            const int kap0 = (g == 0) ? (128 * b - 128) : ((g == 1) ? (32 * b - 128) : ((8 * b - 128) & ~31));
            const int ntile = (g == 0) ? 8 : 5;
            const int tmax = (per >> 5) - 1;
            const unsigned char* Kc = F.outb + (size_t)g * KC8_BYTES + ((size_t)kh * 512 + (size_t)rho * (per >> 5)) * 4096 + (ar * 2 + h) * 16;
            const unsigned char* Vc = F.ws + (g == 0 ? WS_VT0 : (g == 1 ? WS_VT1 : WS_VT2)) + ((size_t)kh * 512 + (size_t)rho * (per >> 5)) * 4096 + (ar * 2 + h) * 16;
            long Qf[8];
            { const unsigned char* qp = Q2 + pg8::tm_off(t, (g * 16 + 4 * kh + rep) * 128 + 8 * h, 6144);
#pragma unroll
              for (int ks = 0; ks < 8; ++ks) Qf[ks] = *(const GAS long*)(qp + 16 * ks); }
            const int tt0 = kap0 >= -31 ? 0 : ((-31 - kap0) + 31) / 32;
            v4u K0[4], V0[4], K1[4], V1[4], K2[4], V2[4]; long Pf[2]; f32x16 acc;
#define P9_GLD(dst_, ptr_, off_) asm volatile("global_load_dwordx4 %0, %1, off offset:" #off_ : "=v"(dst_) : "v"(ptr_) : "memory")
#define P9_LOAD(KF_, VF_, tt_) do { int ti_ = (kap0 + 32 * (tt_)) >> 5; ti_ = ti_ < 0 ? 0 : (ti_ > tmax ? tmax : ti_); const unsigned char* kp_ = Kc + (size_t)ti_ * 4096; const unsigned char* vp_ = Vc + (size_t)ti_ * 4096; \
                P9_GLD(KF_[0], kp_, 0); P9_GLD(KF_[1], kp_, 1024); P9_GLD(KF_[2], kp_, 2048); P9_GLD(KF_[3], kp_, 3072); P9_GLD(VF_[0], vp_, 0); P9_GLD(VF_[1], vp_, 1024); P9_GLD(VF_[2], vp_, 2048); P9_GLD(VF_[3], vp_, 3072); } while (0)
#define P9_WAIT(KF_, VF_) do { asm volatile("s_waitcnt vmcnt(16)" : "+v"(KF_[0]), "+v"(KF_[1]), "+v"(KF_[2]), "+v"(KF_[3]), "+v"(VF_[0]), "+v"(VF_[1]), "+v"(VF_[2]), "+v"(VF_[3]) :: "memory"); __builtin_amdgcn_sched_barrier(0); } while (0)
#define P9_BODY(KF_, VF_, tt_) do { \
                _Pragma("unroll") for (int i = 0; i < 16; ++i) acc[i] = 0.f; \
                _Pragma("unroll") for (int kp2 = 0; kp2 < 4; ++kp2) { acc = __builtin_amdgcn_mfma_f32_32x32x16_fp8_fp8(pk_long(KF_[kp2].x, KF_[kp2].y), Qf[2 * kp2], acc, 0, 0, 0); \
                    acc = __builtin_amdgcn_mfma_f32_32x32x16_fp8_fp8(pk_long(KF_[kp2].z, KF_[kp2].w), Qf[2 * kp2 + 1], acc, 0, 0, 0); } \
                const int kt = kap0 + 32 * (tt_); float mloc = -__builtin_inff(); \
                if (!(kt >= full_lo && kt + 31 <= full_hi)) {            \
                    const unsigned dbase = (unsigned)(kt + 4 * h - wlo); \
                    _Pragma("unroll") for (int i = 0; i < 16; ++i) acc[i] = (dbase + (unsigned)((i & 3) + 8 * (i >> 2)) <= wrng) ? acc[i] : -__builtin_inff(); } \
                _Pragma("unroll") for (int i = 0; i < 16; ++i) mloc = __builtin_fmaxf(mloc, acc[i]); \
                mloc = swap32_max(mloc) * scale;                         \
                const float mnew = __builtin_fmaxf(m, mloc); const float alpha = __builtin_amdgcn_exp2f(m - mnew); const float off = 8.0f - mnew; float ls = 0.f; \
                _Pragma("unroll") for (int i = 0; i < 16; ++i) { acc[i] = __builtin_amdgcn_exp2f(__builtin_fmaf(acc[i], scale, off)); ls += acc[i]; } \
                ls = swap32_sum(ls); l = l * alpha + ls; m = mnew; \
                _Pragma("unroll") for (int dt = 0; dt < 4; ++dt) _Pragma("unroll") for (int i = 0; i < 16; ++i) O[dt][i] *= alpha; \
                _Pragma("unroll") for (int s2 = 0; s2 < 2; ++s2) Pf[s2] = pk_long(pk4_fp8(acc[8 * s2 + 0], acc[8 * s2 + 1], acc[8 * s2 + 2], acc[8 * s2 + 3]), pk4_fp8(acc[8 * s2 + 4], acc[8 * s2 + 5], acc[8 * s2 + 6], acc[8 * s2 + 7])); \
                _Pragma("unroll") for (int dt = 0; dt < 4; ++dt) { O[dt] = __builtin_amdgcn_mfma_f32_32x32x16_fp8_fp8(pk_long(VF_[dt].x, VF_[dt].y), Pf[0], O[dt], 0, 0, 0); \
                    O[dt] = __builtin_amdgcn_mfma_f32_32x32x16_fp8_fp8(pk_long(VF_[dt].z, VF_[dt].w), Pf[1], O[dt], 0, 0, 0); } } while (0)
            asm volatile("" : "+v"(Qf[0]), "+v"(Qf[1]), "+v"(Qf[2]), "+v"(Qf[3]), "+v"(Qf[4]), "+v"(Qf[5]), "+v"(Qf[6]), "+v"(Qf[7]) :: "memory");
            P9_LOAD(K0, V0, tt0); P9_LOAD(K1, V1, tt0 + 1); P9_LOAD(K2, V2, tt0 + 2);
            for (int tt = tt0; tt < ntile; tt += 3) {
                P9_WAIT(K0, V0); P9_BODY(K0, V0, tt); P9_LOAD(K0, V0, tt + 3);
                if (tt + 1 >= ntile) break;
                P9_WAIT(K1, V1); P9_BODY(K1, V1, tt + 1); P9_LOAD(K1, V1, tt + 4);
                if (tt + 2 >= ntile) break;
                P9_WAIT(K2, V2); P9_BODY(K2, V2, tt + 2); P9_LOAD(K2, V2, tt + 5);
            }
            asm volatile("s_waitcnt vmcnt(0)" : "+v"(K0[0]), "+v"(K0[1]), "+v"(K0[2]), "+v"(K0[3]), "+v"(V0[0]), "+v"(V0[1]), "+v"(V0[2]), "+v"(V0[3]), "+v"(K1[0]), "+v"(K1[1]), "+v"(K1[2]), "+v"(K1[3]),
                         "+v"(V1[0]), "+v"(V1[1]), "+v"(V1[2]), "+v"(V1[3]), "+v"(K2[0]), "+v"(K2[1]), "+v"(K2[2]), "+v"(K2[3]), "+v"(V2[0]), "+v"(V2[1]), "+v"(V2[2]), "+v"(V2[3]) :: "memory");
#undef P9_GLD
#undef P9_LOAD
#undef P9_WAIT
#undef P9_BODY
        }
        const float inv = 1.0f / l;
        bf16* op = O2 + ktm_off(t, (4 * kh + rep) * 128 + 4 * h);
#pragma unroll
        for (int dt = 0; dt < 4; ++dt)
#pragma unroll
            for (int q = 0; q < 4; ++q) {
                v2u w; w.x = pg8::cvt_pk_bf16(O[dt][4 * q] * inv, O[dt][4 * q + 1] * inv); w.y = pg8::cvt_pk_bf16(O[dt][4 * q + 2] * inv, O[dt][4 * q + 3] * inv);
                *(GAS v2u*)(op + (dt >> 1) * 16384 + 32 * (dt & 1) + 8 * q) = w;
            }
    }
}

__device__ __forceinline__ void p13_final(Frame& F, const Params& P) {
    const int gw = F.vcu * NWAVES + F.wave, NGW = F.G * NWAVES;
    const pg8::ssq_t* ss4 = (const pg8::ssq_t*)(F.ws + WS_SS) + 4 * S; const float* gn = P.in[12]; const bf16* hb = (const bf16*)(F.ws + WS_HB);
    f32x4 gv[4][2];
#pragma unroll
    for (int j = 0; j < 4; ++j) { gv[j][0] = *((const f32x4*)gn + 2 * (F.lane + 64 * j)); gv[j][1] = *((const f32x4*)gn + 2 * (F.lane + 64 * j) + 1); }
    for (int m = gw; m < S; m += NGW) {
        const float rs = pg8::rstd_of(ss4[m]);
        const GAS v4u* hr = (const GAS v4u*)(hb + (size_t)(m >> 8) * (256 * D) + (size_t)((F.lane >> 3) * 16384 + (m & 255) * 64 + 8 * (F.lane & 7)));
        GAS f32x4* xr = (GAS f32x4*)(P.out + (size_t)m * D);
#pragma unroll
        for (int j = 0; j < 4; ++j) {
            const v4u v = hr[(8 * 16384 / 8) * j];
            const f32x4 lo = (f32x4){__uint_as_float(v.x << 16), __uint_as_float(v.x & 0xffff0000u), __uint_as_float(v.y << 16), __uint_as_float(v.y & 0xffff0000u)};
            const f32x4 hi = (f32x4){__uint_as_float(v.z << 16), __uint_as_float(v.z & 0xffff0000u), __uint_as_float(v.w << 16), __uint_as_float(v.w & 0xffff0000u)};
            xr[2 * (F.lane + 64 * j)] = lo * rs * gv[j][0]; xr[2 * (F.lane + 64 * j) + 1] = hi * rs * gv[j][1];
        }
    }
}


__global__ void __launch_bounds__(NWAVES * 64, 2) yoco_fwd(Params P) {
    extern __shared__ __attribute__((aligned(16))) unsigned char lds[];
    Frame F;
    F.lds = (LAS unsigned char*)lds;
    F.tid = threadIdx.x; F.lane = F.tid & 63; F.wave = __builtin_amdgcn_readfirstlane(F.tid >> 6);
    F.G = gridDim.x; { const int bx = blockIdx.x; F.vcu = (F.G % 8 == 0) ? (bx % 8) * (F.G / 8) + bx / 8 : bx; }
    F.ws = P.ws; F.outb = (unsigned char*)P.out;
    volatile LAS unsigned* MISC = (volatile LAS unsigned*)(F.lds + MISC_OFF);
    for (int u = F.tid; u < (LDS_BYTES - LDSCTL_OFF) / 4; u += NWAVES * 64) ((LAS unsigned*)(F.lds + LDSCTL_OFF))[u] = 0u;
    __syncthreads();
    const int lo = P.ph_lo, hi = P.ph_hi;
    const bool multi = (hi - lo) > 1;
    XcdBarrier bar; bar.bar = (unsigned*)(P.ws + WS_CTL) + CW_BAR; bar.x = 0; bar.st = nullptr;
    if (multi) bar = xcd_barrier_post((unsigned*)(P.ws + WS_CTL) + CW_BAR, MISC + 8);
#define IN(k) (lo <= (k) && (k) < hi)
#define BOTH(k) (IN(k) && IN((k) + 1))
#define GRID_BAR(k) do { if (BOTH(k)) xcd_barrier(bar); } while (0)
#ifndef PROBE_MASK
#define PROBE_MASK 0
#endif
#define REP(k) _Pragma("unroll") for (int rep_ = 0; rep_ < ((((PROBE_MASK) >> (k)) & 1) ? 2 : 1); ++rep_)
    unsigned char* ws = P.ws;
    pg8::ssq_t* ss = (pg8::ssq_t*)(ws + WS_SS);
    const float* cosh = (const float*)(ws + WS_COSH); const float* sinh = (const float*)(ws + WS_SINH);
    const float* cosi = (const float*)(ws + WS_COSI); const float* sini = (const float*)(ws + WS_SINI);
    bf16* hb = (bf16*)(ws + WS_HB);
    const int bx = (int)blockIdx.x;

    if (IN(0)) { REP(0) { p0_prologue(F, P); } GRID_BAR(0); }
    if (IN(1)) {
        pg8::Gemm g{hb, (const bf16*)(ws + WS_WIN), S, 4096, D}; pg8::StaticOrder So; So.init(S, 4096, F.G, bx);
        pg8::EpiIn E{ss, cosh, sinh, cosi, sini, (bf16*)(ws + WS_QA), (bf16*)(ws + WS_KA), (bf16*)(ws + WS_VA), (bf16*)(ws + WS_QI), (bf16*)(ws + WS_KI), (float*)(ws + WS_WI)};
        REP(1) { p1_kiwi(F, cosi, sini); pg8::gemm_phase<pg8::EpiIn, pg8::StaticOrder, true, true, true>(F.lds + RING_OFF, g, So, E); }
        GRID_BAR(1);
    }
    if (IN(2)) {
        REP(2) { p2_indexer<0>(F); } GRID_BAR(2); }
    if (IN(3)) { REP(3) { p3_sparse_fp8(F); } GRID_BAR(3); }
    if (IN(4)) {
        pg8::Gemm g{(const bf16*)(ws + WS_OA), (const bf16*)(ws + WS_WOA), S, D, D}; pg8::StaticOrder So; So.init(S, D, F.G, bx);
        pg8::EpiRes E{hb, ss + 1 * S};
        pg8::gemm_phase<pg8::EpiRes, pg8::StaticOrder, true, true, true>(F.lds + RING_OFF, g, So, E);
        GRID_BAR(4);
    }
    if (IN(5)) {
        pg8::Gemm g{hb, (const bf16*)(ws + WS_WUP), S, FF, D}; pg8::StaticOrder So; So.init(S, FF, F.G, bx);
        pg8::EpiUp E{ss + 1 * S, (bf16*)(ws + WS_U), FF, 0};
        REP(5) pg8::gemm_phase<pg8::EpiUp, pg8::StaticOrder, true, true, true>(F.lds + RING_OFF, g, So, E);
        GRID_BAR(5);
    }
    if (IN(6)) {
        pg8::Gemm g{(const bf16*)(ws + WS_U), (const bf16*)(ws + WS_WDN), S, D, FF}; pg8::StaticOrder So; So.init(S, D, F.G, bx);
        pg8::EpiRes E{hb, ss + 2 * S};
        if (pg8::RowOrder::usable(S, D, F.G)) { pg8::RowOrder Ro; Ro.init(S, D, F.G, bx); pg8::gemm_phase<pg8::EpiRes, pg8::RowOrder, true, true, true>(F.lds + RING_OFF, g, Ro, E); }
        else pg8::gemm_phase<pg8::EpiRes, pg8::StaticOrder, true, true, true>(F.lds + RING_OFF, g, So, E);
        GRID_BAR(6);
    }
    if (IN(7)) {
        pg8::Gemm g{hb, (const bf16*)(ws + WS_WKVQ), S, NKVQ, D}; pg8::StaticOrder So; So.init(S, NKVQ, F.G, bx);
        pg8::EpiKvq E{ss + 2 * S, cosh, sinh, (bf16*)(ws + WS_KS), (bf16*)(ws + WS_VS), (bf16*)(ws + WS_Q2)};
        REP(7) pg8::gemm_phase<pg8::EpiKvq, pg8::StaticOrder, true, true, true>(F.lds + RING_OFF, g, So, E);
        GRID_BAR(7);
    }
    if (IN(8)) { REP(8) { p7_convert_mlp2(F, P); p8_kv_copies(F); } GRID_BAR(8); }
    if (IN(9)) { REP(9) { p9_dilated_dense(F); } GRID_BAR(9); }
    if (IN(10)) {
        pg8::Gemm g{(const bf16*)(ws + WS_O2), (const bf16*)(ws + WS_WOB), S, D, D}; pg8::StaticOrder So; So.init(S, D, F.G, bx);
        pg8::EpiRes E{hb, ss + 3 * S};
        pg8::gemm_phase<pg8::EpiRes, pg8::StaticOrder, true, true, true>(F.lds + RING_OFF, g, So, E);
        GRID_BAR(10);
    }
    if (IN(11)) {
        pg8::Gemm g{hb, (const bf16*)(ws + WS_WUP), S, FF, D}; pg8::StaticOrder So; So.init(S, FF, F.G, bx);
        pg8::EpiUp E{ss + 3 * S, (bf16*)(ws + WS_U), FF, 0};
        REP(11) pg8::gemm_phase<pg8::EpiUp, pg8::StaticOrder, true, true, true>(F.lds + RING_OFF, g, So, E);
        GRID_BAR(11);
    }
    if (IN(12)) {
        pg8::Gemm g{(const bf16*)(ws + WS_U), (const bf16*)(ws + WS_WDN), S, D, FF}; pg8::StaticOrder So; So.init(S, D, F.G, bx);
        pg8::EpiRes E{hb, ss + 4 * S};
        if (pg8::RowOrder::usable(S, D, F.G)) { pg8::RowOrder Ro; Ro.init(S, D, F.G, bx); pg8::gemm_phase<pg8::EpiRes, pg8::RowOrder, true, true, true>(F.lds + RING_OFF, g, Ro, E); }
        else pg8::gemm_phase<pg8::EpiRes, pg8::StaticOrder, true, true, true>(F.lds + RING_OFF, g, So, E);
        GRID_BAR(12);
    }
    if (IN(13)) { p13_final(F, P); }
#undef IN
#undef BOTH
#undef GRID_BAR
}

extern "C" void kernel_launch(void* const* d_in, const int* in_sizes, int n_in, void* d_out, int out_size, void* d_ws, size_t ws_size, hipStream_t stream) {
    static int grid = 0;
    if (grid == 0) {
        if (n_in != 13 || in_sizes[0] != S * D || out_size != S * D || ws_size < WS_END) { fprintf(stderr, "kernel_launch: unexpected shapes / workspace (n_in %d, ws %zu, need %zu)\n", n_in, ws_size, (size_t)WS_END); grid = -1; return; }
        int dev = 0, cus = 0, per_cu = 0;
        if (hipGetDevice(&dev) != hipSuccess || hipDeviceGetAttribute(&cus, hipDeviceAttributeMultiprocessorCount, dev) != hipSuccess) { grid = -1; return; }
        if (hipFuncSetAttribute((const void*)yoco_fwd, hipFuncAttributeMaxDynamicSharedMemorySize, LDS_BYTES) != hipSuccess) { fprintf(stderr, "kernel_launch: hipFuncSetAttribute failed\n"); grid = -1; return; }
        if (hipOccupancyMaxActiveBlocksPerMultiprocessor(&per_cu, (const void*)yoco_fwd, NWAVES * 64, LDS_BYTES) != hipSuccess || per_cu < 1) fprintf(stderr, "kernel_launch: occupancy query reports %d\n", per_cu);
        (void)hipGetLastError();
        grid = cus;
    }
    if (grid < 0) return;
    (void)hipMemsetAsync((char*)d_ws + WS_CTL, 0, CTL_ZERO_BYTES, stream);
    Params p{};
    for (int i = 0; i < 13; ++i) p.in[i] = (const float*)d_in[i];
    p.out = (float*)d_out; p.ws = (unsigned char*)d_ws;
    for (int i = 0; i < 16; ++i) p.invh[i] = (float)std::pow(500000.0, (double)(-(float)(2 * i) / 32.0f));
    for (int i = 0; i < 8; ++i) p.invi[i] = (float)std::pow(500000.0, (double)(-(float)(2 * i) / 16.0f));
#if MK_ONE_LAUNCH
    p.ph_lo = 0; p.ph_hi = N_PHASES;
    hipLaunchKernelGGL(yoco_fwd, dim3(grid), dim3(NWAVES * 64), LDS_BYTES, stream, p);
#else
    for (int k = 0; k < N_PHASES; ++k) { p.ph_lo = k; p.ph_hi = k + 1; hipLaunchKernelGGL(yoco_fwd, dim3(grid), dim3(NWAVES * 64), LDS_BYTES, stream, p); }
#endif
}
```

```cpp
#include <hip/hip_runtime.h>
#include <cstdio>
#include <cstdint>
#include <cmath>
namespace pg8 {
#define PG8_LAS __attribute__((address_space(3)))
typedef unsigned short bf16_t;
typedef short bf16x8 __attribute__((ext_vector_type(8)));
typedef float f32x4 __attribute__((ext_vector_type(4)));
typedef unsigned u32x4 __attribute__((ext_vector_type(4)));
constexpr int BM = 256, BK = 64, HALF = 128, HTB = HALF * BK * 2  , STAGE_BYTES = 8 * HTB, NXCD = 8, WGM = 8;

__host__ __device__ __forceinline__ int lds_byte(int r, int c) { const int st = (r >> 4) * 2 + (c >> 5), rr = r & 15, cc = c & 31, ob = rr * 64 + cc * 2; return st * 1024 + (ob ^ (((ob >> 9) & 1) << 5)); }
__host__ __device__ __forceinline__ void stage_rc(int b, int& R, int& C) { const int st = b / 1024, sb = b % 1024, swz = sb ^ (((sb >> 9) & 1) << 5); R = (st >> 1) * 16 + swz / 64; C = (st & 1) * 32 + (swz % 64) / 2; }
__host__ __device__ __forceinline__ int perm32(int rho) { const int n = rho >> 4, i = rho & 15; return 8 * (i >> 2) + 4 * n + (i & 3); }

struct Unit { int pm, pn; };
struct Gemm { const bf16_t* A; const bf16_t* Bt; int M, N, K; };

struct StaticOrder {
    int nM, nN, nwg, G, c;
    __host__ __device__ void init(int M, int N, int G_, int c_) { nM = M / BM; nN = N / BM; nwg = nM * nN; G = G_; c = c_; }
    __host__ __device__ bool next(int i, Unit& u) const {
        const long L = (long)i * G + c; if (L >= nwg) return false;
        int wgid = (int)L; { const int q = nwg / NXCD, r = nwg % NXCD, xcd = wgid % NXCD, off = wgid / NXCD; wgid = (xcd < r ? xcd * (q + 1) : r * (q + 1) + (xcd - r) * q) + off; }
        const int nig = WGM * nN, gid = wgid / nig, fm = gid * WGM, gsz = (nM - fm) < WGM ? (nM - fm) : WGM;
        u.pm = fm + ((wgid % nig) % gsz); u.pn = (wgid % nig) / gsz; return true;
    }
    __device__ __forceinline__ void a_ready(const Unit&) const {}
    __device__ __forceinline__ void done(const Unit&) const {}
};


__device__ __forceinline__ unsigned cvt_pk_bf16(float lo, float hi) { unsigned r; asm volatile("v_cvt_pk_bf16_f32 %0, %1, %2" : "=v"(r) : "v"(lo), "v"(hi)); return r; }
typedef unsigned u32x2 __attribute__((ext_vector_type(2)));
constexpr float RMS_EPS = 1e-6f;
typedef unsigned long long ssq_t;
__device__ __forceinline__ ssq_t ss_fix(float q) { return (ssq_t)(q * 65536.0f + 0.5f); }
__device__ __forceinline__ float rstd_of(ssq_t ss) { return 1.0f / sqrtf((float)ss * (1.0f / (65536.0f * 2048.0f)) + RMS_EPS); }
__device__ __forceinline__ u32x2 pack4(f32x4 v) { u32x2 w; w.x = cvt_pk_bf16(v[0], v[1]); w.y = cvt_pk_bf16(v[2], v[3]); return w; }
__device__ __forceinline__ void widen16(unsigned& x, unsigned& y) { const auto r = __builtin_amdgcn_permlane16_swap(x, y, false, false); x = r[0]; y = r[1]; }
__device__ __forceinline__ int wide_col(int fq) { return 16 * (fq & 1) + 8 * (fq >> 1); }

__device__ __forceinline__ size_t tm_off(int t, int c, int ld) { return (size_t)((t >> 8) * (ld >> 8) + (c >> 8)) * (size_t)(BM * BM) + (size_t)((t & 255) * BM + (c & 255)); }

__device__ __forceinline__ void store_heads128(const f32x4 (&acc)[2][2][4][2], int row0, int wc, int fq, const ssq_t* ss, bf16_t* base, int ld, int colt, bool rope, const float* cosh, const float* sinh) {
    rope = rope && (wc == 0);
    const int colw = colt + wc * 32 + wide_col(fq);
#pragma unroll
    for (int ai = 0; ai < 2; ++ai)
#pragma unroll
        for (int m = 0; m < 4; ++m) {
            const int row = row0 + ai * HALF + m * 16;
            const float rs = rstd_of(ss[row]);
            f32x4 c4 = (f32x4){1.f, 1.f, 1.f, 1.f}, s4 = (f32x4){0.f, 0.f, 0.f, 0.f};
            if (rope) { c4 = *(const f32x4*)(cosh + (size_t)row * 16 + 4 * fq); s4 = *(const f32x4*)(sinh + (size_t)row * 16 + 4 * fq); }
            bf16_t* rowp = base + tm_off(row, colw, ld);
#pragma unroll
            for (int bj = 0; bj < 2; ++bj) {
                f32x4 v0 = acc[ai][bj][m][0] * rs, v1 = acc[ai][bj][m][1] * rs;
                if (rope) { const f32x4 a = v0 * c4 - v1 * s4, b = v1 * c4 + v0 * s4; v0 = a; v1 = b; }
                const u32x2 A = pack4(v0), B = pack4(v1); unsigned ax = A.x, ay = A.y, bx = B.x, by = B.y; widen16(ax, bx); widen16(ay, by);
                u32x4 w; w.x = ax; w.y = ay; w.z = bx; w.w = by; *(u32x4*)(rowp + bj * HALF) = w;
            }
        }
}

constexpr int SEQ = 16384;
__device__ __forceinline__ int pack4_fp8(f32x4 v) { int w = __builtin_amdgcn_cvt_pk_fp8_f32(v[0], v[1], 0, false); return __builtin_amdgcn_cvt_pk_fp8_f32(v[2], v[3], w, true); }
__device__ __forceinline__ void store_heads128_fp8(const f32x4 (&acc)[2][2][4][2], int row0, int wc, int fq, const ssq_t* ss, unsigned char* base, int head0, bool rope, const float* cosh, const float* sinh) {
    rope = rope && (wc == 0);
#pragma unroll
    for (int ai = 0; ai < 2; ++ai)
#pragma unroll
        for (int m = 0; m < 4; ++m) {
            const int row = row0 + ai * HALF + m * 16;
            const float rs = rstd_of(ss[row]);
            f32x4 c4 = (f32x4){1.f, 1.f, 1.f, 1.f}, s4 = (f32x4){0.f, 0.f, 0.f, 0.f};
            if (rope) { c4 = *(const f32x4*)(cosh + (size_t)row * 16 + 4 * fq); s4 = *(const f32x4*)(sinh + (size_t)row * 16 + 4 * fq); }
#pragma unroll
            for (int bj = 0; bj < 2; ++bj) {
                f32x4 v0 = acc[ai][bj][m][0] * rs, v1 = acc[ai][bj][m][1] * rs;
                if (rope) { const f32x4 a = v0 * c4 - v1 * s4, b = v1 * c4 + v0 * s4; v0 = a; v1 = b; }
                unsigned char* p = base + ((size_t)(head0 + bj) * SEQ + row) * 128 + wc * 32 + wide_col(fq);
                unsigned a8 = (unsigned)pack4_fp8(v0), b8 = (unsigned)pack4_fp8(v1); widen16(a8, b8);
                u32x2 w; w.x = a8; w.y = b8; *(u32x2*)p = w;
            }
        }
}

__device__ __forceinline__ void store_heads128_q8(const f32x4 (&acc)[2][2][4][2], int row0, int wc, int fq, const ssq_t* ss, unsigned char* base, int ld, int colt, const float* cosh, const float* sinh) {
    const bool rope = (wc == 0);
    const int col0 = colt + wc * 32 + wide_col(fq);
#pragma unroll
    for (int ai = 0; ai < 2; ++ai)
#pragma unroll
        for (int m = 0; m < 4; ++m) {
            const int row = row0 + ai * HALF + m * 16;
            const float rs = rstd_of(ss[row]);
            f32x4 c4 = (f32x4){1.f, 1.f, 1.f, 1.f}, s4 = (f32x4){0.f, 0.f, 0.f, 0.f};
            if (rope) { c4 = *(const f32x4*)(cosh + (size_t)row * 16 + 4 * fq); s4 = *(const f32x4*)(sinh + (size_t)row * 16 + 4 * fq); }
            unsigned char* rowp = base + tm_off(row, col0, ld);
#pragma unroll
            for (int bj = 0; bj < 2; ++bj) {
                f32x4 v0 = acc[ai][bj][m][0] * rs, v1 = acc[ai][bj][m][1] * rs;
                if (rope) { const f32x4 a = v0 * c4 - v1 * s4, b = v1 * c4 + v0 * s4; v0 = a; v1 = b; }
                unsigned a8 = (unsigned)pack4_fp8(v0), b8 = (unsigned)pack4_fp8(v1); widen16(a8, b8);
                u32x2 w; w.x = a8; w.y = b8; *(u32x2*)(rowp + bj * HALF) = w;
            }
        }
}

struct EpiIn {
    static constexpr bool PERM = false, AFTER_DRAIN = false;
    const ssq_t* ss;
    const float *cosh, *sinh, *cosi, *sini;
    bf16_t *Q, *K, *V, *QI, *KI; float* WI;
    __device__ __forceinline__ void operator()(const f32x4 (&acc)[2][2][4][2], const Unit& u, int wr, int wc, int fr, int fq) const {
        const int row0 = u.pm * BM + wr * 64 + fr, pn = u.pn;
        if (pn < 12) {
            if (pn < 8) store_heads128_q8(acc, row0, wc, fq, ss, (unsigned char*)Q, 2048, pn * 256, cosh, sinh);
            else if (pn < 10) store_heads128_fp8(acc, row0, wc, fq, ss, (unsigned char*)K, 2 * (pn - 8), true, cosh, sinh);
            else store_heads128_fp8(acc, row0, wc, fq, ss, (unsigned char*)V, 2 * (pn - 10), false, cosh, sinh);
        } else if (pn < 16) {
            const int col0 = (pn - 12) * 256 + wc * 32 + wide_col(fq); const bool rope = (wc & 1) == 0;
#pragma unroll
            for (int ai = 0; ai < 2; ++ai)
#pragma unroll
                for (int m = 0; m < 4; ++m) {
                    const int row = row0 + ai * HALF + m * 16; const float rs = rstd_of(ss[row]);
                    const f32x4 c4 = *(const f32x4*)(cosi + (size_t)row * 8 + 4 * (fq & 1)), s4 = *(const f32x4*)(sini + (size_t)row * 8 + 4 * (fq & 1));
                    bf16_t* rowp = QI + tm_off(row, col0, 1024);
#pragma unroll
                    for (int bj = 0; bj < 2; ++bj) {
                        f32x4 v0 = acc[ai][bj][m][0] * rs; const f32x4 v1 = acc[ai][bj][m][1] * rs;
                        f32x4 p; p[0] = __shfl_xor(v0[0], 32); p[1] = __shfl_xor(v0[1], 32); p[2] = __shfl_xor(v0[2], 32); p[3] = __shfl_xor(v0[3], 32);
                        if (rope) v0 = (fq < 2) ? (v0 * c4 - p * s4) : (v0 * c4 + p * s4);
                        const u32x2 A = pack4(v0), B = pack4(v1); unsigned ax = A.x, ay = A.y, bx = B.x, by = B.y; widen16(ax, bx); widen16(ay, by);
                        u32x4 w; w.x = ax; w.y = ay; w.z = bx; w.w = by; *(u32x4*)(rowp + bj * HALF) = w;
                    }
                }
        }
    }
};

struct EpiKvq {
    static constexpr bool PERM = false, AFTER_DRAIN = false;
    const ssq_t* ss; const float *cosh, *sinh; bf16_t *K, *V, *Q;
    __device__ __forceinline__ void operator()(const f32x4 (&acc)[2][2][4][2], const Unit& u, int wr, int wc, int fr, int fq) const {
        const int row0 = u.pm * BM + wr * 64 + fr, pn = u.pn;
        if (pn < 2) store_heads128(acc, row0, wc, fq, ss, K, 512, pn * 256, true, cosh, sinh);
        else if (pn < 4) store_heads128(acc, row0, wc, fq, ss, V, 512, (pn - 2) * 256, false, cosh, sinh);
        else store_heads128_q8(acc, row0, wc, fq, ss, (unsigned char*)Q, 6144, (pn - 4) * 256, cosh, sinh);
    }
};

struct EpiRes {
    static constexpr bool PERM = true, AFTER_DRAIN = false;
    bf16_t* hb; ssq_t* ssq;
    __device__ __forceinline__ void operator()(const f32x4 (&acc)[2][2][4][2], const Unit& u, int wr, int wc, int fr, int fq) const {
        const int row0 = u.pm * BM + wr * 64 + fr, col0 = u.pn * BM + wc * 32 + 8 * fq;
#pragma unroll
        for (int ai = 0; ai < 2; ++ai)
#pragma unroll
            for (int m = 0; m < 4; ++m) {
                const int row = row0 + ai * HALF + m * 16; float q = 0.f;
                bf16_t* rowp = hb + ((size_t)(u.pm * 8 + u.pn) * (size_t)(BM * BM) + (size_t)((wc >> 1) * (BM * BK) + (row - u.pm * BM) * BK + (wc & 1) * 32 + 8 * fq));
                u32x4 b[2];
#pragma unroll
                for (int bj = 0; bj < 2; ++bj) b[bj] = *(const u32x4*)(rowp + bj * (2 * BM * BK));
#pragma unroll
                for (int bj = 0; bj < 2; ++bj) {
                    u32x4 w;
#pragma unroll
                    for (int i = 0; i < 4; ++i) {
                        const f32x4& a = acc[ai][bj][m][i >> 1];
                        const float lo = __uint_as_float(b[bj][i] << 16) + a[(i & 1) * 2], hi = __uint_as_float(b[bj][i] & 0xffff0000u) + a[(i & 1) * 2 + 1];
                        const unsigned pk = cvt_pk_bf16(lo, hi); w[i] = pk;
                        const float rl = __uint_as_float(pk << 16), rh = __uint_as_float(pk & 0xffff0000u);
                        q += rl * rl + rh * rh;
                    }
                    *(u32x4*)(rowp + bj * (2 * BM * BK)) = w;
                }
                q += __shfl_xor(q, 16); q += __shfl_xor(q, 32);
                if (fq == 0) atomicAdd(ssq + row, ss_fix(q));
            }
    }
};

struct RowOrder {
    int nN, nwg, G, c;
    __host__ __device__ void init(int M, int N, int G_, int c_) { nN = N / BM; nwg = (M / BM) * nN; G = G_; c = c_; }
    __host__ __device__ static bool usable(int M, int N, int G_) { const int n = N / BM; return G_ % (NXCD * n) == 0 && ((M / BM) * n) % G_ == 0; }
    __host__ __device__ bool next(int i, Unit& u) const {
        if ((long)i * G + c >= nwg) return false;
        const int ppx = G / NXCD / nN, x = c % NXCD, j = c / NXCD;
        u.pm = i * (G / nN) + x * ppx + (j % ppx); u.pn = j / ppx; return true;
    }
    __device__ __forceinline__ void a_ready(const Unit&) const {}
    __device__ __forceinline__ void done(const Unit&) const {}
};

struct EpiUp {
    static constexpr bool PERM = true, AFTER_DRAIN = false;
    const ssq_t* ss; bf16_t* O; int ldc; int dry;
    __device__ __forceinline__ void operator()(const f32x4 (&acc)[2][2][4][2], const Unit& u, int wr, int wc, int fr, int fq) const {
        const int row0 = u.pm * BM + wr * 64 + fr, col0 = u.pn * BM + wc * 32 + 8 * fq;
#pragma unroll
        for (int ai = 0; ai < 2; ++ai)
#pragma unroll
            for (int m = 0; m < 4; ++m) {
                const int row = row0 + ai * HALF + m * 16; const float rs = rstd_of(ss[row]);
                bf16_t* rowp = O + ((size_t)(u.pm * (ldc / BM) + u.pn) * (size_t)(BM * BM) + (size_t)((wc >> 1) * (BM * BK) + (row - u.pm * BM) * BK + (wc & 1) * 32 + 8 * fq));
#pragma unroll
                for (int bj = 0; bj < 2; ++bj) {
                    f32x4 v0 = acc[ai][bj][m][0] * rs, v1 = acc[ai][bj][m][1] * rs;
                    v0 = __builtin_elementwise_max(v0, (f32x4){0.f, 0.f, 0.f, 0.f}); v1 = __builtin_elementwise_max(v1, (f32x4){0.f, 0.f, 0.f, 0.f});
                    v0 = v0 * v0; v1 = v1 * v1;
                    u32x4 w; w.x = cvt_pk_bf16(v0[0], v0[1]); w.y = cvt_pk_bf16(v0[2], v0[3]); w.z = cvt_pk_bf16(v1[0], v1[1]); w.w = cvt_pk_bf16(v1[2], v1[3]);
                    if (dry) asm volatile("" :: "v"(w.x), "v"(w.y), "v"(w.z), "v"(w.w)); else *(u32x4*)(rowp + bj * (2 * BM * BK)) = w;
                }
            }
    }
};
template <class Epi, class Sched, bool ALIGN_EPI = false, bool SP2 = false, bool ATILED = false>
__device__ __forceinline__ void gemm_phase(PG8_LAS unsigned char* lds, const Gemm g, const Sched& S, const Epi& E) {
    const int tid = threadIdx.x, wid = __builtin_amdgcn_readfirstlane(tid >> 6), lane = tid & 63, wr = wid >> 2, wc = wid & 3, fr = lane & 15, fq = lane >> 4;
    const int K = g.K, nt = K / BK;
    const int LDA = ATILED ? BK : K;
    unsigned voffA[2], voffB[2];
#pragma unroll
    for (int i = 0; i < 2; ++i) { int R, C; stage_rc(tid * 16 + i * 8192, R, C); const int Rb = Epi::PERM ? ((R & ~31) + perm32(R & 31)) : R;
        voffA[i] = (unsigned)(R * LDA + C) * 2u; voffB[i] = (unsigned)(Rb * LDA + C) * 2u; }
    const size_t kstep = (size_t)(BK * 2);
    const size_t hstepA = (size_t)HALF * LDA * 2, hstepB = hstepA;
    const size_t tstep = (size_t)BM * K * 2;
    const unsigned ldsw = (unsigned)wid * 1024u;
    const int aoff = lds_byte(wr * 64 + fr, fq * 8), boff = lds_byte(wc * 32 + fr, fq * 8);
#define PG8_SA(b, h) (((b) * 2 + (h)) * HTB)
#define PG8_SB(b, h) ((4 + (b) * 2 + (h)) * HTB)
#define PG8_STAGE(bufoff, gbase, voff) do { _Pragma("unroll") for (int _i = 0; _i < 2; ++_i) \
        __builtin_amdgcn_global_load_lds((const unsigned*)((const char*)(gbase) + (voff)[_i]), (PG8_LAS unsigned*)(lds + (bufoff) + ldsw + _i * 8192), 16, 0, 0); } while (0)
#define PG8_LDA(dst, b, h) do { _Pragma("unroll") for (int m = 0; m < 4; ++m) _Pragma("unroll") for (int k = 0; k < 2; ++k) dst[m][k] = *(const PG8_LAS bf16x8*)(lds + PG8_SA(b, h) + aoff + m * 2048 + k * 1024); } while (0)
#define PG8_LDB(dst, b, h) do { _Pragma("unroll") for (int n = 0; n < 2; ++n) _Pragma("unroll") for (int k = 0; k < 2; ++k) dst[n][k] = *(const PG8_LAS bf16x8*)(lds + PG8_SB(b, h) + boff + n * 2048 + k * 1024); } while (0)
#define PG8_MMA(ai, bj, At, Bt) do { __builtin_amdgcn_s_setprio(1); _Pragma("unroll") for (int m = 0; m < 4; ++m) _Pragma("unroll") for (int n = 0; n < 2; ++n) _Pragma("unroll") for (int k = 0; k < 2; ++k) \
        acc[ai][bj][m][n] = __builtin_amdgcn_mfma_f32_16x16x32_bf16(Bt[n][k], At[m][k], acc[ai][bj][m][n], 0, 0, 0); __builtin_amdgcn_s_setprio(0); } while (0)
#define PG8_WAIT_V(n) asm volatile("s_waitcnt vmcnt(" #n ")" ::: "memory")
#define PG8_WAIT_L(n) asm volatile("s_waitcnt lgkmcnt(" #n ")" ::: "memory")
#define PG8_BAR __builtin_amdgcn_s_barrier()
#define PG8_SCHED __builtin_amdgcn_sched_barrier(0)
    auto akt = [&](int t) -> size_t { return ATILED ? (size_t)t * (size_t)(BM * BK * 2) : (size_t)t * kstep; };
    const size_t akt1 = akt(1);
    Unit cur, nxt; int ui = 0;
    if (!S.next(0, cur)) return;
    f32x4 acc[2][2][4][2];
#pragma unroll
    for (int a = 0; a < 2; ++a)
#pragma unroll
        for (int b = 0; b < 2; ++b)
#pragma unroll
            for (int m = 0; m < 4; ++m)
#pragma unroll
                for (int n = 0; n < 2; ++n) acc[a][b][m][n] = (f32x4){0.f, 0.f, 0.f, 0.f};
    bf16x8 At[4][2], B0[2][2], B1[2][2];
    const char* cA = (const char*)g.A + (size_t)cur.pm * tstep; const char* cB = (const char*)g.Bt + (size_t)cur.pn * tstep;
    S.a_ready(cur);
    if constexpr (SP2) {
        PG8_STAGE(PG8_SB(0, 0), cB, voffB); PG8_STAGE(PG8_SB(0, 1), cB + hstepB, voffB); PG8_STAGE(PG8_SA(0, 0), cA, voffA); PG8_STAGE(PG8_SA(0, 1), cA + hstepA, voffA);
        if (wr == 1) PG8_BAR;
        PG8_WAIT_V(2); PG8_BAR;
        PG8_STAGE(PG8_SB(1, 0), cB + akt1, voffB); PG8_STAGE(PG8_SA(1, 0), cA + akt1, voffA); PG8_STAGE(PG8_SB(1, 1), cB + hstepB + akt1, voffB);
        PG8_WAIT_V(6); PG8_BAR;
    } else {
        PG8_STAGE(PG8_SB(0, 0), cB, voffB); PG8_STAGE(PG8_SA(0, 0), cA, voffA); PG8_STAGE(PG8_SB(0, 1), cB + hstepB, voffB); PG8_STAGE(PG8_SA(0, 1), cA + hstepA, voffA);
        if (wr == 1) PG8_BAR;
        PG8_WAIT_V(4); PG8_BAR;
        PG8_STAGE(PG8_SB(1, 0), cB + akt1, voffB); PG8_STAGE(PG8_SA(1, 0), cA + akt1, voffA); PG8_STAGE(PG8_SB(1, 1), cB + hstepB + akt1, voffB);
        PG8_WAIT_V(6); PG8_BAR;
    }
    for (;;) {
        const bool has_next = S.next(ui + 1, nxt);
        const char* nA = has_next ? (const char*)g.A + (size_t)nxt.pm * tstep : cA; const char* nB = has_next ? (const char*)g.Bt + (size_t)nxt.pn * tstep : cB;
        for (int t = 0; t < nt; t += 2) {
            const bool last = (t == nt - 2);
            const char* a1 = cA + akt(t + 1);
            const char* a2 = last ? nA : cA + akt(t + 2); const char* b2 = last ? nB : cB + akt(t + 2);
            const char* a3 = a2 + akt1; const char* b3 = b2 + akt1;
            if (last && has_next) S.a_ready(nxt);
            if constexpr (SP2) {
            PG8_LDB(B0, 0, 0); PG8_LDB(B1, 0, 1); PG8_SCHED; PG8_LDA(At, 0, 0); PG8_STAGE(PG8_SA(1, 1), a1 + hstepA, voffA);
            PG8_WAIT_V(8); PG8_WAIT_L(0); PG8_BAR; PG8_MMA(0, 0, At, B0); PG8_MMA(0, 1, At, B1); PG8_BAR; PG8_SCHED;
            PG8_LDA(At, 0, 1); PG8_STAGE(PG8_SB(0, 0), b2, voffB); PG8_STAGE(PG8_SB(0, 1), b2 + hstepB, voffB); PG8_STAGE(PG8_SA(0, 0), a2, voffA);
            PG8_WAIT_V(8); PG8_WAIT_L(0); PG8_BAR; PG8_MMA(1, 0, At, B0); PG8_MMA(1, 1, At, B1); PG8_BAR; PG8_SCHED;
            PG8_LDB(B0, 1, 0); PG8_LDB(B1, 1, 1); PG8_SCHED; PG8_LDA(At, 1, 0); PG8_STAGE(PG8_SA(0, 1), a2 + hstepA, voffA);
            PG8_WAIT_V(8); PG8_WAIT_L(0); PG8_BAR; PG8_MMA(0, 0, At, B0); PG8_MMA(0, 1, At, B1); PG8_BAR; PG8_SCHED;
            PG8_LDA(At, 1, 1); PG8_STAGE(PG8_SB(1, 0), b3, voffB); PG8_STAGE(PG8_SB(1, 1), b3 + hstepB, voffB); PG8_STAGE(PG8_SA(1, 0), a3, voffA);
            PG8_WAIT_V(8); PG8_WAIT_L(0); PG8_BAR; PG8_MMA(1, 0, At, B0); PG8_MMA(1, 1, At, B1); PG8_BAR; PG8_SCHED;
            } else {
            PG8_LDB(B0, 0, 0); PG8_SCHED; PG8_LDA(At, 0, 0); PG8_STAGE(PG8_SA(1, 1), a1 + hstepA, voffA);
            PG8_WAIT_L(8); PG8_BAR; PG8_WAIT_L(0); PG8_MMA(0, 0, At, B0); PG8_BAR; PG8_SCHED;
            PG8_LDB(B1, 0, 1); PG8_STAGE(PG8_SB(0, 0), b2, voffB);
            PG8_BAR; PG8_WAIT_L(0); PG8_MMA(0, 1, At, B1); PG8_BAR;
            PG8_LDA(At, 0, 1); PG8_STAGE(PG8_SA(0, 0), a2, voffA);
            PG8_BAR; PG8_WAIT_L(0); PG8_MMA(1, 0, At, B0); PG8_BAR; PG8_SCHED;
            PG8_STAGE(PG8_SB(0, 1), b2 + hstepB, voffB);
            PG8_WAIT_V(6); PG8_BAR; PG8_MMA(1, 1, At, B1); PG8_BAR;
            PG8_LDB(B0, 1, 0); PG8_SCHED; PG8_LDA(At, 1, 0); PG8_STAGE(PG8_SA(0, 1), a2 + hstepA, voffA);
            PG8_WAIT_L(8); PG8_BAR; PG8_WAIT_L(0); PG8_MMA(0, 0, At, B0); PG8_BAR; PG8_SCHED;
            PG8_LDB(B1, 1, 1); PG8_STAGE(PG8_SB(1, 0), b3, voffB);
            PG8_BAR; PG8_WAIT_L(0); PG8_MMA(0, 1, At, B1); PG8_BAR;
            PG8_LDA(At, 1, 1); PG8_STAGE(PG8_SA(1, 0), a3, voffA);
            PG8_BAR; PG8_WAIT_L(0); PG8_MMA(1, 0, At, B0); PG8_BAR; PG8_SCHED;
            PG8_STAGE(PG8_SB(1, 1), b3 + hstepB, voffB);
            PG8_WAIT_V(6); PG8_BAR; PG8_MMA(1, 1, At, B1); PG8_BAR;
            }
        }
        if constexpr (ALIGN_EPI) { if (wr == 0) PG8_BAR; }
        if constexpr (!Epi::AFTER_DRAIN) { E(acc, cur, wr, wc, fr, fq); S.done(cur); }
        if (!has_next) break;
#pragma unroll
        for (int a = 0; a < 2; ++a)
#pragma unroll
            for (int b = 0; b < 2; ++b)
#pragma unroll
                for (int m = 0; m < 4; ++m)
#pragma unroll
                    for (int n = 0; n < 2; ++n) acc[a][b][m][n] = (f32x4){0.f, 0.f, 0.f, 0.f};
        cur = nxt; cA = nA; cB = nB; ++ui;
        if constexpr (ALIGN_EPI) { if (wr == 1) PG8_BAR; }
    }
    PG8_WAIT_V(0);
    if constexpr (!ALIGN_EPI) { if (wr == 0) PG8_BAR; }
    PG8_BAR;
    if constexpr (Epi::AFTER_DRAIN) { E.fused(acc, cur, wr, wc, fr, fq, lds, wid, lane); S.done(cur); }
#undef PG8_SA
#undef PG8_SB
#undef PG8_STAGE
#undef PG8_LDA
#undef PG8_LDB
#undef PG8_MMA
#undef PG8_WAIT_V
#undef PG8_WAIT_L
#undef PG8_BAR
#undef PG8_SCHED
}
}

constexpr int S = 16384, D = 2048, FF = 8192;
constexpr int NIN = 4176, NIN_PAD = 4352;
constexpr int NKVQ = 7168;
constexpr int TOPK = 256;
constexpr int NWAVES = 8;
constexpr int N_PHASES = 14;
#ifndef MK_ONE_LAUNCH
#define MK_ONE_LAUNCH 1
#endif

constexpr size_t MiB = 1u << 20;
constexpr size_t WS_CTL = 0, CTL_ZERO_BYTES = 16384;
constexpr size_t WS_COSH = 1 * MiB, WS_SINH = 2 * MiB, WS_COSI = 3 * MiB, WS_SINI = 3 * MiB + 512 * 1024;
constexpr size_t WS_SS = 4 * MiB;
constexpr size_t WS_SEL = 5 * MiB;
constexpr size_t WS_WIN = 13 * MiB, WS_WOA = 30 * MiB, WS_WOB = 38 * MiB, WS_WKVQ = 46 * MiB, WS_WUP = 74 * MiB, WS_WDN = 106 * MiB;
constexpr size_t WS_HB = 138 * MiB;
constexpr size_t WS_R = 202 * MiB;
constexpr size_t WS_QA = WS_R, WS_KA = WS_R + 64 * MiB, WS_VA = WS_R + 80 * MiB, WS_QI = WS_R + 96 * MiB, WS_KI = WS_R + 128 * MiB, WS_WI = WS_R + 130 * MiB, WS_OA = WS_R + 132 * MiB;
constexpr size_t WS_U = WS_R;
constexpr size_t WS_Q2 = WS_R, WS_KS = WS_R + 192 * MiB, WS_VS = WS_R + 208 * MiB, WS_O2 = WS_R + 224 * MiB;
constexpr size_t WS_END = WS_R + 288 * MiB;
constexpr size_t WS_VT0 = 5 * MiB, WS_VT1 = 21 * MiB, WS_VT2 = 46 * MiB;
static_assert(WS_OA + 64 * MiB <= WS_END && WS_U + 256 * MiB <= WS_END && WS_O2 + 64 * MiB <= WS_END, "ws map");
constexpr int CW_BAR = 0;

constexpr int RING_OFF = 0, RING_BYTES = 131072;
constexpr int LDSCTL_OFF = RING_BYTES, MISC_OFF = LDSCTL_OFF + 320;
constexpr int LDS_BYTES = 147456;

#define GAS __attribute__((address_space(1)))
#define LAS __attribute__((address_space(3)))
typedef unsigned short bf16;
typedef unsigned v4u __attribute__((ext_vector_type(4)));
typedef unsigned v2u __attribute__((ext_vector_type(2)));
typedef float f32x4 __attribute__((ext_vector_type(4)));
typedef float f32x16 __attribute__((ext_vector_type(16)));
typedef short bf16x8 __attribute__((ext_vector_type(8)));
typedef GAS unsigned gu32;
#define LDS_WAIT() asm volatile("s_waitcnt lgkmcnt(0)" ::: "memory")
#define VM_WAIT() asm volatile("s_waitcnt vmcnt(0)" ::: "memory")
__device__ __forceinline__ unsigned f2bf(float f) { unsigned u = __builtin_bit_cast(unsigned, f); return (u + 0x7fffu + ((u >> 16) & 1u)) >> 16; }
__device__ __forceinline__ unsigned pk2(float lo, float hi) { return f2bf(lo) | (f2bf(hi) << 16); }
__device__ __forceinline__ float bf2f(short v) { return __uint_as_float(((unsigned)(unsigned short)v) << 16); }
#define XB_TMO      128
#define XB_XCNT(j)  (256  + 64 * (j))
#define XB_XSUB(j)  (1280 + 64 * (j))
#define XB_XGEN(j)  (2304 + 64 * (j))
#define XB_TOP      3328
#define XB_TOPGEN   3392
#define XCD_BAR_WORDS 3456
#define XB_SPIN_CAP (1u << 18)

__device__ __forceinline__ unsigned xb_ld(unsigned* p)              { return __hip_atomic_load(p, __ATOMIC_RELAXED, __HIP_MEMORY_SCOPE_AGENT); }
__device__ __forceinline__ unsigned xb_add(unsigned* p, unsigned v) { return __hip_atomic_fetch_add(p, v, __ATOMIC_RELAXED, __HIP_MEMORY_SCOPE_AGENT); }
__device__ __forceinline__ unsigned xb_xcc_id() { return (unsigned)__builtin_amdgcn_s_getreg((3 << 11) | 20) & 0xFu; }
#define XB_SPIN(cond, bar) do { unsigned _sp = 0; while (cond) { __builtin_amdgcn_s_sleep(1); \
    if ((++_sp & 255u) == 0u) { if (xb_ld(&(bar)[XB_TMO])) break; if (_sp > XB_SPIN_CAP) { atomicAdd(&(bar)[XB_TMO], 1u); break; } } } } while (0)

struct XcdBarrier {
    unsigned* bar; unsigned x;
    volatile LAS unsigned* st;
};

__device__ __forceinline__ XcdBarrier xcd_barrier_post(unsigned* bar, volatile LAS unsigned* st) {
    XcdBarrier b; b.bar = bar; b.x = xb_xcc_id(); b.st = st;
    if (threadIdx.x == 0) (void)xb_add(&bar[XB_XCNT(b.x)], 1u);
    return b;
}
__device__ __forceinline__ void xcd_barrier_complete(unsigned* bar, unsigned x, unsigned& nloc, unsigned& nx) {
    const unsigned G = gridDim.x * gridDim.y * gridDim.z;
    unsigned sum, cnt, mine, sp = 0u;
    for (;;) {
        sum = 0u; cnt = 0u; mine = 0u;
#pragma unroll
        for (unsigned j = 0; j < 16; ++j) { const unsigned c = xb_ld(&bar[XB_XCNT(j)]); sum += c; cnt += (c > 0u) ? 1u : 0u; mine = (j == x) ? c : mine; }
        if (sum == G) break;
        __builtin_amdgcn_s_sleep(1);
        if ((++sp & 255u) == 0u) { if (xb_ld(&bar[XB_TMO])) break; if (sp > XB_SPIN_CAP) { atomicAdd(&bar[XB_TMO], 1u); break; } }
    }
    nloc = mine > 0u ? mine : 1u; nx = cnt > 0u ? cnt : 1u;
}

__device__ __forceinline__ void xcd_barrier(const XcdBarrier& b) {
    asm volatile("s_waitcnt vmcnt(0)" ::: "memory");
    __syncthreads();
    if (threadIdx.x == 0) {
        unsigned* bar = b.bar;
        __builtin_amdgcn_s_waitcnt(0);
        unsigned nloc = b.st[0], nx = b.st[1];
        if (nloc == 0u) { xcd_barrier_complete(bar, b.x, nloc, nx); b.st[0] = nloc; b.st[1] = nx; }
        const unsigned old = xb_add(&bar[XB_XSUB(b.x)], 1u);
        const unsigned gen = old / nloc;
        if (old + 1u == (gen + 1u) * nloc) {
            __builtin_amdgcn_fence(__ATOMIC_RELEASE, "agent");
            asm volatile("s_waitcnt vmcnt(0)" ::: "memory");
            const unsigned og = xb_add(&bar[XB_TOP], 1u);
            const unsigned tg = og / nx;
            if (og + 1u == (tg + 1u) * nx) xb_add(&bar[XB_TOPGEN], 1u);
            else XB_SPIN(xb_ld(&bar[XB_TOPGEN]) == tg, bar);
            __builtin_amdgcn_fence(__ATOMIC_ACQUIRE, "agent");
            xb_add(&bar[XB_XGEN(b.x)], 1u);
            asm volatile("s_waitcnt vmcnt(0)" ::: "memory");
        } else {
            XB_SPIN(xb_ld(&bar[XB_XGEN(b.x)]) == gen, bar);
            __builtin_amdgcn_fence(__ATOMIC_ACQUIRE, "agent");
            asm volatile("s_waitcnt vmcnt(0)" ::: "memory");
        }
    }
    __syncthreads();
}

struct Params { const float* in[13]; float* out; unsigned char* ws; float invh[16]; float invi[8]; int ph_lo, ph_hi; };
struct Frame {
    LAS unsigned char* lds;
    int tid, lane, wave, vcu, G;
    unsigned char* ws; unsigned char* outb;
};
template <int CTRL> __device__ __forceinline__ float dpp_mov(float v) { return __uint_as_float(__builtin_amdgcn_update_dpp(0u, __float_as_uint(v), CTRL, 0xf, 0xf, false)); }
__device__ __forceinline__ float row_sum16(float v) { v += dpp_mov<0x128>(v); v += dpp_mov<0x124>(v); v += dpp_mov<0x122>(v); v += dpp_mov<0x121>(v); return v; }
__device__ __forceinline__ float row_max16(float v) { v = __builtin_fmaxf(v, dpp_mov<0x128>(v)); v = __builtin_fmaxf(v, dpp_mov<0x124>(v)); v = __builtin_fmaxf(v, dpp_mov<0x122>(v)); v = __builtin_fmaxf(v, dpp_mov<0x121>(v)); return v; }
__device__ __forceinline__ float swap16_sum(float v) { const auto r = __builtin_amdgcn_permlane16_swap(__float_as_uint(v), __float_as_uint(v), false, false); return __uint_as_float(r[0]) + __uint_as_float(r[1]); }
__device__ __forceinline__ float swap32_sum(float v) { const auto r = __builtin_amdgcn_permlane32_swap(__float_as_uint(v), __float_as_uint(v), false, false); return __uint_as_float(r[0]) + __uint_as_float(r[1]); }
__device__ __forceinline__ float swap32_max(float v) { const auto r = __builtin_amdgcn_permlane32_swap(__float_as_uint(v), __float_as_uint(v), false, false); return __builtin_fmaxf(__uint_as_float(r[0]), __uint_as_float(r[1])); }
__device__ __forceinline__ float bcast_row0(float v) {
    const auto r = __builtin_amdgcn_permlane16_swap(__float_as_uint(v), __float_as_uint(v), false, false);
    const auto q = __builtin_amdgcn_permlane32_swap(r[0], r[0], false, false);
    return __uint_as_float(q[0]);
}
__device__ __forceinline__ float wave_sum(float v) { return swap32_sum(swap16_sum(row_sum16(v))); }

__device__ __forceinline__ size_t ktm_off(int t, int c) { return (size_t)(t >> 8) * (size_t)(256 * 2048) + (size_t)((c >> 6) * 16384 + (t & 255) * 64 + (c & 63)); }
__device__ __forceinline__ void tr_item(const float* W, int K, int N, int Npad, const float* gain, bf16* WT, int row_off, LAS float* scr, int item, int lane) {
    const int nblk = Npad / 32, kb = item / nblk, nb = item - kb * nblk, k0 = 64 * kb, n0 = 32 * nb;
    const int kr = lane >> 3, c = lane & 7, n = n0 + 4 * c;
    f32x4 v[8];
#pragma unroll
    for (int i = 0; i < 8; ++i) {
        const float* src = W + (size_t)(k0 + kr + 8 * i) * N + n;
        if (n + 3 < N) v[i] = *(const GAS f32x4*)src;
        else { v[i] = (f32x4){0.f, 0.f, 0.f, 0.f}; if (n < N) v[i].x = src[0]; if (n + 1 < N) v[i].y = src[1]; if (n + 2 < N) v[i].z = src[2]; }
    }
#pragma unroll
    for (int i = 0; i < 8; ++i) {
        const int kk = kr + 8 * i; const float gsc = gain ? gain[k0 + kk] : 1.0f;
        LAS float* d = scr + kk * 33 + 4 * c;
        d[0] = v[i].x * gsc; d[1] = v[i].y * gsc; d[2] = v[i].z * gsc; d[3] = v[i].w * gsc;
    }
    LDS_WAIT(); asm volatile("" ::: "memory");
    const int c8 = lane & 7;
#pragma unroll
    for (int j = 0; j < 4; ++j) { const int nn = (lane >> 3) + 8 * j; const LAS float* s = scr + (8 * c8) * 33 + nn;
        v4u o; o.x = pk2(s[0 * 33], s[1 * 33]); o.y = pk2(s[2 * 33], s[3 * 33]); o.z = pk2(s[4 * 33], s[5 * 33]); o.w = pk2(s[6 * 33], s[7 * 33]);
        const int row = row_off + n0 + nn;
        *(GAS v4u*)(WT + (size_t)(row >> 8) * ((size_t)256 * K) + (size_t)(kb * 16384 + (row & 255) * 64 + 8 * c8)) = o; }
    LDS_WAIT(); asm volatile("" ::: "memory");
}
__device__ __forceinline__ void sincos_acc(float angf, float& sn_, float& cs_) {
    const double a = (double)angf;
    const double k = __builtin_rint(a * 0.15915494309189535);
    double r = __builtin_fma(-k, 6.283185307179586, a); r = __builtin_fma(-k, 2.4492935982947064e-16, r);
    const double x = r * 0.25, x2 = x * x;
    const double sn = x * (1.0 + x2 * (-1.0 / 6.0 + x2 * (1.0 / 120.0 + x2 * (-1.0 / 5040.0 + x2 * (1.0 / 362880.0 + x2 * (-1.0 / 39916800.0 + x2 * (1.0 / 6227020800.0)))))));
    const double cs = 1.0 + x2 * (-0.5 + x2 * (1.0 / 24.0 + x2 * (-1.0 / 720.0 + x2 * (1.0 / 40320.0 + x2 * (-1.0 / 3628800.0 + x2 * (1.0 / 479001600.0 + x2 * (-1.0 / 87178291200.0)))))));
    const double s2 = 2.0 * sn * cs, c2 = 1.0 - 2.0 * sn * sn;
    const double s4 = 2.0 * s2 * c2, c4 = 1.0 - 2.0 * s2 * s2;
    sn_ = (float)s4; cs_ = (float)c4;
}

__device__ __forceinline__ void p0_prologue(Frame& F, const Params& P) {
    LAS float* scr = (LAS float*)(F.lds + RING_OFF + F.wave * 16384);
    const int gw = F.vcu * NWAVES + F.wave, NGW = F.G * NWAVES;
    bf16* WinT = (bf16*)(F.ws + WS_WIN); bf16* WoaT = (bf16*)(F.ws + WS_WOA); bf16* WobT = (bf16*)(F.ws + WS_WOB); bf16* WkvqT = (bf16*)(F.ws + WS_WKVQ);
    bf16* WupT = (bf16*)(F.ws + WS_WUP); bf16* WdnT = (bf16*)(F.ws + WS_WDN);
    constexpr int I0 = (D / 64) * (NIN_PAD / 32), I1 = (D / 64) * (D / 32), I2 = I1, I3 = (D / 64) * (1024 / 32), I4 = (D / 64) * (6144 / 32), I5 = (D / 64) * (FF / 32), I6 = (FF / 64) * (D / 32);
    constexpr int NITEMS = I0 + I1 + I2 + I3 + I4 + I5 + I6;
    for (int it = gw; it < NITEMS; it += NGW) {
        int r = it;
        if (r < I0) { tr_item(P.in[2], D, NIN, NIN_PAD, P.in[1], WinT, 0, scr, r, F.lane); continue; } r -= I0;
        if (r < I1) { tr_item(P.in[3], D, D, D, nullptr, WoaT, 0, scr, r, F.lane); continue; } r -= I1;
        if (r < I2) { tr_item(P.in[8], D, D, D, nullptr, WobT, 0, scr, r, F.lane); continue; } r -= I2;
        if (r < I3) { tr_item(P.in[5], D, 1024, 1024, P.in[4], WkvqT, 0, scr, r, F.lane); continue; } r -= I3;
        if (r < I4) { tr_item(P.in[7], D, 6144, 6144, P.in[6], WkvqT, 1024, scr, r, F.lane); continue; } r -= I4;
        if (r < I5) { tr_item(P.in[10], D, FF, FF, P.in[9], WupT, 0, scr, r, F.lane); continue; } r -= I5;
        tr_item(P.in[11], FF, D, D, nullptr, WdnT, 0, scr, r, F.lane);
    }
    bf16* hb = (bf16*)(F.ws + WS_HB); pg8::ssq_t* ss = (pg8::ssq_t*)(F.ws + WS_SS);
    for (int m = gw; m < S; m += NGW) {
        const GAS f32x4* xr = (const GAS f32x4*)(P.in[0] + (size_t)m * D) + F.lane;
        f32x4 v[8]; float s = 0.f;
#pragma unroll
        for (int j = 0; j < 8; ++j) { v[j] = xr[64 * j]; s += (v[j].x * v[j].x + v[j].y * v[j].y) + (v[j].z * v[j].z + v[j].w * v[j].w); }
        s = wave_sum(s);
        GAS v2u* o8 = (GAS v2u*)(hb + (size_t)(m >> 8) * (256 * D) + (size_t)((F.lane >> 4) * 16384 + (m & 255) * 64 + 4 * (F.lane & 15)));
#pragma unroll
        for (int j = 0; j < 8; ++j) { v2u w; w.x = pk2(v[j].x, v[j].y); w.y = pk2(v[j].z, v[j].w); o8[(4 * 16384 / 4) * j] = w; }
        if (F.lane == 0) ss[m] = pg8::ss_fix(s);
    }
    { const int gt = gw * 64 + F.lane, NT = NGW * 64; for (int i = gt; i < 4 * S; i += NT) ss[S + i] = 0ull; }
    { float* cosh = (float*)(F.ws + WS_COSH); float* sinh = (float*)(F.ws + WS_SINH); float* cosi = (float*)(F.ws + WS_COSI); float* sini = (float*)(F.ws + WS_SINI);
      const int gt = gw * 64 + F.lane, NT = NGW * 64;
      float ivh = P.invh[0], ivi = P.invi[0];
#pragma unroll
      for (int kk = 1; kk < 16; ++kk) ivh = ((gt & 15) == kk) ? P.invh[kk] : ivh;
#pragma unroll
      for (int kk = 1; kk < 8; ++kk) ivi = ((gt & 7) == kk) ? P.invi[kk] : ivi;
      for (int i = gt; i < S * 16; i += NT) { const int pos = i >> 4; float sn, cs; sincos_acc((float)pos * ivh, sn, cs); cosh[i] = cs; sinh[i] = sn; }
      for (int i = gt; i < S * 8; i += NT) { const int pos = i >> 3; float sn, cs; sincos_acc((float)pos * ivi, sn, cs); cosi[i] = cs; sini[i] = sn; }
    }
}
__device__ __forceinline__ void p7_convert_mlp2(Frame& F, const Params& P) {
    LAS float* scr = (LAS float*)(F.lds + RING_OFF + F.wave * 16384);
    const int gw = F.vcu * NWAVES + F.wave, NGW = F.G * NWAVES;
    bf16* WupT = (bf16*)(F.ws + WS_WUP); bf16* WdnT = (bf16*)(F.ws + WS_WDN);
    constexpr int I5 = (D / 64) * (FF / 32), I6 = (FF / 64) * (D / 32);
    for (int it = gw; it < I5 + I6; it += NGW) {
        int r = it;
        if (r < I5) { tr_item(P.in[10] + (size_t)D * FF, D, FF, FF, P.in[9] + D, WupT, 0, scr, r, F.lane); continue; } r -= I5;
        tr_item(P.in[11] + (size_t)FF * D, FF, D, D, nullptr, WdnT, 0, scr, r, F.lane);
    }
}

__device__ __forceinline__ void p1_kiwi(Frame& F, const float* cosi, const float* sini) {
    const bf16* hb = (const bf16*)(F.ws + WS_HB); const bf16* Wt = (const bf16*)(F.ws + WS_WIN) + (size_t)16 * 256 * D;
    const pg8::ssq_t* ss = (const pg8::ssq_t*)(F.ws + WS_SS); bf16* KI = (bf16*)(F.ws + WS_KI); float* WI = (float*)(F.ws + WS_WI);
    LAS f32x4* red = (LAS f32x4*)(F.lds + RING_OFF);
    const int lane = F.lane, fr = lane & 15, fq = lane >> 4, w = F.wave;
    for (int blk = (int)blockIdx.x; blk < S / 64; blk += F.G) {
        const int row0 = blk * 64;
        const bf16* ap = hb + (size_t)(row0 >> 8) * (256 * D) + (size_t)(((row0 & 255) + fr) * 64 + 8 * fq);
        const bf16* wp = Wt + fr * 64 + 8 * fq;
        f32x4 acc[4][5];
#pragma unroll
        for (int rb = 0; rb < 4; ++rb)
#pragma unroll
            for (int cb = 0; cb < 5; ++cb) acc[rb][cb] = (f32x4){0.f, 0.f, 0.f, 0.f};
        bf16x8 a0[4], b0[5], a1[4], b1[5];
#define KIWI_LOAD(a, b, st) do { const int k = w * 256 + (st) * 32, ko = (k >> 6) * 16384 + (k & 63); _Pragma("unroll") for (int rb = 0; rb < 4; ++rb) a[rb] = *(const bf16x8*)(ap + rb * 1024 + ko); \
            _Pragma("unroll") for (int cb = 0; cb < 5; ++cb) b[cb] = *(const bf16x8*)(wp + cb * 1024 + ko); __builtin_amdgcn_sched_barrier(0); } while (0)
#define KIWI_MMA(a, b) do { _Pragma("unroll") for (int rb = 0; rb < 4; ++rb) _Pragma("unroll") for (int cb = 0; cb < 5; ++cb) acc[rb][cb] = __builtin_amdgcn_mfma_f32_16x16x32_bf16(b[cb], a[rb], acc[rb][cb], 0, 0, 0); \
            __builtin_amdgcn_sched_barrier(0); } while (0)
        KIWI_LOAD(a0, b0, 0);
#pragma unroll 1
        for (int it = 0; it < 4; ++it) {
            KIWI_LOAD(a1, b1, 2 * it + 1); KIWI_MMA(a0, b0);
            if (it < 3) KIWI_LOAD(a0, b0, 2 * it + 2);
            KIWI_MMA(a1, b1);
        }
#undef KIWI_LOAD
#undef KIWI_MMA
#pragma unroll
        for (int r = 0; r < 2; ++r) {
#pragma unroll
            for (int jb = 0; jb < 2; ++jb)
#pragma unroll
                for (int cb = 0; cb < 5; ++cb) red[(w * 10 + jb * 5 + cb) * 64 + lane] = acc[2 * r + jb][cb];
            __syncthreads();
            for (int item = w; item < 10; item += 8) {
                f32x4 v = red[item * 64 + lane];
#pragma unroll
                for (int ww = 1; ww < 8; ++ww) v += red[(ww * 10 + item) * 64 + lane];
                const int jb = item / 5, cb = item - 5 * jb, row = row0 + 16 * (2 * r + jb) + fr;
                const float rs = pg8::rstd_of(ss[row]);
                if (cb < 4) {
                    v = v * rs;
                    if (cb == 0) { const f32x4 c4 = *(const f32x4*)(cosi + (size_t)row * 8 + 4 * (fq & 1)), s4 = *(const f32x4*)(sini + (size_t)row * 8 + 4 * (fq & 1));
                                   f32x4 p; p[0] = __shfl_xor(v[0], 32); p[1] = __shfl_xor(v[1], 32); p[2] = __shfl_xor(v[2], 32); p[3] = __shfl_xor(v[3], 32);
                                   v = (fq < 2) ? (v * c4 - p * s4) : (v * c4 + p * s4); }
                    bf16* dst = KI + ((size_t)(((row >> 5) * 4 + cb) * 32 + (row & 31)) * 2 + (fq >> 1)) * 8 + 4 * (fq & 1);
                    *(pg8::u32x2*)dst = pg8::pack4(v);
                } else {
                    *(f32x4*)(WI + (size_t)row * 16 + 4 * fq) = v * (rs * 0.03125f);
                }
            }
            __syncthreads();
        }
    }
}

constexpr int CAP = 512;
__device__ __forceinline__ unsigned f2ord(float f) { const unsigned u = __float_as_uint(f); return (u & 0x80000000u) ? ~u : (u | 0x80000000u); }
__device__ __forceinline__ float ord2f(unsigned k) { const unsigned u = (k & 0x80000000u) ? (k & 0x7fffffffu) : ~k; return __uint_as_float(u); }
template <int CTRL> __device__ __forceinline__ unsigned dpp_movu(unsigned v) { return (unsigned)__builtin_amdgcn_update_dpp(0u, v, CTRL, 0xf, 0xf, false); }
__device__ __forceinline__ unsigned umax2(unsigned a, unsigned b) { return a > b ? a : b; }
__device__ __forceinline__ unsigned wave_max_u32(unsigned v) {
    v = umax2(v, dpp_movu<0x128>(v)); v = umax2(v, dpp_movu<0x124>(v)); v = umax2(v, dpp_movu<0x122>(v)); v = umax2(v, dpp_movu<0x121>(v));
    { const auto r = __builtin_amdgcn_permlane16_swap(v, v, false, false); v = umax2(r[0], r[1]); }
    { const auto r = __builtin_amdgcn_permlane32_swap(v, v, false, false); v = umax2(r[0], r[1]); }
    return v;
}
template <bool EXACT> __device__ __forceinline__ void topk_select(LAS float* s_, LAS unsigned* i_, int& cnt, float& tau, int lane) {
    const int n = cnt;
    unsigned k[8], ix[8];
#pragma unroll
    for (int j = 0; j < 8; ++j) { const int e = lane + 64 * j; const bool v = e < n; k[j] = v ? f2ord(s_[e]) : 0u; ix[j] = i_[e]; }
    unsigned mxk = k[0], mnk = ~k[0];
#pragma unroll
    for (int j = 1; j < 8; ++j) { mxk = umax2(mxk, k[j]); mnk = umax2(mnk, (lane + 64 * j < n) ? ~k[j] : 0u); }
    mxk = (unsigned)__builtin_amdgcn_readfirstlane((int)wave_max_u32(mxk)); mnk = ~(unsigned)__builtin_amdgcn_readfirstlane((int)wave_max_u32(mnk));
    const unsigned diff = mxk ^ mnk;
    unsigned T = mnk; int need_eq = TOPK;
    if (diff != 0u) {
        const int top = 31 - __builtin_clz(diff);
        T = (top == 31) ? 0u : ((mxk >> (top + 1)) << (top + 1));
        bool coarse_done = false;
        for (int bit = top; bit >= 0; --bit) {
            const unsigned cand = T | (1u << bit);
            int c = 0;
#pragma unroll
            for (int j = 0; j < 8; ++j) c += __popcll(__ballot(k[j] >= cand));
            if (c >= TOPK) { T = cand; if (c == TOPK || (!EXACT && c <= TOPK + 64)) { coarse_done = true; break; } }
        }
        if (!EXACT && coarse_done) need_eq = 1 << 20;
    }
    int ngt = 0;
#pragma unroll
    for (int j = 0; j < 8; ++j) ngt += __popcll(__ballot(k[j] > T));
    if (need_eq == TOPK) need_eq = TOPK - ngt;
    int offg = 0, offe = 0;
    const unsigned long long lm = (1ull << lane) - 1ull;
#pragma unroll
    for (int j = 0; j < 8; ++j) {
        const bool g = k[j] > T, e = k[j] == T;
        const unsigned long long bg = __ballot(g), be = __ballot(e);
        const int pg = offg + __popcll(bg & lm), pe = offe + __popcll(be & lm);
        if (g) { s_[pg] = ord2f(k[j]); i_[pg] = ix[j]; }
        else if (e && pe < need_eq) { s_[ngt + pe] = ord2f(k[j]); i_[ngt + pe] = ix[j]; }
        offg += __popcll(bg); offe += __popcll(be);
    }
    cnt = ngt + (offe < need_eq ? offe : need_eq); tau = ord2f(T);
    LDS_WAIT();
}
__device__ __forceinline__ float relu_f(float x) { const int b = __float_as_int(x); return __int_as_float(b > 0 ? b : 0); }
__device__ __forceinline__ float idx_score(const f32x16& acc, const float (&w)[16]) {
    float sc = 0.f;
#pragma unroll
    for (int i = 0; i < 16; ++i) sc = __builtin_fmaf(w[i], relu_f(acc[i]), sc);
    return sc;
}
__device__ __forceinline__ void idx_tile_tail(float sc, int (&cnt)[2], float (&tau)[2], LAS float* bs, LAS unsigned* bi, int key, int tq0, int r, int hh, int lane) {
    const float mytau = hh ? tau[1] : tau[0];
    const bool pass = (key <= tq0 + hh) && (sc > mytau);
    const unsigned long long mk = __ballot(pass);
    if (mk) {
        const unsigned m0 = (unsigned)mk, m1 = (unsigned)(mk >> 32);
        const unsigned mym = hh ? m1 : m0;
        const int pos = (hh ? cnt[1] : cnt[0]) + __popc(mym & ((1u << r) - 1u));
        if (pass) { bs[hh * CAP + pos] = sc; bi[hh * CAP + pos] = (unsigned)key; }
        cnt[0] += __popc(m0); cnt[1] += __popc(m1);
    }
}
__device__ __forceinline__ void idx_tile_tail2(float s0, float s1, int (&cnt)[2][2], float (&tau)[2][2], LAS float* bs, LAS unsigned* bi, int key, int q0, int r, int hh, int lane) {
    const float t0 = hh ? tau[0][1] : tau[0][0], t1 = hh ? tau[1][1] : tau[1][0];
    const bool p0 = (key <= q0 + hh) && (s0 > t0), p1 = (key <= q0 + 2 + hh) && (s1 > t1);
    const unsigned long long k0 = __ballot(p0), k1 = __ballot(p1);
    if (k0 | k1) {
        const unsigned a0 = (unsigned)k0, a1 = (unsigned)(k0 >> 32), b0 = (unsigned)k1, b1 = (unsigned)(k1 >> 32);
        const int na0 = __popc(a0), na1 = __popc(a1), nb0 = __popc(b0), nb1 = __popc(b1);
        const int pa = (int)__builtin_amdgcn_mbcnt_hi(a1, __builtin_amdgcn_mbcnt_lo(a0, 0u)) - (hh ? na0 : 0) + (hh ? cnt[0][1] : cnt[0][0]);
        const int pb = (int)__builtin_amdgcn_mbcnt_hi(b1, __builtin_amdgcn_mbcnt_lo(b0, 0u)) - (hh ? nb0 : 0) + (hh ? cnt[1][1] : cnt[1][0]);
        if (p0) { bs[hh * CAP + pa] = s0; bi[hh * CAP + pa] = (unsigned)key; }
        if (p1) { bs[(2 + hh) * CAP + pb] = s1; bi[(2 + hh) * CAP + pb] = (unsigned)key; }
        cnt[0][0] += na0; cnt[0][1] += na1; cnt[1][0] += nb0; cnt[1][1] += nb1;
    }
}
template <bool EXACT> __device__ __forceinline__ void idx_reselect(int (&cnt)[2][2], float (&tau)[2][2], LAS float* bs, LAS unsigned* bi, int limit, int lane) {
#pragma unroll 1
    for (int qs = 0; qs < 4; ++qs) {
        int c = qs == 0 ? cnt[0][0] : (qs == 1 ? cnt[0][1] : (qs == 2 ? cnt[1][0] : cnt[1][1]));
        if (c > limit) {
            float t = 0.f;
            topk_select<EXACT>(bs + qs * CAP, bi + qs * CAP, c, t, lane);
            cnt[0][0] = qs == 0 ? c : cnt[0][0]; cnt[0][1] = qs == 1 ? c : cnt[0][1]; cnt[1][0] = qs == 2 ? c : cnt[1][0]; cnt[1][1] = qs == 3 ? c : cnt[1][1];
            tau[0][0] = qs == 0 ? t : tau[0][0]; tau[0][1] = qs == 1 ? t : tau[0][1]; tau[1][0] = qs == 2 ? t : tau[1][0]; tau[1][1] = qs == 3 ? t : tau[1][1];
        }
    }
}
template <int PMODE> __device__ __forceinline__ void p2_indexer(Frame& F) {
    const bf16* QI = (const bf16*)(F.ws + WS_QI); const bf16* KI = (const bf16*)(F.ws + WS_KI); const float* WI = (const float*)(F.ws + WS_WI);
    unsigned short* sel = (unsigned short*)(F.ws + WS_SEL);
    const int lane = F.lane, r = lane & 31, hh = lane >> 5;
    LAS float* bs = (LAS float*)(F.lds + RING_OFF + F.wave * 16384);
    LAS unsigned* bi = (LAS unsigned*)(F.lds + RING_OFF + F.wave * 16384 + 8192);
    const int gw = F.vcu * NWAVES + F.wave, NGW = F.G * NWAVES;
    constexpr int NT = S / 4;
    for (int it = 0;; ++it) {
        const int kk = it * NGW + ((it & 1) ? (NGW - 1 - gw) : gw);
        if (it * NGW >= NT) break;
        if (kk >= NT) continue;
        const int task = NT - 1 - kk, q0 = task * 4;
        bf16x8 Af[2][4]; float w[2][16];
#pragma unroll
        for (int pi = 0; pi < 2; ++pi) {
            const int qa = q0 + 2 * pi + ((r >> 2) & 1), head = (r & 3) + 4 * (r >> 3);
#pragma unroll
            for (int ks = 0; ks < 4; ++ks) Af[pi][ks] = *(const bf16x8*)(QI + pg8::tm_off(qa, head * 64 + 16 * ks + 8 * hh, 1024));
#pragma unroll
            for (int i = 0; i < 4; ++i) { const f32x4 t = *(const f32x4*)(WI + (size_t)(q0 + 2 * pi + hh) * 16 + 4 * i); w[pi][4 * i] = t[0]; w[pi][4 * i + 1] = t[1]; w[pi][4 * i + 2] = t[2]; w[pi][4 * i + 3] = t[3]; }
        }
        int cnt[2][2] = {{0, 0}, {0, 0}}; float tau[2][2];
        tau[0][0] = tau[0][1] = tau[1][0] = tau[1][1] = -__builtin_inff();
        const int ntile = (q0 + 3) / 32 + 1;
        const bf16* kb = KI + (size_t)(r * 2 + hh) * 8;
        bf16x8 Bf[4];
#define P2_LOADB(t_) do { const int tc_ = (t_) < ntile ? (t_) : ntile - 1; const bf16* kn_ = kb + (size_t)tc_ * 2048; \
            _Pragma("unroll") for (int ks = 0; ks < 4; ++ks) Bf[ks] = *(const bf16x8*)(kn_ + ks * 512); } while (0)
#define P2_MFMA(x0_, x1_) do { _Pragma("unroll") for (int i = 0; i < 16; ++i) { x0_[i] = 0.f; x1_[i] = 0.f; } \
            _Pragma("unroll") for (int ks = 0; ks < 4; ++ks) x0_ = __builtin_amdgcn_mfma_f32_32x32x16_bf16(Af[0][ks], Bf[ks], x0_, 0, 0, 0); \
            _Pragma("unroll") for (int ks = 0; ks < 4; ++ks) x1_ = __builtin_amdgcn_mfma_f32_32x32x16_bf16(Af[1][ks], Bf[ks], x1_, 0, 0, 0); } while (0)
#define P2_TAIL(x0_, x1_, t_) do { const int key = (t_) * 32 + r; \
            if (PMODE == 0) { const float s0 = idx_score(x0_, w[0]), s1 = idx_score(x1_, w[1]); \
                idx_tile_tail2(s0, s1, cnt, tau, bs, bi, key, q0, r, hh, lane); \
                if ((cnt[0][0] > CAP - 32) | (cnt[0][1] > CAP - 32) | (cnt[1][0] > CAP - 32) | (cnt[1][1] > CAP - 32)) idx_reselect<false>(cnt, tau, bs, bi, CAP - 32, lane); } \
            else if (PMODE == 1) { const float s0 = idx_score(x0_, w[0]), s1 = idx_score(x1_, w[1]); asm volatile("" :: "v"(s0), "v"(s1), "v"(key)); } \
            else { asm volatile("" :: "v"(x0_[0]), "v"(x1_[0]), "v"(x0_[15]), "v"(x1_[15]), "v"(key)); } } while (0)
        f32x16 a0, a1, b0, b1;
        P2_LOADB(0); P2_MFMA(a0, a1); P2_LOADB(1);
        for (int tile = 0; tile < ntile; tile += 2) {
            P2_MFMA(b0, b1); P2_LOADB(tile + 2);
            P2_TAIL(a0, a1, tile);
            if (tile + 1 >= ntile) break;
            P2_MFMA(a0, a1); P2_LOADB(tile + 3);
            P2_TAIL(b0, b1, tile + 1);
        }
#undef P2_LOADB
#undef P2_MFMA
#undef P2_TAIL
        if (PMODE == 0) {
            idx_reselect<true>(cnt, tau, bs, bi, TOPK, lane);
            LDS_WAIT();
#pragma unroll 1
            for (int qs = 0; qs < 4; ++qs) {
                const int n = qs == 0 ? cnt[0][0] : (qs == 1 ? cnt[0][1] : (qs == 2 ? cnt[1][0] : cnt[1][1]));
#pragma unroll
                for (int j = 0; j < 4; ++j) { const int e = lane + 64 * j; if (e < n) sel[(size_t)(q0 + qs) * TOPK + e] = (unsigned short)bi[qs * CAP + e]; }
            }
        }
        LDS_WAIT();
    }
}

__device__ __forceinline__ long pk_long(unsigned lo, unsigned hi) { return (long)(((unsigned long long)hi << 32) | (unsigned long long)lo); }
typedef int v2i __attribute__((ext_vector_type(2)));
__device__ __forceinline__ void p3_sparse_fp8(Frame& F) {
    const unsigned char* Qp = F.ws + WS_QA; const unsigned char* K8 = F.ws + WS_KA; const unsigned char* V8 = F.ws + WS_VA;
    const unsigned short* sel = (const unsigned short*)(F.ws + WS_SEL); bf16* Op = (bf16*)(F.ws + WS_OA);
    LAS float* Pt = (LAS float*)(F.lds + RING_OFF + F.wave * 16384);
    LAS unsigned* Sl = (LAS unsigned*)(F.lds + RING_OFF + F.wave * 16384 + 4096);
    LAS unsigned char* Kst = F.lds + RING_OFF + F.wave * 16384 + 8192;
    const int lane = F.lane, c16 = lane & 15, kg = lane >> 4, e8 = lane >> 3, ch = lane & 7;
    const int gw = F.vcu * NWAVES + F.wave, NGW = F.G * NWAVES;
    const float scale = 0.08838834764831845f * 1.4426950408889634f;
    unsigned short selv[4]; v4u qv[2];
    { const int task = gw; if (task < 4 * S) { const int g = task / S, t = task - g * S;
#pragma unroll
        for (int i = 0; i < 4; ++i) selv[i] = sel[(size_t)t * TOPK + lane + 64 * i];
        { const unsigned char* q8 = Qp + pg8::tm_off(t, (4 * g + (c16 & 3)) * 128 + 32 * kg, 2048); qv[0] = *(const GAS v4u*)q8; qv[1] = *(const GAS v4u*)(q8 + 16); } } }
    for (int task = gw; task < 4 * S; task += NGW) {
        const int g = task / S, t = task - g * S;
        const int n = t + 1 < TOPK ? t + 1 : TOPK;
#pragma unroll
        for (int i = 0; i < 4; ++i) { const int e = lane + 64 * i; Sl[e] = e < n ? (unsigned)selv[i] : 0x80000000u; }
        long Aq[4];
        Aq[0] = (c16 < 4) ? pk_long(qv[0].x, qv[0].y) : 0l; Aq[1] = (c16 < 4) ? pk_long(qv[0].z, qv[0].w) : 0l;
        Aq[2] = (c16 < 4) ? pk_long(qv[1].x, qv[1].y) : 0l; Aq[3] = (c16 < 4) ? pk_long(qv[1].z, qv[1].w) : 0l;
        LDS_WAIT();
        const unsigned char* kb2 = K8 + (size_t)g * S * 128 + 16 * ch;
        const unsigned char* vb2 = V8 + (size_t)g * S * 128 + 16 * ch;
        float mx[4] = {-__builtin_inff(), -__builtin_inff(), -__builtin_inff(), -__builtin_inff()};
#pragma unroll
        for (int half = 0; half < 2; ++half) {
            v4u kq[16];
#pragma unroll
            for (int u = 0; u < 16; ++u) { const unsigned pos = Sl[128 * half + 8 * u + e8] & 0x7fffffffu; kq[u] = *(const GAS v4u*)(kb2 + (size_t)pos * 128); }
            __builtin_amdgcn_sched_barrier(0);
#pragma unroll
            for (int r2 = 0; r2 < 2; ++r2) {
#pragma unroll
                for (int uu = 0; uu < 8; ++uu) { const int ksl = 8 * uu + e8; *(LAS v4u*)(Kst + ksl * 128 + 16 * (ch ^ ((ksl >> 1) & 7))) = kq[8 * r2 + uu]; }
#pragma unroll
                for (int g4 = 0; g4 < 4; ++g4) {
                    const int ksl = 16 * g4 + c16, e = 128 * half + 64 * r2 + ksl, f = (ksl >> 1) & 7;
                    const v4u k0 = *(const LAS v4u*)(Kst + ksl * 128 + 16 * ((2 * kg) ^ f)), k1 = *(const LAS v4u*)(Kst + ksl * 128 + 16 * ((2 * kg + 1) ^ f));
                    const bool valid = (Sl[e] >> 31) == 0u;
                    f32x4 a = (f32x4){0.f, 0.f, 0.f, 0.f};
                    a = __builtin_amdgcn_mfma_f32_16x16x32_fp8_fp8(Aq[0], pk_long(k0.x, k0.y), a, 0, 0, 0);
                    a = __builtin_amdgcn_mfma_f32_16x16x32_fp8_fp8(Aq[1], pk_long(k0.z, k0.w), a, 0, 0, 0);
                    a = __builtin_amdgcn_mfma_f32_16x16x32_fp8_fp8(Aq[2], pk_long(k1.x, k1.y), a, 0, 0, 0);
                    a = __builtin_amdgcn_mfma_f32_16x16x32_fp8_fp8(Aq[3], pk_long(k1.z, k1.w), a, 0, 0, 0);
#pragma unroll
                    for (int j = 0; j < 4; ++j) { const float sv = valid ? a[j] * scale : -__builtin_inff(); mx[j] = __builtin_fmaxf(mx[j], sv); if (kg == 0) Pt[j * 256 + e] = sv; }
                }
            }
            __builtin_amdgcn_sched_barrier(0);
        }
        v4u vA[8], vB[8];
#pragma unroll
        for (int u = 0; u < 8; ++u) { const unsigned pos = Sl[8 * u + e8] & 0x7fffffffu; vA[u] = *(const GAS v4u*)(vb2 + (size_t)pos * 128); }
#pragma unroll
        for (int j = 0; j < 4; ++j) {
            float v = mx[j];
            mx[j] = bcast_row0(row_max16(v));
        }
        LDS_WAIT();
        float sum[4] = {0.f, 0.f, 0.f, 0.f};
#pragma unroll
        for (int j = 0; j < 4; ++j)
#pragma unroll
            for (int i = 0; i < 4; ++i) {
                const int e = lane + 64 * i;
                const float pr = __builtin_amdgcn_exp2f(Pt[j * 256 + e] - mx[j] + 8.0f);
                sum[j] += pr; Pt[j * 256 + e] = pr;
            }
#pragma unroll
        for (int j = 0; j < 4; ++j) sum[j] = wave_sum(sum[j]);
        { const int tn = task + NGW; if (tn < 4 * S) { const int g2 = tn / S, t2 = tn - g2 * S;
#pragma unroll
            for (int i = 0; i < 4; ++i) selv[i] = sel[(size_t)t2 * TOPK + lane + 64 * i];
            { const unsigned char* q8 = Qp + pg8::tm_off(t2, (4 * g2 + (c16 & 3)) * 128 + 32 * kg, 2048); qv[0] = *(const GAS v4u*)q8; qv[1] = *(const GAS v4u*)(q8 + 16); } } }
        LDS_WAIT();
        f32x4 oacc[8];
#pragma unroll
        for (int dt = 0; dt < 8; ++dt) oacc[dt] = (f32x4){0.f, 0.f, 0.f, 0.f};
#pragma unroll
        for (int c4 = 0; c4 < 4; ++c4) {
#pragma unroll
            for (int uu = 0; uu < 8; ++uu) { const int ksl = 8 * uu + e8; *(LAS v4u*)(Kst + ksl * 128 + 16 * (ch ^ ((ksl >> 1) & 7))) = (c4 & 1) ? vB[uu] : vA[uu]; }
            if (c4 < 3) {
#pragma unroll
                for (int u = 0; u < 8; ++u) { const unsigned pos = Sl[64 * (c4 + 1) + 8 * u + e8] & 0x7fffffffu; const v4u vv = *(const GAS v4u*)(vb2 + (size_t)pos * 128); if (c4 & 1) vA[u] = vv; else vB[u] = vv; }
            }
#pragma unroll
            for (int ks2 = 0; ks2 < 2; ++ks2) {
                const LAS float* pp = Pt + (c16 & 3) * 256 + 64 * c4 + 32 * ks2 + 8 * kg;
                const f32x4 p0 = *(const LAS f32x4*)pp, p1 = *(const LAS f32x4*)(pp + 4);
                int w0 = __builtin_amdgcn_cvt_pk_fp8_f32(p0[0], p0[1], 0, false); w0 = __builtin_amdgcn_cvt_pk_fp8_f32(p0[2], p0[3], w0, true);
                int w1 = __builtin_amdgcn_cvt_pk_fp8_f32(p1[0], p1[1], 0, false); w1 = __builtin_amdgcn_cvt_pk_fp8_f32(p1[2], p1[3], w1, true);
                const long Ap = (c16 < 4) ? pk_long((unsigned)w0, (unsigned)w1) : 0l;
                const int ksl = 32 * ks2 + 8 * kg + (c16 >> 1), f = (ksl >> 1) & 7;
                const LAS unsigned char* vrow = Kst + ksl * 128 + 8 * (c16 & 1);
#pragma unroll
                for (int dt = 0; dt < 8; ++dt) {
                    const v2i bv = __builtin_amdgcn_ds_read_tr8_b64_v2i32((LAS v2i*)(vrow + 16 * (dt ^ f)));
                    oacc[dt] = __builtin_amdgcn_mfma_f32_16x16x32_fp8_fp8(Ap, pk_long((unsigned)bv.x, (unsigned)bv.y), oacc[dt], 0, 0, 0);
                }
            }
        }
        LDS_WAIT();
        if (kg == 0) {
#pragma unroll
            for (int j = 0; j < 4; ++j) { const float inv = 1.0f / sum[j];
#pragma unroll
                for (int dt = 0; dt < 8; ++dt) Pt[j * 128 + 16 * dt + c16] = oacc[dt][j] * inv; }
        }
        LDS_WAIT();
        { const LAS float* op = Pt + (lane >> 4) * 128 + 8 * (lane & 15);
          const f32x4 a = *(const LAS f32x4*)op, b = *(const LAS f32x4*)(op + 4);
          v4u w; w.x = pk2(a[0], a[1]); w.y = pk2(a[2], a[3]); w.z = pk2(b[0], b[1]); w.w = pk2(b[2], b[3]);
          *(GAS v4u*)(Op + ktm_off(t, (4 * g + (lane >> 4)) * 128 + 8 * (lane & 15))) = w; }
        LDS_WAIT();
    }
}

constexpr size_t KC8_BYTES = (size_t)4 * 512 * 4096;
__device__ __forceinline__ unsigned pk4_fp8(float a, float b, float c, float d) { int w = __builtin_amdgcn_cvt_pk_fp8_f32(a, b, 0, false); return (unsigned)__builtin_amdgcn_cvt_pk_fp8_f32(c, d, w, true); }
__device__ __forceinline__ float bfu(unsigned short v) { return __uint_as_float(((unsigned)v) << 16); }
__device__ __forceinline__ void p8_kv_copies(Frame& F) {
    const bf16* Ks = (const bf16*)(F.ws + WS_KS); const bf16* Vs = (const bf16*)(F.ws + WS_VS);
    LAS unsigned short* scr = (LAS unsigned short*)(F.lds + RING_OFF + F.wave * 16384);
    const int gw = F.vcu * NWAVES + F.wave, NGW = F.G * NWAVES, lane = F.lane;
    constexpr int NITEM = 3 * 4 * (S / 32);
    for (int it = gw; it < NITEM; it += NGW) {
        const int tile = it & 511, kh = (it >> 9) & 3, g = it >> 11;
        const int sh = 2 * g, per = S >> sh;
        const int idx0 = tile * 32, rho = idx0 / per, kap0 = idx0 - rho * per;
        unsigned char* Kc = F.outb + (size_t)g * KC8_BYTES + (size_t)(kh * 512 + tile) * 4096;
        unsigned char* Vc = F.ws + (g == 0 ? WS_VT0 : (g == 1 ? WS_VT1 : WS_VT2)) + (size_t)(kh * 512 + tile) * 4096;
#pragma unroll
        for (int q = 0; q < 8; ++q) {
            const int ch = q * 64 + lane, key = ch >> 4, cc = ch & 15;
            const int pos = rho + ((kap0 + key) << sh);
            const v4u kv = *(const GAS v4u*)(Ks + pg8::tm_off(pos, kh * 128 + 8 * cc, 512));
            const v4u vv = *(const GAS v4u*)(Vs + pg8::tm_off(pos, kh * 128 + 8 * cc, 512));
            *(LAS v4u*)(scr + key * 128 + 8 * cc) = kv;
            *(LAS v4u*)(scr + 4096 + key * 128 + 8 * cc) = vv;
        }
        LDS_WAIT(); asm volatile("" ::: "memory");
#pragma unroll
        for (int q = 0; q < 4; ++q) {
            const int co = q * 64 + lane;
            { const int hh = co & 1, key = (co >> 1) & 31, ksp = co >> 6;
              const LAS unsigned short* s0 = scr + key * 128 + 32 * ksp + 8 * hh;
              v4u w; w.x = pk4_fp8(bfu(s0[0]), bfu(s0[1]), bfu(s0[2]), bfu(s0[3])); w.y = pk4_fp8(bfu(s0[4]), bfu(s0[5]), bfu(s0[6]), bfu(s0[7]));
              w.z = pk4_fp8(bfu(s0[16]), bfu(s0[17]), bfu(s0[18]), bfu(s0[19])); w.w = pk4_fp8(bfu(s0[20]), bfu(s0[21]), bfu(s0[22]), bfu(s0[23]));
              *(GAS v4u*)(Kc + 16 * co) = w; }
            { const int hh = co & 1, dimt = (co >> 1) & 31, dt = co >> 6, dim = 32 * dt + dimt;
              float e[16];
#pragma unroll
              for (int s2 = 0; s2 < 2; ++s2)
#pragma unroll
                  for (int j = 0; j < 8; ++j) e[8 * s2 + j] = bfu(scr[4096 + (16 * s2 + 8 * (j >> 2) + 4 * hh + (j & 3)) * 128 + dim]);
              v4u w; w.x = pk4_fp8(e[0], e[1], e[2], e[3]); w.y = pk4_fp8(e[4], e[5], e[6], e[7]); w.z = pk4_fp8(e[8], e[9], e[10], e[11]); w.w = pk4_fp8(e[12], e[13], e[14], e[15]);
              *(GAS v4u*)(Vc + 16 * co) = w; }
        }
        LDS_WAIT(); asm volatile("" ::: "memory");
    }
}

__device__ __forceinline__ void p9_dilated_dense(Frame& F) {
    const unsigned char* Q2 = F.ws + WS_Q2; bf16* O2 = (bf16*)(F.ws + WS_O2);
    const int lane = F.lane, ar = lane & 31, h = lane >> 5, qi = ar >> 2, rep = ar & 3;
    const int gw = F.vcu * NWAVES + F.wave, NGW = F.G * NWAVES;
    const float scale = 0.08838834764831845f * 1.4426950408889634f;
    for (int uid = gw; uid < 8192; uid += NGW) {
        const int c = uid & 15, b = (uid >> 4) & 127, kh = uid >> 11;
        const int t = c + 16 * (8 * b + qi);
        f32x16 O[4];
#pragma unroll
        for (int dt = 0; dt < 4; ++dt)
#pragma unroll
            for (int i = 0; i < 16; ++i) O[dt][i] = 0.f;
        float m = -1e30f, l = 0.f;
#pragma unroll 1
        for (int g = 0; g < 3; ++g) {
            const int sh = 2 * g, per = S >> sh;
            const int rho = (g == 0) ? 0 : ((g == 1) ? (c & 3) : c);
            const int tau = (t - rho) >> sh;
            const int wlo = tau > 128 ? tau - 128 : 0; const unsigned wrng = (unsigned)(tau - wlo);
            const int tau0 = (c + 128 * b - rho) >> sh, tau7 = tau0 + 7 * (16 >> sh);
            const int full_lo = tau7 > 128 ? tau7 - 128 : 0, full_hi = tau0;
            const int kap0 = (g == 0) ? (128 * b - 128) : ((g == 1) ? (32 * b - 128) : ((8 * b - 128) & ~31));
            const int ntile = (g == 0) ? 8 : 5;
            const int tmax = (per >> 5) - 1;
            const unsigned char* Kc = F.outb + (size_t)g * KC8_BYTES + ((size_t)kh * 512 + (size_t)rho * (per >> 5)) * 4096 + (ar * 2 + h) * 16;
            const unsigned char* Vc = F.ws + (g == 0 ? WS_VT0 : (g == 1 ? WS_VT1 : WS_VT2)) + ((size_t)kh * 512 + (size_t)rho * (per >> 5)) * 4096 + (ar * 2 + h) * 16;
            long Qf[8];
            { const unsigned char* qp = Q2 + pg8::tm_off(t, (g * 16 + 4 * kh + rep) * 128 + 8 * h, 6144);
#pragma unroll
              for (int ks = 0; ks < 8; ++ks) Qf[ks] = *(const GAS long*)(qp + 16 * ks); }
            const int tt0 = kap0 >= -31 ? 0 : ((-31 - kap0) + 31) / 32;
            v4u K0[4], V0[4], K1[4], V1[4], K2[4], V2[4]; long Pf[2]; f32x16 acc;
#define P9_GLD(dst_, ptr_, off_) asm volatile("global_load_dwordx4 %0, %1, off offset:" #off_ : "=v"(dst_) : "v"(ptr_) : "memory")
#define P9_LOAD(KF_, VF_, tt_) do { int ti_ = (kap0 + 32 * (tt_)) >> 5; ti_ = ti_ < 0 ? 0 : (ti_ > tmax ? tmax : ti_); const unsigned char* kp_ = Kc + (size_t)ti_ * 4096; const unsigned char* vp_ = Vc + (size_t)ti_ * 4096; \
                P9_GLD(KF_[0], kp_, 0); P9_GLD(KF_[1], kp_, 1024); P9_GLD(KF_[2], kp_, 2048); P9_GLD(KF_[3], kp_, 3072); P9_GLD(VF_[0], vp_, 0); P9_GLD(VF_[1], vp_, 1024); P9_GLD(VF_[2], vp_, 2048); P9_GLD(VF_[3], vp_, 3072); } while (0)
#define P9_WAIT(KF_, VF_) do { asm volatile("s_waitcnt vmcnt(16)" : "+v"(KF_[0]), "+v"(KF_[1]), "+v"(KF_[2]), "+v"(KF_[3]), "+v"(VF_[0]), "+v"(VF_[1]), "+v"(VF_[2]), "+v"(VF_[3]) :: "memory"); __builtin_amdgcn_sched_barrier(0); } while (0)
#define P9_BODY(KF_, VF_, tt_) do { \
                _Pragma("unroll") for (int i = 0; i < 16; ++i) acc[i] = 0.f; \
                _Pragma("unroll") for (int kp2 = 0; kp2 < 4; ++kp2) { acc = __builtin_amdgcn_mfma_f32_32x32x16_fp8_fp8(pk_long(KF_[kp2].x, KF_[kp2].y), Qf[2 * kp2], acc, 0, 0, 0); \
                    acc = __builtin_amdgcn_mfma_f32_32x32x16_fp8_fp8(pk_long(KF_[kp2].z, KF_[kp2].w), Qf[2 * kp2 + 1], acc, 0, 0, 0); } \
                const int kt = kap0 + 32 * (tt_); float mloc = -__builtin_inff(); \
                if (!(kt >= full_lo && kt + 31 <= full_hi)) {            \
                    const unsigned dbase = (unsigned)(kt + 4 * h - wlo); \
                    _Pragma("unroll") for (int i = 0; i < 16; ++i) acc[i] = (dbase + (unsigned)((i & 3) + 8 * (i >> 2)) <= wrng) ? acc[i] : -__builtin_inff(); } \
                _Pragma("unroll") for (int i = 0; i < 16; ++i) mloc = __builtin_fmaxf(mloc, acc[i]); \
                mloc = swap32_max(mloc) * scale;                         \
                const float mnew = __builtin_fmaxf(m, mloc); const float alpha = __builtin_amdgcn_exp2f(m - mnew); const float off = 8.0f - mnew; float ls = 0.f; \
                _Pragma("unroll") for (int i = 0; i < 16; ++i) { acc[i] = __builtin_amdgcn_exp2f(__builtin_fmaf(acc[i], scale, off)); ls += acc[i]; } \
                ls = swap32_sum(ls); l = l * alpha + ls; m = mnew; \
                _Pragma("unroll") for (int dt = 0; dt < 4; ++dt) _Pragma("unroll") for (int i = 0; i < 16; ++i) O[dt][i] *= alpha; \
                _Pragma("unroll") for (int s2 = 0; s2 < 2; ++s2) Pf[s2] = pk_long(pk4_fp8(acc[8 * s2 + 0], acc[8 * s2 + 1], acc[8 * s2 + 2], acc[8 * s2 + 3]), pk4_fp8(acc[8 * s2 + 4], acc[8 * s2 + 5], acc[8 * s2 + 6], acc[8 * s2 + 7])); \
                _Pragma("unroll") for (int dt = 0; dt < 4; ++dt) { O[dt] = __builtin_amdgcn_mfma_f32_32x32x16_fp8_fp8(pk_long(VF_[dt].x, VF_[dt].y), Pf[0], O[dt], 0, 0, 0); \
                    O[dt] = __builtin_amdgcn_mfma_f32_32x32x16_fp8_fp8(pk_long(VF_[dt].z, VF_[dt].w), Pf[1], O[dt], 0, 0, 0); } } while (0)
            asm volatile("" : "+v"(Qf[0]), "+v"(Qf[1]), "+v"(Qf[2]), "+v"(Qf[3]), "+v"(Qf[4]), "+v"(Qf[5]), "+v"(Qf[6]), "+v"(Qf[7]) :: "memory");
            P9_LOAD(K0, V0, tt0); P9_LOAD(K1, V1, tt0 + 1); P9_LOAD(K2, V2, tt0 + 2);
            for (int tt = tt0; tt < ntile; tt += 3) {
                P9_WAIT(K0, V0); P9_BODY(K0, V0, tt); P9_LOAD(K0, V0, tt + 3);
                if (tt + 1 >= ntile) break;
                P9_WAIT(K1, V1); P9_BODY(K1, V1, tt + 1); P9_LOAD(K1, V1, tt + 4);
                if (tt + 2 >= ntile) break;
                P9_WAIT(K2, V2); P9_BODY(K2, V2, tt + 2); P9_LOAD(K2, V2, tt + 5);
            }
            asm volatile("s_waitcnt vmcnt(0)" : "+v"(K0[0]), "+v"(K0[1]), "+v"(K0[2]), "+v"(K0[3]), "+v"(V0[0]), "+v"(V0[1]), "+v"(V0[2]), "+v"(V0[3]), "+v"(K1[0]), "+v"(K1[1]), "+v"(K1[2]), "+v"(K1[3]),
                         "+v"(V1[0]), "+v"(V1[1]), "+v"(V1[2]), "+v"(V1[3]), "+v"(K2[0]), "+v"(K2[1]), "+v"(K2[2]), "+v"(K2[3]), "+v"(V2[0]), "+v"(V2[1]), "+v"(V2[2]), "+v"(V2[3]) :: "memory");
#undef P9_GLD
#undef P9_LOAD
#undef P9_WAIT
#undef P9_BODY
        }
        const float inv = 1.0f / l;
        bf16* op = O2 + ktm_off(t, (4 * kh + rep) * 128 + 8 * h);
#pragma unroll
        for (int dt = 0; dt < 4; ++dt)
#pragma unroll
            for (int q = 0; q < 4; q += 2) {
                const unsigned x0 = pg8::cvt_pk_bf16(O[dt][4 * q] * inv, O[dt][4 * q + 1] * inv), x1 = pg8::cvt_pk_bf16(O[dt][4 * q + 2] * inv, O[dt][4 * q + 3] * inv);
                const unsigned y0 = pg8::cvt_pk_bf16(O[dt][4 * q + 4] * inv, O[dt][4 * q + 5] * inv), y1 = pg8::cvt_pk_bf16(O[dt][4 * q + 6] * inv, O[dt][4 * q + 7] * inv);
                const auto r0 = __builtin_amdgcn_permlane32_swap(x0, y0, false, false), r1 = __builtin_amdgcn_permlane32_swap(x1, y1, false, false);
                v4u w; w.x = r0[0]; w.y = r1[0]; w.z = r0[1]; w.w = r1[1];
                *(GAS v4u*)(op + (dt >> 1) * 16384 + 32 * (dt & 1) + 8 * q) = w;
            }
    }
}

__device__ __forceinline__ void p13_final(Frame& F, const Params& P) {
    const int gw = F.vcu * NWAVES + F.wave, NGW = F.G * NWAVES;
    const pg8::ssq_t* ss4 = (const pg8::ssq_t*)(F.ws + WS_SS) + 4 * S; const float* gn = P.in[12]; const bf16* hb = (const bf16*)(F.ws + WS_HB);
    f32x4 gv[4][2];
#pragma unroll
    for (int j = 0; j < 4; ++j) { gv[j][0] = *((const f32x4*)gn + 2 * (F.lane + 64 * j)); gv[j][1] = *((const f32x4*)gn + 2 * (F.lane + 64 * j) + 1); }
    for (int m = gw; m < S; m += NGW) {
        const float rs = pg8::rstd_of(ss4[m]);
        const GAS v4u* hr = (const GAS v4u*)(hb + (size_t)(m >> 8) * (256 * D) + (size_t)((F.lane >> 3) * 16384 + (m & 255) * 64 + 8 * (F.lane & 7)));
        GAS f32x4* xr = (GAS f32x4*)(P.out + (size_t)m * D);
#pragma unroll
        for (int j = 0; j < 4; ++j) {
            const v4u v = hr[(8 * 16384 / 8) * j];
            const f32x4 lo = (f32x4){__uint_as_float(v.x << 16), __uint_as_float(v.x & 0xffff0000u), __uint_as_float(v.y << 16), __uint_as_float(v.y & 0xffff0000u)};
            const f32x4 hi = (f32x4){__uint_as_float(v.z << 16), __uint_as_float(v.z & 0xffff0000u), __uint_as_float(v.w << 16), __uint_as_float(v.w & 0xffff0000u)};
            xr[2 * (F.lane + 64 * j)] = lo * rs * gv[j][0]; xr[2 * (F.lane + 64 * j) + 1] = hi * rs * gv[j][1];
        }
    }
}


__global__ void __launch_bounds__(NWAVES * 64, 2) yoco_fwd(Params P) {
    extern __shared__ __attribute__((aligned(16))) unsigned char lds[];
    Frame F;
    F.lds = (LAS unsigned char*)lds;
    F.tid = threadIdx.x; F.lane = F.tid & 63; F.wave = __builtin_amdgcn_readfirstlane(F.tid >> 6);
    F.G = gridDim.x; { const int bx = blockIdx.x; F.vcu = (F.G % 8 == 0) ? (bx % 8) * (F.G / 8) + bx / 8 : bx; }
    F.ws = P.ws; F.outb = (unsigned char*)P.out;
    volatile LAS unsigned* MISC = (volatile LAS unsigned*)(F.lds + MISC_OFF);
    for (int u = F.tid; u < (LDS_BYTES - LDSCTL_OFF) / 4; u += NWAVES * 64) ((LAS unsigned*)(F.lds + LDSCTL_OFF))[u] = 0u;
    __syncthreads();
    const int lo = P.ph_lo, hi = P.ph_hi;
    const bool multi = (hi - lo) > 1;
    XcdBarrier bar; bar.bar = (unsigned*)(P.ws + WS_CTL) + CW_BAR; bar.x = 0; bar.st = nullptr;
    if (multi) bar = xcd_barrier_post((unsigned*)(P.ws + WS_CTL) + CW_BAR, MISC + 8);
#define IN(k) (lo <= (k) && (k) < hi)
#define BOTH(k) (IN(k) && IN((k) + 1))
#define GRID_BAR(k) do { if (BOTH(k)) xcd_barrier(bar); } while (0)
#ifndef PROBE_MASK
#define PROBE_MASK 0
#endif
#define REP(k) _Pragma("unroll") for (int rep_ = 0; rep_ < ((((PROBE_MASK) >> (k)) & 1) ? 2 : 1); ++rep_)
    unsigned char* ws = P.ws;
    pg8::ssq_t* ss = (pg8::ssq_t*)(ws + WS_SS);
    const float* cosh = (const float*)(ws + WS_COSH); const float* sinh = (const float*)(ws + WS_SINH);
    const float* cosi = (const float*)(ws + WS_COSI); const float* sini = (const float*)(ws + WS_SINI);
    bf16* hb = (bf16*)(ws + WS_HB);
    const int bx = (int)blockIdx.x;

    if (IN(0)) { REP(0) { p0_prologue(F, P); } GRID_BAR(0); }
    if (IN(1)) {
        pg8::Gemm g{hb, (const bf16*)(ws + WS_WIN), S, 4096, D}; pg8::StaticOrder So; So.init(S, 4096, F.G, bx);
        pg8::EpiIn E{ss, cosh, sinh, cosi, sini, (bf16*)(ws + WS_QA), (bf16*)(ws + WS_KA), (bf16*)(ws + WS_VA), (bf16*)(ws + WS_QI), (bf16*)(ws + WS_KI), (float*)(ws + WS_WI)};
        REP(1) { p1_kiwi(F, cosi, sini); pg8::gemm_phase<pg8::EpiIn, pg8::StaticOrder, true, true, true>(F.lds + RING_OFF, g, So, E); }
        GRID_BAR(1);
    }
    if (IN(2)) {
        REP(2) { p2_indexer<0>(F); } GRID_BAR(2); }
    if (IN(3)) { REP(3) { p3_sparse_fp8(F); } GRID_BAR(3); }
    if (IN(4)) {
        pg8::Gemm g{(const bf16*)(ws + WS_OA), (const bf16*)(ws + WS_WOA), S, D, D}; pg8::StaticOrder So; So.init(S, D, F.G, bx);
        pg8::EpiRes E{hb, ss + 1 * S};
        pg8::gemm_phase<pg8::EpiRes, pg8::StaticOrder, true, true, true>(F.lds + RING_OFF, g, So, E);
        GRID_BAR(4);
    }
    if (IN(5)) {
        pg8::Gemm g{hb, (const bf16*)(ws + WS_WUP), S, FF, D}; pg8::StaticOrder So; So.init(S, FF, F.G, bx);
        pg8::EpiUp E{ss + 1 * S, (bf16*)(ws + WS_U), FF, 0};
        REP(5) pg8::gemm_phase<pg8::EpiUp, pg8::StaticOrder, true, true, true>(F.lds + RING_OFF, g, So, E);
        GRID_BAR(5);
    }
    if (IN(6)) {
        pg8::Gemm g{(const bf16*)(ws + WS_U), (const bf16*)(ws + WS_WDN), S, D, FF}; pg8::StaticOrder So; So.init(S, D, F.G, bx);
        pg8::EpiRes E{hb, ss + 2 * S};
        if (pg8::RowOrder::usable(S, D, F.G)) { pg8::RowOrder Ro; Ro.init(S, D, F.G, bx); pg8::gemm_phase<pg8::EpiRes, pg8::RowOrder, true, true, true>(F.lds + RING_OFF, g, Ro, E); }
        else pg8::gemm_phase<pg8::EpiRes, pg8::StaticOrder, true, true, true>(F.lds + RING_OFF, g, So, E);
        GRID_BAR(6);
    }
    if (IN(7)) {
        pg8::Gemm g{hb, (const bf16*)(ws + WS_WKVQ), S, NKVQ, D}; pg8::StaticOrder So; So.init(S, NKVQ, F.G, bx);
        pg8::EpiKvq E{ss + 2 * S, cosh, sinh, (bf16*)(ws + WS_KS), (bf16*)(ws + WS_VS), (bf16*)(ws + WS_Q2)};
        REP(7) pg8::gemm_phase<pg8::EpiKvq, pg8::StaticOrder, true, true, true>(F.lds + RING_OFF, g, So, E);
        GRID_BAR(7);
    }
    if (IN(8)) { REP(8) { p7_convert_mlp2(F, P); p8_kv_copies(F); } GRID_BAR(8); }
    if (IN(9)) { REP(9) { p9_dilated_dense(F); } GRID_BAR(9); }
    if (IN(10)) {
        pg8::Gemm g{(const bf16*)(ws + WS_O2), (const bf16*)(ws + WS_WOB), S, D, D}; pg8::StaticOrder So; So.init(S, D, F.G, bx);
        pg8::EpiRes E{hb, ss + 3 * S};
        pg8::gemm_phase<pg8::EpiRes, pg8::StaticOrder, true, true, true>(F.lds + RING_OFF, g, So, E);
        GRID_BAR(10);
    }
    if (IN(11)) {
        pg8::Gemm g{hb, (const bf16*)(ws + WS_WUP), S, FF, D}; pg8::StaticOrder So; So.init(S, FF, F.G, bx);
        pg8::EpiUp E{ss + 3 * S, (bf16*)(ws + WS_U), FF, 0};
        REP(11) pg8::gemm_phase<pg8::EpiUp, pg8::StaticOrder, true, true, true>(F.lds + RING_OFF, g, So, E);
        GRID_BAR(11);
    }
    if (IN(12)) {
        pg8::Gemm g{(const bf16*)(ws + WS_U), (const bf16*)(ws + WS_WDN), S, D, FF}; pg8::StaticOrder So; So.init(S, D, F.G, bx);
        pg8::EpiRes E{hb, ss + 4 * S};
        if (pg8::RowOrder::usable(S, D, F.G)) { pg8::RowOrder Ro; Ro.init(S, D, F.G, bx); pg8::gemm_phase<pg8::EpiRes, pg8::RowOrder, true, true, true>(F.lds + RING_OFF, g, Ro, E); }
        else pg8::gemm_phase<pg8::EpiRes, pg8::StaticOrder, true, true, true>(F.lds + RING_OFF, g, So, E);
        GRID_BAR(12);
    }
    if (IN(13)) { p13_final(F, P); }
#undef IN
#undef BOTH
#undef GRID_BAR
}

extern "C" void kernel_launch(void* const* d_in, const int* in_sizes, int n_in, void* d_out, int out_size, void* d_ws, size_t ws_size, hipStream_t stream) {
    static int grid = 0;
    if (grid == 0) {
        if (n_in != 13 || in_sizes[0] != S * D || out_size != S * D || ws_size < WS_END) { fprintf(stderr, "kernel_launch: unexpected shapes / workspace (n_in %d, ws %zu, need %zu)\n", n_in, ws_size, (size_t)WS_END); grid = -1; return; }
        int dev = 0, cus = 0, per_cu = 0;
        if (hipGetDevice(&dev) != hipSuccess || hipDeviceGetAttribute(&cus, hipDeviceAttributeMultiprocessorCount, dev) != hipSuccess) { grid = -1; return; }
        if (hipFuncSetAttribute((const void*)yoco_fwd, hipFuncAttributeMaxDynamicSharedMemorySize, LDS_BYTES) != hipSuccess) { fprintf(stderr, "kernel_launch: hipFuncSetAttribute failed\n"); grid = -1; return; }
        if (hipOccupancyMaxActiveBlocksPerMultiprocessor(&per_cu, (const void*)yoco_fwd, NWAVES * 64, LDS_BYTES) != hipSuccess || per_cu < 1) fprintf(stderr, "kernel_launch: occupancy query reports %d\n", per_cu);
        (void)hipGetLastError();
        grid = cus;
    }
    if (grid < 0) return;
    (void)hipMemsetAsync((char*)d_ws + WS_CTL, 0, CTL_ZERO_BYTES, stream);
    Params p{};
    for (int i = 0; i < 13; ++i) p.in[i] = (const float*)d_in[i];
    p.out = (float*)d_out; p.ws = (unsigned char*)d_ws;
    for (int i = 0; i < 16; ++i) p.invh[i] = (float)std::pow(500000.0, (double)(-(float)(2 * i) / 32.0f));
    for (int i = 0; i < 8; ++i) p.invi[i] = (float)std::pow(500000.0, (double)(-(float)(2 * i) / 16.0f));
#if MK_ONE_LAUNCH
    p.ph_lo = 0; p.ph_hi = N_PHASES;
    hipLaunchKernelGGL(yoco_fwd, dim3(grid), dim3(NWAVES * 64), LDS_BYTES, stream, p);
#else
    for (int k = 0; k < N_PHASES; ++k) { p.ph_lo = k; p.ph_hi = k + 1; hipLaunchKernelGGL(yoco_fwd, dim3(grid), dim3(NWAVES * 64), LDS_BYTES, stream, p); }
#endif
}
```

```cpp
#include <hip/hip_runtime.h>
#include <cstdio>
#include <cstdint>
#include <cmath>
namespace pg8 {
#define PG8_LAS __attribute__((address_space(3)))
typedef unsigned short bf16_t;
typedef short bf16x8 __attribute__((ext_vector_type(8)));
typedef float f32x4 __attribute__((ext_vector_type(4)));
typedef unsigned u32x4 __attribute__((ext_vector_type(4)));
constexpr int BM = 256, BK = 64, HALF = 128, HTB = HALF * BK * 2  , STAGE_BYTES = 8 * HTB, NXCD = 8, WGM = 8;

__host__ __device__ __forceinline__ int lds_byte(int r, int c) { const int st = (r >> 4) * 2 + (c >> 5), rr = r & 15, cc = c & 31, ob = rr * 64 + cc * 2; return st * 1024 + (ob ^ (((ob >> 9) & 1) << 5)); }
__host__ __device__ __forceinline__ void stage_rc(int b, int& R, int& C) { const int st = b / 1024, sb = b % 1024, swz = sb ^ (((sb >> 9) & 1) << 5); R = (st >> 1) * 16 + swz / 64; C = (st & 1) * 32 + (swz % 64) / 2; }
__host__ __device__ __forceinline__ int perm32(int rho) { const int n = rho >> 4, i = rho & 15; return 8 * (i >> 2) + 4 * n + (i & 3); }

struct Unit { int pm, pn; };
struct Gemm { const bf16_t* A; const bf16_t* Bt; int M, N, K; };

struct StaticOrder {
    int nM, nN, nwg, G, c;
    __host__ __device__ void init(int M, int N, int G_, int c_) { nM = M / BM; nN = N / BM; nwg = nM * nN; G = G_; c = c_; }
    __host__ __device__ bool next(int i, Unit& u) const {
        const long L = (long)i * G + c; if (L >= nwg) return false;
        int wgid = (int)L; { const int q = nwg / NXCD, r = nwg % NXCD, xcd = wgid % NXCD, off = wgid / NXCD; wgid = (xcd < r ? xcd * (q + 1) : r * (q + 1) + (xcd - r) * q) + off; }
        const int nig = WGM * nN, gid = wgid / nig, fm = gid * WGM, gsz = (nM - fm) < WGM ? (nM - fm) : WGM;
        u.pm = fm + ((wgid % nig) % gsz); u.pn = (wgid % nig) / gsz; return true;
    }
    __device__ __forceinline__ void a_ready(const Unit&) const {}
    __device__ __forceinline__ void done(const Unit&) const {}
};


__device__ __forceinline__ unsigned cvt_pk_bf16(float lo, float hi) { unsigned r; asm volatile("v_cvt_pk_bf16_f32 %0, %1, %2" : "=v"(r) : "v"(lo), "v"(hi)); return r; }
typedef unsigned u32x2 __attribute__((ext_vector_type(2)));
constexpr float RMS_EPS = 1e-6f;
typedef unsigned long long ssq_t;
__device__ __forceinline__ ssq_t ss_fix(float q) { return (ssq_t)(q * 65536.0f + 0.5f); }
__device__ __forceinline__ float rstd_of(ssq_t ss) { return 1.0f / sqrtf((float)ss * (1.0f / (65536.0f * 2048.0f)) + RMS_EPS); }
__device__ __forceinline__ u32x2 pack4(f32x4 v) { u32x2 w; w.x = cvt_pk_bf16(v[0], v[1]); w.y = cvt_pk_bf16(v[2], v[3]); return w; }
__device__ __forceinline__ void widen16(unsigned& x, unsigned& y) { const auto r = __builtin_amdgcn_permlane16_swap(x, y, false, false); x = r[0]; y = r[1]; }
__device__ __forceinline__ int wide_col(int fq) { return 16 * (fq & 1) + 8 * (fq >> 1); }
__device__ __forceinline__ u32x4 widen32_pair(unsigned a0, unsigned b0, unsigned a1, unsigned b1) {
    const auto ra = __builtin_amdgcn_permlane32_swap(a0, a1, false, false); const auto rb = __builtin_amdgcn_permlane32_swap(b0, b1, false, false);
    u32x4 w; w.x = ra[0]; w.y = rb[0]; w.z = ra[1]; w.w = rb[1]; return w;
}

__device__ __forceinline__ size_t tm_off(int t, int c, int ld) { return (size_t)((t >> 8) * (ld >> 8) + (c >> 8)) * (size_t)(BM * BM) + (size_t)((t & 255) * BM + (c & 255)); }

__device__ __forceinline__ void store_heads128(const f32x4 (&acc)[2][2][4][2], int row0, int wc, int fq, const ssq_t* ss, bf16_t* base, int ld, int colt, bool rope, const float* cosh, const float* sinh) {
    rope = rope && (wc == 0);
    const int colw = colt + wc * 32 + wide_col(fq);
#pragma unroll
    for (int ai = 0; ai < 2; ++ai)
#pragma unroll
        for (int m = 0; m < 4; ++m) {
            const int row = row0 + ai * HALF + m * 16;
            const float rs = rstd_of(ss[row]);
            f32x4 c4 = (f32x4){1.f, 1.f, 1.f, 1.f}, s4 = (f32x4){0.f, 0.f, 0.f, 0.f};
            if (rope) { c4 = *(const f32x4*)(cosh + (size_t)row * 16 + 4 * fq); s4 = *(const f32x4*)(sinh + (size_t)row * 16 + 4 * fq); }
            bf16_t* rowp = base + tm_off(row, colw, ld);
#pragma unroll
            for (int bj = 0; bj < 2; ++bj) {
                f32x4 v0 = acc[ai][bj][m][0] * rs, v1 = acc[ai][bj][m][1] * rs;
                if (rope) { const f32x4 a = v0 * c4 - v1 * s4, b = v1 * c4 + v0 * s4; v0 = a; v1 = b; }
                const u32x2 A = pack4(v0), B = pack4(v1); unsigned ax = A.x, ay = A.y, bx = B.x, by = B.y; widen16(ax, bx); widen16(ay, by);
                u32x4 w; w.x = ax; w.y = ay; w.z = bx; w.w = by; *(u32x4*)(rowp + bj * HALF) = w;
            }
        }
}

constexpr int SEQ = 16384;
__device__ __forceinline__ int pack4_fp8(f32x4 v) { int w = __builtin_amdgcn_cvt_pk_fp8_f32(v[0], v[1], 0, false); return __builtin_amdgcn_cvt_pk_fp8_f32(v[2], v[3], w, true); }
__device__ __forceinline__ void store_heads128_fp8(const f32x4 (&acc)[2][2][4][2], int row0, int wc, int fq, const ssq_t* ss, unsigned char* base, int head0, bool rope, const float* cosh, const float* sinh) {
    rope = rope && (wc == 0);
#pragma unroll
    for (int ai = 0; ai < 2; ++ai)
#pragma unroll
        for (int m = 0; m < 4; ++m) {
            const int row = row0 + ai * HALF + m * 16;
            const float rs = rstd_of(ss[row]);
            f32x4 c4 = (f32x4){1.f, 1.f, 1.f, 1.f}, s4 = (f32x4){0.f, 0.f, 0.f, 0.f};
            if (rope) { c4 = *(const f32x4*)(cosh + (size_t)row * 16 + 4 * fq); s4 = *(const f32x4*)(sinh + (size_t)row * 16 + 4 * fq); }
            unsigned a8[2], b8[2];
#pragma unroll
            for (int bj = 0; bj < 2; ++bj) {
                f32x4 v0 = acc[ai][bj][m][0] * rs, v1 = acc[ai][bj][m][1] * rs;
                if (rope) { const f32x4 a = v0 * c4 - v1 * s4, b = v1 * c4 + v0 * s4; v0 = a; v1 = b; }
                a8[bj] = (unsigned)pack4_fp8(v0); b8[bj] = (unsigned)pack4_fp8(v1); widen16(a8[bj], b8[bj]);
            }
            *(u32x4*)(base + ((size_t)(head0 + (fq >> 1)) * SEQ + row) * 128 + wc * 32 + 16 * (fq & 1)) = widen32_pair(a8[0], b8[0], a8[1], b8[1]);
        }
}

__device__ __forceinline__ void store_heads128_q8(const f32x4 (&acc)[2][2][4][2], int row0, int wc, int fq, const ssq_t* ss, unsigned char* base, int ld, int colt, const float* cosh, const float* sinh) {
    const bool rope = (wc == 0);
    const int col0 = colt + (fq >> 1) * HALF + wc * 32 + 16 * (fq & 1);
#pragma unroll
    for (int ai = 0; ai < 2; ++ai)
#pragma unroll
        for (int m = 0; m < 4; ++m) {
            const int row = row0 + ai * HALF + m * 16;
            const float rs = rstd_of(ss[row]);
            f32x4 c4 = (f32x4){1.f, 1.f, 1.f, 1.f}, s4 = (f32x4){0.f, 0.f, 0.f, 0.f};
            if (rope) { c4 = *(const f32x4*)(cosh + (size_t)row * 16 + 4 * fq); s4 = *(const f32x4*)(sinh + (size_t)row * 16 + 4 * fq); }
            unsigned char* rowp = base + tm_off(row, col0, ld);
            unsigned a8[2], b8[2];
#pragma unroll
            for (int bj = 0; bj < 2; ++bj) {
                f32x4 v0 = acc[ai][bj][m][0] * rs, v1 = acc[ai][bj][m][1] * rs;
                if (rope) { const f32x4 a = v0 * c4 - v1 * s4, b = v1 * c4 + v0 * s4; v0 = a; v1 = b; }
                a8[bj] = (unsigned)pack4_fp8(v0); b8[bj] = (unsigned)pack4_fp8(v1); widen16(a8[bj], b8[bj]);
            }
            *(u32x4*)rowp = widen32_pair(a8[0], b8[0], a8[1], b8[1]);
        }
}

struct EpiIn {
    static constexpr bool PERM = false, AFTER_DRAIN = false;
    const ssq_t* ss;
    const float *cosh, *sinh, *cosi, *sini;
    bf16_t *Q, *K, *V, *QI, *KI; float* WI;
    __device__ __forceinline__ void operator()(const f32x4 (&acc)[2][2][4][2], const Unit& u, int wr, int wc, int fr, int fq) const {
        const int row0 = u.pm * BM + wr * 64 + fr, pn = u.pn;
        if (pn < 12) {
            if (pn < 8) store_heads128_q8(acc, row0, wc, fq, ss, (unsigned char*)Q, 2048, pn * 256, cosh, sinh);
            else if (pn < 10) store_heads128_fp8(acc, row0, wc, fq, ss, (unsigned char*)K, 2 * (pn - 8), true, cosh, sinh);
            else store_heads128_fp8(acc, row0, wc, fq, ss, (unsigned char*)V, 2 * (pn - 10), false, cosh, sinh);
        } else if (pn < 16) {
            const int col0 = (pn - 12) * 256 + wc * 32 + wide_col(fq); const bool rope = (wc & 1) == 0;
#pragma unroll
            for (int ai = 0; ai < 2; ++ai)
#pragma unroll
                for (int m = 0; m < 4; ++m) {
                    const int row = row0 + ai * HALF + m * 16; const float rs = rstd_of(ss[row]);
                    const f32x4 c4 = *(const f32x4*)(cosi + (size_t)row * 8 + 4 * (fq & 1)), s4 = *(const f32x4*)(sini + (size_t)row * 8 + 4 * (fq & 1));
                    bf16_t* rowp = QI + tm_off(row, col0, 1024);
#pragma unroll
                    for (int bj = 0; bj < 2; ++bj) {
                        f32x4 v0 = acc[ai][bj][m][0] * rs; const f32x4 v1 = acc[ai][bj][m][1] * rs;
                        f32x4 p; p[0] = __shfl_xor(v0[0], 32); p[1] = __shfl_xor(v0[1], 32); p[2] = __shfl_xor(v0[2], 32); p[3] = __shfl_xor(v0[3], 32);
                        if (rope) v0 = (fq < 2) ? (v0 * c4 - p * s4) : (v0 * c4 + p * s4);
                        const u32x2 A = pack4(v0), B = pack4(v1); unsigned ax = A.x, ay = A.y, bx = B.x, by = B.y; widen16(ax, bx); widen16(ay, by);
                        u32x4 w; w.x = ax; w.y = ay; w.z = bx; w.w = by; *(u32x4*)(rowp + bj * HALF) = w;
                    }
                }
        }
    }
};

struct EpiKvq {
    static constexpr bool PERM = false, AFTER_DRAIN = false;
    const ssq_t* ss; const float *cosh, *sinh; bf16_t *K, *V, *Q;
    __device__ __forceinline__ void operator()(const f32x4 (&acc)[2][2][4][2], const Unit& u, int wr, int wc, int fr, int fq) const {
        const int row0 = u.pm * BM + wr * 64 + fr, pn = u.pn;
        if (pn < 2) store_heads128(acc, row0, wc, fq, ss, K, 512, pn * 256, true, cosh, sinh);
        else if (pn < 4) store_heads128(acc, row0, wc, fq, ss, V, 512, (pn - 2) * 256, false, cosh, sinh);
        else store_heads128_q8(acc, row0, wc, fq, ss, (unsigned char*)Q, 6144, (pn - 4) * 256, cosh, sinh);
    }
};

struct EpiRes {
    static constexpr bool PERM = true, AFTER_DRAIN = false;
    bf16_t* hb; ssq_t* ssq;
    __device__ __forceinline__ void operator()(const f32x4 (&acc)[2][2][4][2], const Unit& u, int wr, int wc, int fr, int fq) const {
        const int row0 = u.pm * BM + wr * 64 + fr, col0 = u.pn * BM + wc * 32 + 8 * fq;
#pragma unroll
        for (int ai = 0; ai < 2; ++ai)
#pragma unroll
            for (int m = 0; m < 4; ++m) {
                const int row = row0 + ai * HALF + m * 16; float q = 0.f;
                bf16_t* rowp = hb + ((size_t)(u.pm * 8 + u.pn) * (size_t)(BM * BM) + (size_t)(wc * (BM * BK) + (row - u.pm * BM) * BK + 8 * fq));
                u32x4 b[2];
#pragma unroll
                for (int bj = 0; bj < 2; ++bj) b[bj] = *(const u32x4*)(rowp + bj * 32);
#pragma unroll
                for (int bj = 0; bj < 2; ++bj) {
                    u32x4 w;
#pragma unroll
                    for (int i = 0; i < 4; ++i) {
                        const f32x4& a = acc[ai][bj][m][i >> 1];
                        const float lo = __uint_as_float(b[bj][i] << 16) + a[(i & 1) * 2], hi = __uint_as_float(b[bj][i] & 0xffff0000u) + a[(i & 1) * 2 + 1];
                        const unsigned pk = cvt_pk_bf16(lo, hi); w[i] = pk;
                        const float rl = __uint_as_float(pk << 16), rh = __uint_as_float(pk & 0xffff0000u);
                        q += rl * rl + rh * rh;
                    }
                    *(u32x4*)(rowp + bj * 32) = w;
                }
                q += __shfl_xor(q, 16); q += __shfl_xor(q, 32);
                if (fq == 0) atomicAdd(ssq + row, ss_fix(q));
            }
    }
};

struct RowOrder {
    int nN, nwg, G, c;
    __host__ __device__ void init(int M, int N, int G_, int c_) { nN = N / BM; nwg = (M / BM) * nN; G = G_; c = c_; }
    __host__ __device__ static bool usable(int M, int N, int G_) { const int n = N / BM; return G_ % (NXCD * n) == 0 && ((M / BM) * n) % G_ == 0; }
    __host__ __device__ bool next(int i, Unit& u) const {
        if ((long)i * G + c >= nwg) return false;
        const int ppx = G / NXCD / nN, x = c % NXCD, j = c / NXCD;
        u.pm = i * (G / nN) + x * ppx + (j % ppx); u.pn = j / ppx; return true;
    }
    __device__ __forceinline__ void a_ready(const Unit&) const {}
    __device__ __forceinline__ void done(const Unit&) const {}
};

struct EpiUp {
    static constexpr bool PERM = true, AFTER_DRAIN = false;
    const ssq_t* ss; bf16_t* O; int ldc; int dry;
    __device__ __forceinline__ static unsigned ror8(unsigned v) { return __builtin_amdgcn_update_dpp(0u, v, 0x128, 0xf, 0xf, false); }
    __device__ __forceinline__ void operator()(const f32x4 (&acc)[2][2][4][2], const Unit& u, int wr, int wc, int fr, int fq) const {
        const int row0 = u.pm * BM + wr * 64 + fr;
        const bool lo8 = fr < 8;
        bf16_t* base = O + ((size_t)(u.pm * (ldc / BM) + u.pn) * (size_t)(BM * BM) + (size_t)(wc * (BM * BK) + (wr * 64 + (fr & 7)) * BK + (fr >> 3) * 32 + 8 * fq));
#pragma unroll
        for (int ai = 0; ai < 2; ++ai)
#pragma unroll
            for (int m = 0; m < 4; ++m) {
                const int row = row0 + ai * HALF + m * 16; const float rs = rstd_of(ss[row]);
                u32x4 w[2];
#pragma unroll
                for (int bj = 0; bj < 2; ++bj) {
                    f32x4 v0 = acc[ai][bj][m][0] * rs, v1 = acc[ai][bj][m][1] * rs;
                    v0 = __builtin_elementwise_max(v0, (f32x4){0.f, 0.f, 0.f, 0.f}); v1 = __builtin_elementwise_max(v1, (f32x4){0.f, 0.f, 0.f, 0.f});
                    v0 = v0 * v0; v1 = v1 * v1;
                    w[bj].x = cvt_pk_bf16(v0[0], v0[1]); w[bj].y = cvt_pk_bf16(v0[2], v0[3]); w[bj].z = cvt_pk_bf16(v1[0], v1[1]); w[bj].w = cvt_pk_bf16(v1[2], v1[3]);
                }
                u32x4 d1, d2;
#pragma unroll
                for (int i = 0; i < 4; ++i) { const unsigned rx = ror8(w[0][i]), ry = ror8(w[1][i]); d1[i] = lo8 ? w[0][i] : ry; d2[i] = lo8 ? rx : w[1][i]; }
                bf16_t* p = base + (ai * HALF + m * 16) * BK;
                if (dry) asm volatile("" :: "v"(d1.x), "v"(d1.y), "v"(d1.z), "v"(d1.w), "v"(d2.x), "v"(d2.y), "v"(d2.z), "v"(d2.w));
                else { *(u32x4*)p = d1; *(u32x4*)(p + 8 * BK) = d2; }
            }
    }
};
template <class Epi, class Sched, bool ALIGN_EPI = false, bool SP2 = false, bool ATILED = false>
__device__ __forceinline__ void gemm_phase(PG8_LAS unsigned char* lds, const Gemm g, const Sched& S, const Epi& E) {
    const int tid = threadIdx.x, wid = __builtin_amdgcn_readfirstlane(tid >> 6), lane = tid & 63, wr = wid >> 2, wc = wid & 3, fr = lane & 15, fq = lane >> 4;
    const int K = g.K, nt = K / BK;
    const int LDA = ATILED ? BK : K;
    unsigned voffA[2], voffB[2];
#pragma unroll
    for (int i = 0; i < 2; ++i) { int R, C; stage_rc(tid * 16 + i * 8192, R, C); const int Rb = Epi::PERM ? (64 * (R >> 5) + perm32(R & 31)) : R;
        voffA[i] = (unsigned)(R * LDA + C) * 2u; voffB[i] = (unsigned)(Rb * LDA + C) * 2u; }
    const size_t kstep = (size_t)(BK * 2);
    const size_t hstepA = (size_t)HALF * LDA * 2, hstepB = Epi::PERM ? (size_t)32 * LDA * 2 : hstepA;
    const size_t tstep = (size_t)BM * K * 2;
    const unsigned ldsw = (unsigned)wid * 1024u;
    const int aoff = lds_byte(wr * 64 + fr, fq * 8), boff = lds_byte(wc * 32 + fr, fq * 8);
#define PG8_SA(b, h) (((b) * 2 + (h)) * HTB)
#define PG8_SB(b, h) ((4 + (b) * 2 + (h)) * HTB)
#define PG8_STAGE(bufoff, gbase, voff) do { _Pragma("unroll") for (int _i = 0; _i < 2; ++_i) \
        __builtin_amdgcn_global_load_lds((const unsigned*)((const char*)(gbase) + (voff)[_i]), (PG8_LAS unsigned*)(lds + (bufoff) + ldsw + _i * 8192), 16, 0, 0); } while (0)
#define PG8_LDA(dst, b, h) do { _Pragma("unroll") for (int m = 0; m < 4; ++m) _Pragma("unroll") for (int k = 0; k < 2; ++k) dst[m][k] = *(const PG8_LAS bf16x8*)(lds + PG8_SA(b, h) + aoff + m * 2048 + k * 1024); } while (0)
#define PG8_LDB(dst, b, h) do { _Pragma("unroll") for (int n = 0; n < 2; ++n) _Pragma("unroll") for (int k = 0; k < 2; ++k) dst[n][k] = *(const PG8_LAS bf16x8*)(lds + PG8_SB(b, h) + boff + n * 2048 + k * 1024); } while (0)
#define PG8_MMA(ai, bj, At, Bt) do { __builtin_amdgcn_s_setprio(1); _Pragma("unroll") for (int m = 0; m < 4; ++m) _Pragma("unroll") for (int n = 0; n < 2; ++n) _Pragma("unroll") for (int k = 0; k < 2; ++k) \
        acc[ai][bj][m][n] = __builtin_amdgcn_mfma_f32_16x16x32_bf16(Bt[n][k], At[m][k], acc[ai][bj][m][n], 0, 0, 0); __builtin_amdgcn_s_setprio(0); } while (0)
#define PG8_WAIT_V(n) asm volatile("s_waitcnt vmcnt(" #n ")" ::: "memory")
#define PG8_WAIT_L(n) asm volatile("s_waitcnt lgkmcnt(" #n ")" ::: "memory")
#define PG8_BAR __builtin_amdgcn_s_barrier()
#define PG8_SCHED __builtin_amdgcn_sched_barrier(0)
    auto akt = [&](int t) -> size_t { return ATILED ? (size_t)t * (size_t)(BM * BK * 2) : (size_t)t * kstep; };
    const size_t akt1 = akt(1);
    Unit cur, nxt; int ui = 0;
    if (!S.next(0, cur)) return;
    f32x4 acc[2][2][4][2];
#pragma unroll
    for (int a = 0; a < 2; ++a)
#pragma unroll
        for (int b = 0; b < 2; ++b)
#pragma unroll
            for (int m = 0; m < 4; ++m)
#pragma unroll
                for (int n = 0; n < 2; ++n) acc[a][b][m][n] = (f32x4){0.f, 0.f, 0.f, 0.f};
    bf16x8 At[4][2], B0[2][2], B1[2][2];
    const char* cA = (const char*)g.A + (size_t)cur.pm * tstep; const char* cB = (const char*)g.Bt + (size_t)cur.pn * tstep;
    S.a_ready(cur);
    if constexpr (SP2) {
        PG8_STAGE(PG8_SB(0, 0), cB, voffB); PG8_STAGE(PG8_SB(0, 1), cB + hstepB, voffB); PG8_STAGE(PG8_SA(0, 0), cA, voffA); PG8_STAGE(PG8_SA(0, 1), cA + hstepA, voffA);
        if (wr == 1) PG8_BAR;
        PG8_WAIT_V(2); PG8_BAR;
        PG8_STAGE(PG8_SB(1, 0), cB + akt1, voffB); PG8_STAGE(PG8_SA(1, 0), cA + akt1, voffA); PG8_STAGE(PG8_SB(1, 1), cB + hstepB + akt1, voffB);
        PG8_WAIT_V(6); PG8_BAR;
    } else {
        PG8_STAGE(PG8_SB(0, 0), cB, voffB); PG8_STAGE(PG8_SA(0, 0), cA, voffA); PG8_STAGE(PG8_SB(0, 1), cB + hstepB, voffB); PG8_STAGE(PG8_SA(0, 1), cA + hstepA, voffA);
        if (wr == 1) PG8_BAR;
        PG8_WAIT_V(4); PG8_BAR;
        PG8_STAGE(PG8_SB(1, 0), cB + akt1, voffB); PG8_STAGE(PG8_SA(1, 0), cA + akt1, voffA); PG8_STAGE(PG8_SB(1, 1), cB + hstepB + akt1, voffB);
        PG8_WAIT_V(6); PG8_BAR;
    }
    for (;;) {
        const bool has_next = S.next(ui + 1, nxt);
        const char* nA = has_next ? (const char*)g.A + (size_t)nxt.pm * tstep : cA; const char* nB = has_next ? (const char*)g.Bt + (size_t)nxt.pn * tstep : cB;
        for (int t = 0; t < nt; t += 2) {
            const bool last = (t == nt - 2);
            const char* a1 = cA + akt(t + 1);
            const char* a2 = last ? nA : cA + akt(t + 2); const char* b2 = last ? nB : cB + akt(t + 2);
            const char* a3 = a2 + akt1; const char* b3 = b2 + akt1;
            if (last && has_next) S.a_ready(nxt);
            if constexpr (SP2) {
            PG8_LDB(B0, 0, 0); PG8_LDB(B1, 0, 1); PG8_SCHED; PG8_LDA(At, 0, 0); PG8_STAGE(PG8_SA(1, 1), a1 + hstepA, voffA);
            PG8_WAIT_V(8); PG8_WAIT_L(0); PG8_BAR; PG8_MMA(0, 0, At, B0); PG8_MMA(0, 1, At, B1); PG8_BAR; PG8_SCHED;
            PG8_LDA(At, 0, 1); PG8_STAGE(PG8_SB(0, 0), b2, voffB); PG8_STAGE(PG8_SB(0, 1), b2 + hstepB, voffB); PG8_STAGE(PG8_SA(0, 0), a2, voffA);
            PG8_WAIT_V(8); PG8_WAIT_L(0); PG8_BAR; PG8_MMA(1, 0, At, B0); PG8_MMA(1, 1, At, B1); PG8_BAR; PG8_SCHED;
            PG8_LDB(B0, 1, 0); PG8_LDB(B1, 1, 1); PG8_SCHED; PG8_LDA(At, 1, 0); PG8_STAGE(PG8_SA(0, 1), a2 + hstepA, voffA);
            PG8_WAIT_V(8); PG8_WAIT_L(0); PG8_BAR; PG8_MMA(0, 0, At, B0); PG8_MMA(0, 1, At, B1); PG8_BAR; PG8_SCHED;
            PG8_LDA(At, 1, 1); PG8_STAGE(PG8_SB(1, 0), b3, voffB); PG8_STAGE(PG8_SB(1, 1), b3 + hstepB, voffB); PG8_STAGE(PG8_SA(1, 0), a3, voffA);
            PG8_WAIT_V(8); PG8_WAIT_L(0); PG8_BAR; PG8_MMA(1, 0, At, B0); PG8_MMA(1, 1, At, B1); PG8_BAR; PG8_SCHED;
            } else {
            PG8_LDB(B0, 0, 0); PG8_SCHED; PG8_LDA(At, 0, 0); PG8_STAGE(PG8_SA(1, 1), a1 + hstepA, voffA);
            PG8_WAIT_L(8); PG8_BAR; PG8_WAIT_L(0); PG8_MMA(0, 0, At, B0); PG8_BAR; PG8_SCHED;
            PG8_LDB(B1, 0, 1); PG8_STAGE(PG8_SB(0, 0), b2, voffB);
            PG8_BAR; PG8_WAIT_L(0); PG8_MMA(0, 1, At, B1); PG8_BAR;
            PG8_LDA(At, 0, 1); PG8_STAGE(PG8_SA(0, 0), a2, voffA);
            PG8_BAR; PG8_WAIT_L(0); PG8_MMA(1, 0, At, B0); PG8_BAR; PG8_SCHED;
            PG8_STAGE(PG8_SB(0, 1), b2 + hstepB, voffB);
            PG8_WAIT_V(6); PG8_BAR; PG8_MMA(1, 1, At, B1); PG8_BAR;
            PG8_LDB(B0, 1, 0); PG8_SCHED; PG8_LDA(At, 1, 0); PG8_STAGE(PG8_SA(0, 1), a2 + hstepA, voffA);
            PG8_WAIT_L(8); PG8_BAR; PG8_WAIT_L(0); PG8_MMA(0, 0, At, B0); PG8_BAR; PG8_SCHED;
            PG8_LDB(B1, 1, 1); PG8_STAGE(PG8_SB(1, 0), b3, voffB);
            PG8_BAR; PG8_WAIT_L(0); PG8_MMA(0, 1, At, B1); PG8_BAR;
            PG8_LDA(At, 1, 1); PG8_STAGE(PG8_SA(1, 0), a3, voffA);
            PG8_BAR; PG8_WAIT_L(0); PG8_MMA(1, 0, At, B0); PG8_BAR; PG8_SCHED;
            PG8_STAGE(PG8_SB(1, 1), b3 + hstepB, voffB);
            PG8_WAIT_V(6); PG8_BAR; PG8_MMA(1, 1, At, B1); PG8_BAR;
            }
        }
        if constexpr (ALIGN_EPI) { if (wr == 0) PG8_BAR; }
        if constexpr (!Epi::AFTER_DRAIN) { E(acc, cur, wr, wc, fr, fq); S.done(cur); }
        if (!has_next) break;
#pragma unroll
        for (int a = 0; a < 2; ++a)
#pragma unroll
            for (int b = 0; b < 2; ++b)
#pragma unroll
                for (int m = 0; m < 4; ++m)
#pragma unroll
                    for (int n = 0; n < 2; ++n) acc[a][b][m][n] = (f32x4){0.f, 0.f, 0.f, 0.f};
        cur = nxt; cA = nA; cB = nB; ++ui;
        if constexpr (ALIGN_EPI) { if (wr == 1) PG8_BAR; }
    }
    PG8_WAIT_V(0);
    if constexpr (!ALIGN_EPI) { if (wr == 0) PG8_BAR; }
    PG8_BAR;
    if constexpr (Epi::AFTER_DRAIN) { E.fused(acc, cur, wr, wc, fr, fq, lds, wid, lane); S.done(cur); }
#undef PG8_SA
#undef PG8_SB
#undef PG8_STAGE
#undef PG8_LDA
#undef PG8_LDB
#undef PG8_MMA
#undef PG8_WAIT_V
#undef PG8_WAIT_L
#undef PG8_BAR
#undef PG8_SCHED
}
}

constexpr int S = 16384, D = 2048, FF = 8192;
constexpr int NIN = 4176, NIN_PAD = 4352;
constexpr int NKVQ = 7168;
constexpr int TOPK = 256;
constexpr int NWAVES = 8;
constexpr int N_PHASES = 14;
#ifndef MK_ONE_LAUNCH
#define MK_ONE_LAUNCH 1
#endif

constexpr size_t MiB = 1u << 20;
constexpr size_t WS_CTL = 0, CTL_ZERO_BYTES = 16384;
constexpr size_t WS_COSH = 1 * MiB, WS_SINH = 2 * MiB, WS_COSI = 3 * MiB, WS_SINI = 3 * MiB + 512 * 1024;
constexpr size_t WS_SS = 4 * MiB;
constexpr size_t WS_SEL = 5 * MiB;
constexpr size_t WS_WIN = 13 * MiB, WS_WOA = 30 * MiB, WS_WOB = 38 * MiB, WS_WKVQ = 46 * MiB, WS_WUP = 74 * MiB, WS_WDN = 106 * MiB;
constexpr size_t WS_HB = 138 * MiB;
constexpr size_t WS_R = 202 * MiB;
constexpr size_t WS_QA = WS_R, WS_KA = WS_R + 64 * MiB, WS_VA = WS_R + 80 * MiB, WS_QI = WS_R + 96 * MiB, WS_KI = WS_R + 128 * MiB, WS_WI = WS_R + 130 * MiB, WS_OA = WS_R + 132 * MiB;
constexpr size_t WS_U = WS_R;
constexpr size_t WS_Q2 = WS_R, WS_KS = WS_R + 192 * MiB, WS_VS = WS_R + 208 * MiB, WS_O2 = WS_R + 224 * MiB;
constexpr size_t WS_END = WS_R + 288 * MiB;
constexpr size_t WS_VT0 = 5 * MiB, WS_VT1 = 21 * MiB, WS_VT2 = 46 * MiB;
static_assert(WS_OA + 64 * MiB <= WS_END && WS_U + 256 * MiB <= WS_END && WS_O2 + 64 * MiB <= WS_END, "ws map");
constexpr int CW_P2Q = 3584;
constexpr int CW_BAR = 0;

constexpr int RING_OFF = 0, RING_BYTES = 131072;
constexpr int LDSCTL_OFF = RING_BYTES, MISC_OFF = LDSCTL_OFF + 320;
constexpr int LDS_BYTES = 147456;

#define GAS __attribute__((address_space(1)))
#define LAS __attribute__((address_space(3)))
typedef unsigned short bf16;
typedef unsigned v4u __attribute__((ext_vector_type(4)));
typedef unsigned v2u __attribute__((ext_vector_type(2)));
typedef float f32x4 __attribute__((ext_vector_type(4)));
typedef float f32x16 __attribute__((ext_vector_type(16)));
typedef short bf16x8 __attribute__((ext_vector_type(8)));
typedef GAS unsigned gu32;
#define LDS_WAIT() asm volatile("s_waitcnt lgkmcnt(0)" ::: "memory")
#define VM_WAIT() asm volatile("s_waitcnt vmcnt(0)" ::: "memory")
__device__ __forceinline__ unsigned f2bf(float f) { unsigned u = __builtin_bit_cast(unsigned, f); return (u + 0x7fffu + ((u >> 16) & 1u)) >> 16; }
__device__ __forceinline__ unsigned pk2(float lo, float hi) { return f2bf(lo) | (f2bf(hi) << 16); }
__device__ __forceinline__ float bf2f(short v) { return __uint_as_float(((unsigned)(unsigned short)v) << 16); }
#define XB_TMO      128
#define XB_XCNT(j)  (256  + 64 * (j))
#define XB_XSUB(j)  (1280 + 64 * (j))
#define XB_XGEN(j)  (2304 + 64 * (j))
#define XB_TOP      3328
#define XB_TOPGEN   3392
#define XCD_BAR_WORDS 3456
#define XB_SPIN_CAP (1u << 18)

__device__ __forceinline__ unsigned xb_ld(unsigned* p)              { return __hip_atomic_load(p, __ATOMIC_RELAXED, __HIP_MEMORY_SCOPE_AGENT); }
__device__ __forceinline__ unsigned xb_add(unsigned* p, unsigned v) { return __hip_atomic_fetch_add(p, v, __ATOMIC_RELAXED, __HIP_MEMORY_SCOPE_AGENT); }
__device__ __forceinline__ unsigned xb_xcc_id() { return (unsigned)__builtin_amdgcn_s_getreg((3 << 11) | 20) & 0xFu; }
#define XB_SPIN(cond, bar) do { unsigned _sp = 0; while (cond) { __builtin_amdgcn_s_sleep(1); \
    if ((++_sp & 255u) == 0u) { if (xb_ld(&(bar)[XB_TMO])) break; if (_sp > XB_SPIN_CAP) { atomicAdd(&(bar)[XB_TMO], 1u); break; } } } } while (0)

struct XcdBarrier {
    unsigned* bar; unsigned x;
    volatile LAS unsigned* st;
};

__device__ __forceinline__ XcdBarrier xcd_barrier_post(unsigned* bar, volatile LAS unsigned* st) {
    XcdBarrier b; b.bar = bar; b.x = xb_xcc_id(); b.st = st;
    if (threadIdx.x == 0) (void)xb_add(&bar[XB_XCNT(b.x)], 1u);
    return b;
}
__device__ __forceinline__ void xcd_barrier_complete(unsigned* bar, unsigned x, unsigned& nloc, unsigned& nx) {
    const unsigned G = gridDim.x * gridDim.y * gridDim.z;
    unsigned sum, cnt, mine, sp = 0u;
    for (;;) {
        sum = 0u; cnt = 0u; mine = 0u;
#pragma unroll
        for (unsigned j = 0; j < 16; ++j) { const unsigned c = xb_ld(&bar[XB_XCNT(j)]); sum += c; cnt += (c > 0u) ? 1u : 0u; mine = (j == x) ? c : mine; }
        if (sum == G) break;
        __builtin_amdgcn_s_sleep(1);
        if ((++sp & 255u) == 0u) { if (xb_ld(&bar[XB_TMO])) break; if (sp > XB_SPIN_CAP) { atomicAdd(&bar[XB_TMO], 1u); break; } }
    }
    nloc = mine > 0u ? mine : 1u; nx = cnt > 0u ? cnt : 1u;
}

__device__ __forceinline__ void xcd_barrier(const XcdBarrier& b) {
    asm volatile("s_waitcnt vmcnt(0)" ::: "memory");
    __syncthreads();
    if (threadIdx.x == 0) {
        unsigned* bar = b.bar;
        __builtin_amdgcn_s_waitcnt(0);
        unsigned nloc = b.st[0], nx = b.st[1];
        if (nloc == 0u) { xcd_barrier_complete(bar, b.x, nloc, nx); b.st[0] = nloc; b.st[1] = nx; }
        const unsigned old = xb_add(&bar[XB_XSUB(b.x)], 1u);
        const unsigned gen = old / nloc;
        if (old + 1u == (gen + 1u) * nloc) {
            __builtin_amdgcn_fence(__ATOMIC_RELEASE, "agent");
            asm volatile("s_waitcnt vmcnt(0)" ::: "memory");
            const unsigned og = xb_add(&bar[XB_TOP], 1u);
            const unsigned tg = og / nx;
            if (og + 1u == (tg + 1u) * nx) xb_add(&bar[XB_TOPGEN], 1u);
            else XB_SPIN(xb_ld(&bar[XB_TOPGEN]) == tg, bar);
            __builtin_amdgcn_fence(__ATOMIC_ACQUIRE, "agent");
            xb_add(&bar[XB_XGEN(b.x)], 1u);
            asm volatile("s_waitcnt vmcnt(0)" ::: "memory");
        } else {
            XB_SPIN(xb_ld(&bar[XB_XGEN(b.x)]) == gen, bar);
            __builtin_amdgcn_fence(__ATOMIC_ACQUIRE, "agent");
            asm volatile("s_waitcnt vmcnt(0)" ::: "memory");
        }
    }
    __syncthreads();
}

struct Params { const float* in[13]; float* out; unsigned char* ws; float invh[16]; float invi[8]; int ph_lo, ph_hi; };
struct Frame {
    LAS unsigned char* lds;
    int tid, lane, wave, vcu, G;
    unsigned char* ws; unsigned char* outb;
};
template <int CTRL> __device__ __forceinline__ float dpp_mov(float v) { return __uint_as_float(__builtin_amdgcn_update_dpp(0u, __float_as_uint(v), CTRL, 0xf, 0xf, false)); }
__device__ __forceinline__ float row_sum16(float v) { v += dpp_mov<0x128>(v); v += dpp_mov<0x124>(v); v += dpp_mov<0x122>(v); v += dpp_mov<0x121>(v); return v; }
__device__ __forceinline__ float row_max16(float v) { v = __builtin_fmaxf(v, dpp_mov<0x128>(v)); v = __builtin_fmaxf(v, dpp_mov<0x124>(v)); v = __builtin_fmaxf(v, dpp_mov<0x122>(v)); v = __builtin_fmaxf(v, dpp_mov<0x121>(v)); return v; }
__device__ __forceinline__ float swap16_sum(float v) { const auto r = __builtin_amdgcn_permlane16_swap(__float_as_uint(v), __float_as_uint(v), false, false); return __uint_as_float(r[0]) + __uint_as_float(r[1]); }
__device__ __forceinline__ float swap32_sum(float v) { const auto r = __builtin_amdgcn_permlane32_swap(__float_as_uint(v), __float_as_uint(v), false, false); return __uint_as_float(r[0]) + __uint_as_float(r[1]); }
__device__ __forceinline__ float swap32_max(float v) { const auto r = __builtin_amdgcn_permlane32_swap(__float_as_uint(v), __float_as_uint(v), false, false); return __builtin_fmaxf(__uint_as_float(r[0]), __uint_as_float(r[1])); }
__device__ __forceinline__ float swap16_max(float v) { const auto r = __builtin_amdgcn_permlane16_swap(__float_as_uint(v), __float_as_uint(v), false, false); return __builtin_fmaxf(__uint_as_float(r[0]), __uint_as_float(r[1])); }
__device__ __forceinline__ float bcast_row0(float v) {
    const auto r = __builtin_amdgcn_permlane16_swap(__float_as_uint(v), __float_as_uint(v), false, false);
    const auto q = __builtin_amdgcn_permlane32_swap(r[0], r[0], false, false);
    return __uint_as_float(q[0]);
}
__device__ __forceinline__ float wave_sum(float v) { return swap32_sum(swap16_sum(row_sum16(v))); }

__device__ __forceinline__ size_t ktm_off(int t, int c) { return (size_t)(t >> 8) * (size_t)(256 * 2048) + (size_t)((c >> 6) * 16384 + (t & 255) * 64 + (c & 63)); }
__device__ __forceinline__ void tr_item(const float* W, int K, int N, int Npad, const float* gain, bf16* WT, int row_off, LAS float* scr, int item, int lane) {
    const int nblk = Npad / 32, kb = item / nblk, nb = item - kb * nblk, k0 = 64 * kb, n0 = 32 * nb;
    const int kr = lane >> 3, c = lane & 7, n = n0 + 4 * c;
    f32x4 v[8];
#pragma unroll
    for (int i = 0; i < 8; ++i) {
        const float* src = W + (size_t)(k0 + kr + 8 * i) * N + n;
        if (n + 3 < N) v[i] = *(const GAS f32x4*)src;
        else { v[i] = (f32x4){0.f, 0.f, 0.f, 0.f}; if (n < N) v[i].x = src[0]; if (n + 1 < N) v[i].y = src[1]; if (n + 2 < N) v[i].z = src[2]; }
    }
    const float gv = gain ? gain[k0 + lane] : 1.0f;
#pragma unroll
    for (int i = 0; i < 8; ++i) {
        const int kk = kr + 8 * i; const float gsc = __shfl(gv, kk);
        LAS float* d = scr + kk * 33 + 4 * c;
        d[0] = v[i].x * gsc; d[1] = v[i].y * gsc; d[2] = v[i].z * gsc; d[3] = v[i].w * gsc;
    }
    LDS_WAIT(); asm volatile("" ::: "memory");
    const int c8 = lane & 7;
#pragma unroll
    for (int j = 0; j < 4; ++j) { const int nn = (lane >> 3) + 8 * j; const LAS float* s = scr + (8 * c8) * 33 + nn;
        v4u o; o.x = pk2(s[0 * 33], s[1 * 33]); o.y = pk2(s[2 * 33], s[3 * 33]); o.z = pk2(s[4 * 33], s[5 * 33]); o.w = pk2(s[6 * 33], s[7 * 33]);
        const int row = row_off + n0 + nn;
        *(GAS v4u*)(WT + (size_t)(row >> 8) * ((size_t)256 * K) + (size_t)(kb * 16384 + (row & 255) * 64 + 8 * c8)) = o; }
    LDS_WAIT(); asm volatile("" ::: "memory");
}
__device__ __forceinline__ void sincos_acc(float angf, float& sn_, float& cs_) {
    const double a = (double)angf;
    const double k = __builtin_rint(a * 0.15915494309189535);
    double r = __builtin_fma(-k, 6.283185307179586, a); r = __builtin_fma(-k, 2.4492935982947064e-16, r);
    const double x = r * 0.25, x2 = x * x;
    const double sn = x * (1.0 + x2 * (-1.0 / 6.0 + x2 * (1.0 / 120.0 + x2 * (-1.0 / 5040.0 + x2 * (1.0 / 362880.0 + x2 * (-1.0 / 39916800.0 + x2 * (1.0 / 6227020800.0)))))));
    const double cs = 1.0 + x2 * (-0.5 + x2 * (1.0 / 24.0 + x2 * (-1.0 / 720.0 + x2 * (1.0 / 40320.0 + x2 * (-1.0 / 3628800.0 + x2 * (1.0 / 479001600.0 + x2 * (-1.0 / 87178291200.0)))))));
    const double s2 = 2.0 * sn * cs, c2 = 1.0 - 2.0 * sn * sn;
    const double s4 = 2.0 * s2 * c2, c4 = 1.0 - 2.0 * s2 * s2;
    sn_ = (float)s4; cs_ = (float)c4;
}

constexpr int WI0 = (D / 64) * (NIN_PAD / 32), WI1 = (D / 64) * (D / 32), WI2 = WI1, WI3 = (D / 64) * (1024 / 32), WI4 = (D / 64) * (6144 / 32), WI5 = (D / 64) * (FF / 32), WI6 = (FF / 64) * (D / 32);
constexpr int WI7 = WI5, WI8 = WI6;
constexpr int W_NITEMS = WI0 + WI1 + WI2 + WI3 + WI4 + WI5 + WI6 + WI7 + WI8;
constexpr size_t OUT_WUP2 = 32 * MiB, OUT_WDN2 = 64 * MiB;
struct TrDesc { const float* W; const float* gain; bf16* WT; int K, N, Npad, row_off, item; };
__device__ __forceinline__ void tr_load(const TrDesc& d, int lane, f32x4 (&v)[8], float& gv) {
    const int nblk = d.Npad / 32, kb = d.item / nblk, nb = d.item - kb * nblk, k0 = 64 * kb, n0 = 32 * nb;
    const int kr = lane >> 3, c = lane & 7, n = n0 + 4 * c, nc = (n + 3 < d.N) ? n : d.N - 4;
#pragma unroll
    for (int i = 0; i < 8; ++i) v[i] = *(const GAS f32x4*)(d.W + (size_t)(k0 + kr + 8 * i) * d.N + nc);
    gv = d.gain ? d.gain[k0 + lane] : 1.0f;
}
__device__ __forceinline__ void tr_finish(const TrDesc& d, int lane, const f32x4 (&v)[8], float gv, LAS float* scr) {
    const int nblk = d.Npad / 32, kb = d.item / nblk, nb = d.item - kb * nblk, n0 = 32 * nb;
    const int kr = lane >> 3, c = lane & 7, n = n0 + 4 * c;
    const bool inside = (n + 3 < d.N);
#pragma unroll
    for (int i = 0; i < 8; ++i) {
        const int kk = kr + 8 * i; float gsh = __shfl(gv, kk); asm volatile("" : "+v"(gsh)); const float gsc = inside ? gsh : 0.f;
        LAS float* q = scr + kk * 33 + 4 * c;
        q[0] = v[i].x * gsc; q[1] = v[i].y * gsc; q[2] = v[i].z * gsc; q[3] = v[i].w * gsc;
    }
    LDS_WAIT(); asm volatile("" ::: "memory");
    const int c8 = lane & 7;
#pragma unroll
    for (int j = 0; j < 4; ++j) { const int nn = (lane >> 3) + 8 * j; const LAS float* sp = scr + (8 * c8) * 33 + nn;
        v4u o; o.x = pk2(sp[0 * 33], sp[1 * 33]); o.y = pk2(sp[2 * 33], sp[3 * 33]); o.z = pk2(sp[4 * 33], sp[5 * 33]); o.w = pk2(sp[6 * 33], sp[7 * 33]);
        const int row = d.row_off + n0 + nn;
        *(GAS v4u*)(d.WT + (size_t)(row >> 8) * ((size_t)256 * d.K) + (size_t)(kb * 16384 + (row & 255) * 64 + 8 * c8)) = o; }
    LDS_WAIT(); asm volatile("" ::: "memory");
}
#ifndef CONV_NF
#define CONV_NF 6
#endif
template <int NF> __device__ __forceinline__ void convert_items(Frame& F, const Params& P, int lo, int hi, int first, int stride) {
    LAS float* scr = (LAS float*)(F.lds + RING_OFF + F.wave * 16384);
    bf16* WinT = (bf16*)(F.ws + WS_WIN); bf16* WoaT = (bf16*)(F.ws + WS_WOA); bf16* WobT = (bf16*)(F.ws + WS_WOB); bf16* WkvqT = (bf16*)(F.ws + WS_WKVQ);
    bf16* WupT = (bf16*)(F.ws + WS_WUP); bf16* WdnT = (bf16*)(F.ws + WS_WDN); bf16* Wup2T = (bf16*)(F.outb + OUT_WUP2); bf16* Wdn2T = (bf16*)(F.outb + OUT_WDN2);
    const float *w_in = P.in[2], *g_in = P.in[1], *w_oa = P.in[3], *w_ob = P.in[8], *w_kv = P.in[5], *g_kv = P.in[4], *w_q2 = P.in[7], *g_q2 = P.in[6], *w_up = P.in[10], *g_up = P.in[9], *w_dn = P.in[11];
#define CV_DECODE(it__, d__) do { int r = (it__); \
        if (r < WI0) { d__ = TrDesc{w_in, g_in, WinT, D, NIN, NIN_PAD, 0, r}; } else { r -= WI0;                       \
        if (r < WI1) { d__ = TrDesc{w_oa, nullptr, WoaT, D, D, D, 0, r}; } else { r -= WI1;                               \
        if (r < WI2) { d__ = TrDesc{w_ob, nullptr, WobT, D, D, D, 0, r}; } else { r -= WI2;                               \
        if (r < WI3) { d__ = TrDesc{w_kv, g_kv, WkvqT, D, 1024, 1024, 0, r}; } else { r -= WI3;                        \
        if (r < WI4) { d__ = TrDesc{w_q2, g_q2, WkvqT, D, 6144, 6144, 1024, r}; } else { r -= WI4;                     \
        if (r < WI5) { d__ = TrDesc{w_up, g_up, WupT, D, FF, FF, 0, r}; } else { r -= WI5;                            \
        if (r < WI6) { d__ = TrDesc{w_dn, nullptr, WdnT, FF, D, D, 0, r}; } else { r -= WI6;                           \
        if (r < WI7) { d__ = TrDesc{w_up + (size_t)D * FF, g_up + D, Wup2T, D, FF, FF, 0, r}; } else { r -= WI7;      \
        d__ = TrDesc{w_dn + (size_t)FF * D, nullptr, Wdn2T, FF, D, D, 0, r}; } } } } } } } } } while (0)
    for (int it = __builtin_amdgcn_readfirstlane(lo + first); it < hi; it += NF * stride) {
        TrDesc d[NF]; f32x4 v[NF][8]; float g[NF];
#pragma unroll
        for (int j = 0; j < NF; ++j) if (j == 0 || it + j * stride < hi) { d[j] = TrDesc{}; CV_DECODE(it + j * stride, d[j]); tr_load(d[j], F.lane, v[j], g[j]); }
#pragma unroll
        for (int j = 0; j < NF; ++j) if (j == 0 || it + j * stride < hi) tr_finish(d[j], F.lane, v[j], g[j], scr);
    }
#undef CV_DECODE
}
__device__ __forceinline__ void p0_prologue(Frame& F, const Params& P) {
    const int gw = F.vcu * NWAVES + F.wave, NGW = F.G * NWAVES;
    convert_items<1>(F, P, 0, WI0, gw, NGW);
    bf16* hb = (bf16*)(F.ws + WS_HB); pg8::ssq_t* ss = (pg8::ssq_t*)(F.ws + WS_SS);
    for (int m = gw; m < S; m += NGW) {
        const GAS f32x4* xr = (const GAS f32x4*)(P.in[0] + (size_t)m * D) + F.lane;
        f32x4 v[8]; float s = 0.f;
#pragma unroll
        for (int j = 0; j < 8; ++j) { v[j] = xr[64 * j]; s += (v[j].x * v[j].x + v[j].y * v[j].y) + (v[j].z * v[j].z + v[j].w * v[j].w); }
        s = wave_sum(s);
        GAS v2u* o8 = (GAS v2u*)(hb + (size_t)(m >> 8) * (256 * D) + (size_t)((F.lane >> 4) * 16384 + (m & 255) * 64 + 4 * (F.lane & 15)));
#pragma unroll
        for (int j = 0; j < 8; ++j) { v2u w; w.x = pk2(v[j].x, v[j].y); w.y = pk2(v[j].z, v[j].w); o8[(4 * 16384 / 4) * j] = w; }
        if (F.lane == 0) ss[m] = pg8::ss_fix(s);
    }
    { const int gt = gw * 64 + F.lane, NT = NGW * 64; for (int i = gt; i < 4 * S; i += NT) ss[S + i] = 0ull; }
    { float* cosh = (float*)(F.ws + WS_COSH); float* sinh = (float*)(F.ws + WS_SINH); float* cosi = (float*)(F.ws + WS_COSI); float* sini = (float*)(F.ws + WS_SINI);
      const int gt = gw * 64 + F.lane, NT = NGW * 64;
      float ivh = P.invh[0], ivi = P.invi[0];
#pragma unroll
      for (int kk = 1; kk < 16; ++kk) ivh = ((gt & 15) == kk) ? P.invh[kk] : ivh;
#pragma unroll
      for (int kk = 1; kk < 8; ++kk) ivi = ((gt & 7) == kk) ? P.invi[kk] : ivi;
      for (int i = gt; i < S * 16; i += NT) { const int pos = i >> 4; float sn, cs; sincos_acc((float)pos * ivh, sn, cs); cosh[i] = cs; sinh[i] = sn; }
      for (int i = gt; i < S * 8; i += NT) { const int pos = i >> 3; float sn, cs; sincos_acc((float)pos * ivi, sn, cs); cosi[i] = cs; sini[i] = sn; }
    }
}

__device__ __forceinline__ void p1_kiwi(Frame& F, const float* cosi, const float* sini) {
    const bf16* hb = (const bf16*)(F.ws + WS_HB); const bf16* Wt = (const bf16*)(F.ws + WS_WIN) + (size_t)16 * 256 * D;
    const pg8::ssq_t* ss = (const pg8::ssq_t*)(F.ws + WS_SS); bf16* KI = (bf16*)(F.ws + WS_KI); float* WI = (float*)(F.ws + WS_WI);
    LAS f32x4* red = (LAS f32x4*)(F.lds + RING_OFF);
    const int lane = F.lane, fr = lane & 15, fq = lane >> 4, w = F.wave;
    for (int blk = (int)blockIdx.x; blk < S / 64; blk += F.G) {
        const int row0 = blk * 64;
        const bf16* ap = hb + (size_t)(row0 >> 8) * (256 * D) + (size_t)(((row0 & 255) + fr) * 64 + 8 * fq);
        const bf16* wp = Wt + fr * 64 + 8 * fq;
        f32x4 acc[4][5];
#pragma unroll
        for (int rb = 0; rb < 4; ++rb)
#pragma unroll
            for (int cb = 0; cb < 5; ++cb) acc[rb][cb] = (f32x4){0.f, 0.f, 0.f, 0.f};
        bf16x8 a0[4], b0[5], a1[4], b1[5];
#define KIWI_LOAD(a, b, st) do { const int k = w * 256 + (st) * 32, ko = (k >> 6) * 16384 + (k & 63); _Pragma("unroll") for (int rb = 0; rb < 4; ++rb) a[rb] = *(const bf16x8*)(ap + rb * 1024 + ko); \
            _Pragma("unroll") for (int cb = 0; cb < 5; ++cb) b[cb] = *(const bf16x8*)(wp + cb * 1024 + ko); __builtin_amdgcn_sched_barrier(0); } while (0)
#define KIWI_MMA(a, b) do { _Pragma("unroll") for (int rb = 0; rb < 4; ++rb) _Pragma("unroll") for (int cb = 0; cb < 5; ++cb) acc[rb][cb] = __builtin_amdgcn_mfma_f32_16x16x32_bf16(b[cb], a[rb], acc[rb][cb], 0, 0, 0); \
            __builtin_amdgcn_sched_barrier(0); } while (0)
        KIWI_LOAD(a0, b0, 0);
#pragma unroll 1
        for (int it = 0; it < 4; ++it) {
            KIWI_LOAD(a1, b1, 2 * it + 1); KIWI_MMA(a0, b0);
            if (it < 3) KIWI_LOAD(a0, b0, 2 * it + 2);
            KIWI_MMA(a1, b1);
        }
#undef KIWI_LOAD
#undef KIWI_MMA
#pragma unroll
        for (int r = 0; r < 2; ++r) {
#pragma unroll
            for (int jb = 0; jb < 2; ++jb)
#pragma unroll
                for (int cb = 0; cb < 5; ++cb) red[(w * 10 + jb * 5 + cb) * 64 + lane] = acc[2 * r + jb][cb];
            __syncthreads();
            for (int item = w; item < 10; item += 8) {
                f32x4 v = red[item * 64 + lane];
#pragma unroll
                for (int ww = 1; ww < 8; ++ww) v += red[(ww * 10 + item) * 64 + lane];
                const int jb = item / 5, cb = item - 5 * jb, row = row0 + 16 * (2 * r + jb) + fr;
                const float rs = pg8::rstd_of(ss[row]);
                if (cb < 4) {
                    v = v * rs;
                    if (cb == 0) { const f32x4 c4 = *(const f32x4*)(cosi + (size_t)row * 8 + 4 * (fq & 1)), s4 = *(const f32x4*)(sini + (size_t)row * 8 + 4 * (fq & 1));
                                   f32x4 p; p[0] = __shfl_xor(v[0], 32); p[1] = __shfl_xor(v[1], 32); p[2] = __shfl_xor(v[2], 32); p[3] = __shfl_xor(v[3], 32);
                                   v = (fq < 2) ? (v * c4 - p * s4) : (v * c4 + p * s4); }
                    bf16* dst = KI + ((size_t)(((row >> 5) * 4 + cb) * 32 + (row & 31)) * 2 + (fq >> 1)) * 8 + 4 * (fq & 1);
                    *(pg8::u32x2*)dst = pg8::pack4(v);
                } else {
                    *(f32x4*)(WI + (size_t)row * 16 + 4 * fq) = v * (rs * 0.03125f);
                }
            }
            __syncthreads();
        }
    }
}

constexpr int CAP = 1024;
constexpr unsigned KEY_SCORE_MASK = 0xFFFFC000u;
__device__ __forceinline__ unsigned f2ord(float f) { const unsigned u = __float_as_uint(f); return (u & 0x80000000u) ? ~u : (u | 0x80000000u); }
__device__ __forceinline__ float ord2f(unsigned k) { const unsigned u = (k & 0x80000000u) ? (k & 0x7fffffffu) : ~k; return __uint_as_float(u); }
__device__ __forceinline__ unsigned pack_key(float s, int key) { return (f2ord(s) & KEY_SCORE_MASK) | (unsigned)key; }
template <int CTRL> __device__ __forceinline__ unsigned dpp_movu(unsigned v) { return (unsigned)__builtin_amdgcn_update_dpp(0u, v, CTRL, 0xf, 0xf, false); }
__device__ __forceinline__ unsigned umax2(unsigned a, unsigned b) { return a > b ? a : b; }
__device__ __forceinline__ unsigned wave_max_u32(unsigned v) {
    v = umax2(v, dpp_movu<0x128>(v)); v = umax2(v, dpp_movu<0x124>(v)); v = umax2(v, dpp_movu<0x122>(v)); v = umax2(v, dpp_movu<0x121>(v));
    { const auto r = __builtin_amdgcn_permlane16_swap(v, v, false, false); v = umax2(r[0], r[1]); }
    { const auto r = __builtin_amdgcn_permlane32_swap(v, v, false, false); v = umax2(r[0], r[1]); }
    return v;
}
template <bool EXACT, int NREG> __device__ __forceinline__ void topk_select(LAS unsigned* k_, int& cnt, float& tau, int lane) {
    const int n = cnt;
    unsigned k[NREG];
#pragma unroll
    for (int j = 0; j < NREG; ++j) { const int e = lane + 64 * j; k[j] = (e < n) ? k_[e] : 0u; }
    unsigned mxk = k[0], mnk = ~k[0];
#pragma unroll
    for (int j = 1; j < NREG; ++j) { mxk = umax2(mxk, k[j]); mnk = umax2(mnk, (lane + 64 * j < n) ? ~k[j] : 0u); }
    mxk = (unsigned)__builtin_amdgcn_readfirstlane((int)wave_max_u32(mxk)); mnk = ~(unsigned)__builtin_amdgcn_readfirstlane((int)wave_max_u32(mnk));
    const unsigned diff = mxk ^ mnk;
    const int top = 31 - __builtin_clz(diff);
    unsigned T = (top == 31) ? 0u : ((mxk >> (top + 1)) << (top + 1));
    for (int bit = top; bit >= 0; --bit) {
        const unsigned cand = T | (1u << bit);
        int c = 0;
#pragma unroll
        for (int j = 0; j < NREG; ++j) c += __popcll(__ballot(k[j] >= cand));
        if (c >= TOPK) { T = cand; if (c == TOPK || (!EXACT && c <= TOPK + 64)) break; }
    }
    int off = 0;
    const unsigned long long lm = (1ull << lane) - 1ull;
#pragma unroll
    for (int j = 0; j < NREG; ++j) {
        const bool g = k[j] >= T;
        const unsigned long long bg = __ballot(g);
        if (g) k_[off + __popcll(bg & lm)] = k[j];
        off += __popcll(bg);
    }
    cnt = off; tau = ord2f(T & KEY_SCORE_MASK);
    LDS_WAIT();
}
__device__ __forceinline__ float relu_f(float x) { const int b = __float_as_int(x); return __int_as_float(b > 0 ? b : 0); }
__device__ __forceinline__ float idx_score(const f32x16& acc, const float (&w)[16]) {
    float sc = 0.f;
#pragma unroll
    for (int i = 0; i < 16; ++i) sc = __builtin_fmaf(w[i], relu_f(acc[i]), sc);
    return sc;
}
__device__ __forceinline__ void idx_tile_tail2(float s0, float s1, int (&cnt)[2][2], float (&tau)[2][2], LAS unsigned* bk, int key, int q0, int r, int hh, int lane) {
    const float t0 = hh ? tau[0][1] : tau[0][0], t1 = hh ? tau[1][1] : tau[1][0];
    const bool p0 = (key <= q0 + hh) && (s0 > t0), p1 = (key <= q0 + 2 + hh) && (s1 > t1);
    const unsigned long long k0 = __ballot(p0), k1 = __ballot(p1);
    if (k0 | k1) {
        const unsigned a0 = (unsigned)k0, a1 = (unsigned)(k0 >> 32), b0 = (unsigned)k1, b1 = (unsigned)(k1 >> 32);
        const int na0 = __popc(a0), na1 = __popc(a1), nb0 = __popc(b0), nb1 = __popc(b1);
        const int pa = (int)__builtin_amdgcn_mbcnt_hi(a1, __builtin_amdgcn_mbcnt_lo(a0, 0u)) - (hh ? na0 : 0) + (hh ? cnt[0][1] : cnt[0][0]);
        const int pb = (int)__builtin_amdgcn_mbcnt_hi(b1, __builtin_amdgcn_mbcnt_lo(b0, 0u)) - (hh ? nb0 : 0) + (hh ? cnt[1][1] : cnt[1][0]);
        if (p0) bk[hh * CAP + pa] = pack_key(s0, key);
        if (p1) bk[(2 + hh) * CAP + pb] = pack_key(s1, key);
        cnt[0][0] += na0; cnt[0][1] += na1; cnt[1][0] += nb0; cnt[1][1] += nb1;
    }
}
template <bool EXACT> __device__ __forceinline__ void idx_reselect(int (&cnt)[2][2], float (&tau)[2][2], LAS unsigned* bk, int limit, int lane) {
#pragma unroll 1
    for (int qs = 0; qs < 4; ++qs) {
        int c = qs == 0 ? cnt[0][0] : (qs == 1 ? cnt[0][1] : (qs == 2 ? cnt[1][0] : cnt[1][1]));
        if (c > limit) {
            float t = 0.f;
            if (EXACT) {
                if (c > TOPK + 64) topk_select<false, 16>(bk + qs * CAP, c, t, lane);
                if (c > TOPK) topk_select<true, 5>(bk + qs * CAP, c, t, lane);
            } else topk_select<false, 16>(bk + qs * CAP, c, t, lane);
            cnt[0][0] = qs == 0 ? c : cnt[0][0]; cnt[0][1] = qs == 1 ? c : cnt[0][1]; cnt[1][0] = qs == 2 ? c : cnt[1][0]; cnt[1][1] = qs == 3 ? c : cnt[1][1];
            tau[0][0] = qs == 0 ? t : tau[0][0]; tau[0][1] = qs == 1 ? t : tau[0][1]; tau[1][0] = qs == 2 ? t : tau[1][0]; tau[1][1] = qs == 3 ? t : tau[1][1];
        }
    }
}
template <int PMODE> __device__ __forceinline__ void p2_indexer(Frame& F) {
    unsigned* qctr = (unsigned*)(F.ws + WS_CTL) + CW_P2Q;
    const bf16* QI = (const bf16*)(F.ws + WS_QI); const bf16* KI = (const bf16*)(F.ws + WS_KI); const float* WI = (const float*)(F.ws + WS_WI);
    unsigned short* sel = (unsigned short*)(F.ws + WS_SEL);
    const int lane = F.lane, r = lane & 31, hh = lane >> 5;
    LAS unsigned* bk = (LAS unsigned*)(F.lds + RING_OFF + F.wave * 16384);
    constexpr int NT = S / 4;
    for (;;) {
        unsigned tk = 0u; if (lane == 0) tk = xb_add(qctr, 1u);
        const int kk = __builtin_amdgcn_readfirstlane((int)tk);
        if (kk >= NT) break;
        const int task = NT - 1 - kk, q0 = task * 4;
        bf16x8 Af[2][4]; float w[2][16];
#pragma unroll
        for (int pi = 0; pi < 2; ++pi) {
            const int qa = q0 + 2 * pi + ((r >> 2) & 1), head = (r & 3) + 4 * (r >> 3);
#pragma unroll
            for (int ks = 0; ks < 4; ++ks) Af[pi][ks] = *(const bf16x8*)(QI + pg8::tm_off(qa, head * 64 + 16 * ks + 8 * hh, 1024));
#pragma unroll
            for (int i = 0; i < 4; ++i) { const f32x4 t = *(const f32x4*)(WI + (size_t)(q0 + 2 * pi + hh) * 16 + 4 * i); w[pi][4 * i] = t[0]; w[pi][4 * i + 1] = t[1]; w[pi][4 * i + 2] = t[2]; w[pi][4 * i + 3] = t[3]; }
        }
        int cnt[2][2] = {{0, 0}, {0, 0}}; float tau[2][2];
        tau[0][0] = tau[0][1] = tau[1][0] = tau[1][1] = -__builtin_inff();
        const int ntile = (q0 + 3) / 32 + 1;
        const bf16* kb = KI + (size_t)(r * 2 + hh) * 8;
        bf16x8 Bf[4];
#define P2_LOADB(t_) do { const int tc_ = (t_) < ntile ? (t_) : ntile - 1; const bf16* kn_ = kb + (size_t)tc_ * 2048; \
            _Pragma("unroll") for (int ks = 0; ks < 4; ++ks) Bf[ks] = *(const bf16x8*)(kn_ + ks * 512); } while (0)
#define P2_MFMA(x0_, x1_) do { _Pragma("unroll") for (int i = 0; i < 16; ++i) { x0_[i] = 0.f; x1_[i] = 0.f; } \
            _Pragma("unroll") for (int ks = 0; ks < 4; ++ks) x0_ = __builtin_amdgcn_mfma_f32_32x32x16_bf16(Af[0][ks], Bf[ks], x0_, 0, 0, 0); \
            _Pragma("unroll") for (int ks = 0; ks < 4; ++ks) x1_ = __builtin_amdgcn_mfma_f32_32x32x16_bf16(Af[1][ks], Bf[ks], x1_, 0, 0, 0); } while (0)
#define P2_TAIL(x0_, x1_, t_) do { const int key = (t_) * 32 + r; \
            if (PMODE == 0) { const float s0 = idx_score(x0_, w[0]), s1 = idx_score(x1_, w[1]); \
                idx_tile_tail2(s0, s1, cnt, tau, bk, key, q0, r, hh, lane); \
                if ((cnt[0][0] > CAP - 32) | (cnt[0][1] > CAP - 32) | (cnt[1][0] > CAP - 32) | (cnt[1][1] > CAP - 32)) idx_reselect<false>(cnt, tau, bk, CAP - 32, lane); } \
            else if (PMODE == 1) { const float s0 = idx_score(x0_, w[0]), s1 = idx_score(x1_, w[1]); asm volatile("" :: "v"(s0), "v"(s1), "v"(key)); } \
            else { asm volatile("" :: "v"(x0_[0]), "v"(x1_[0]), "v"(x0_[15]), "v"(x1_[15]), "v"(key)); } } while (0)
        f32x16 a0, a1, b0, b1;
        P2_LOADB(0); P2_MFMA(a0, a1); P2_LOADB(1);
        for (int tile = 0; tile < ntile; tile += 2) {
            P2_MFMA(b0, b1); P2_LOADB(tile + 2);
            P2_TAIL(a0, a1, tile);
            if (tile + 1 >= ntile) break;
            P2_MFMA(a0, a1); P2_LOADB(tile + 3);
            P2_TAIL(b0, b1, tile + 1);
        }
#undef P2_LOADB
#undef P2_MFMA
#undef P2_TAIL
        if (PMODE == 0) {
            idx_reselect<true>(cnt, tau, bk, TOPK, lane);
            LDS_WAIT();
#pragma unroll 1
            for (int qs = 0; qs < 4; ++qs) {
                const int n = qs == 0 ? cnt[0][0] : (qs == 1 ? cnt[0][1] : (qs == 2 ? cnt[1][0] : cnt[1][1]));
#pragma unroll
                for (int j = 0; j < 4; ++j) { const int e = lane + 64 * j; if (e < n) sel[(size_t)(q0 + qs) * TOPK + e] = (unsigned short)(bk[qs * CAP + e] & 0x3FFFu); }
            }
        }
        LDS_WAIT();
    }
}

__device__ __forceinline__ long pk_long(unsigned lo, unsigned hi) { return (long)(((unsigned long long)hi << 32) | (unsigned long long)lo); }
typedef int v2i __attribute__((ext_vector_type(2)));
__device__ __forceinline__ void p3_sparse_fp8(Frame& F) {
    const unsigned char* Qp = F.ws + WS_QA; const unsigned char* K8 = F.ws + WS_KA; const unsigned char* V8 = F.ws + WS_VA;
    const unsigned short* sel = (const unsigned short*)(F.ws + WS_SEL); bf16* Op = (bf16*)(F.ws + WS_OA);
    LAS float* Pt = (LAS float*)(F.lds + RING_OFF + F.wave * 16384);
    LAS unsigned* Sl = (LAS unsigned*)(F.lds + RING_OFF + F.wave * 16384 + 4096);
    LAS unsigned char* Kst = F.lds + RING_OFF + F.wave * 16384 + 8192;
    const int lane = F.lane, c16 = lane & 15, kg = lane >> 4, e8 = lane >> 3, ch = lane & 7;
    const int gw = F.vcu * NWAVES + F.wave, NGW = F.G * NWAVES;
    const float scale = 0.08838834764831845f * 1.4426950408889634f;
    unsigned short selv[4]; v4u qv[2];
    const int gsh = (F.G % 8 == 0) ? ((F.vcu / (F.G / 8)) & 3) : 0;
    { const int task = gw; if (task < 4 * S) { const int g0 = task / S, t = task - g0 * S, g = (g0 + gsh) & 3;
#pragma unroll
        for (int i = 0; i < 4; ++i) selv[i] = sel[(size_t)t * TOPK + lane + 64 * i];
        { const unsigned char* q8 = Qp + pg8::tm_off(t, (4 * g + (c16 & 3)) * 128 + 32 * kg, 2048); qv[0] = *(const GAS v4u*)q8; qv[1] = *(const GAS v4u*)(q8 + 16); } } }
    for (int task = gw; task < 4 * S; task += NGW) {
        const int g0 = task / S, t = task - g0 * S, g = (g0 + gsh) & 3;
        const int n = t + 1 < TOPK ? t + 1 : TOPK;
#pragma unroll
        for (int i = 0; i < 4; ++i) { const int e = lane + 64 * i; Sl[(e & 128) | ((e & 7) << 4) | ((e >> 3) & 15)] = e < n ? (unsigned)selv[i] : 0x80000000u; }
        long Aq[4];
        Aq[0] = (c16 < 4) ? pk_long(qv[0].x, qv[0].y) : 0l; Aq[1] = (c16 < 4) ? pk_long(qv[0].z, qv[0].w) : 0l;
        Aq[2] = (c16 < 4) ? pk_long(qv[1].x, qv[1].y) : 0l; Aq[3] = (c16 < 4) ? pk_long(qv[1].z, qv[1].w) : 0l;
        LDS_WAIT();
        const unsigned char* kb2 = K8 + (size_t)g * S * 128 + 16 * ch;
        const unsigned char* vb2 = V8 + (size_t)g * S * 128 + 16 * ch;
        float mxl = -__builtin_inff();
#pragma unroll
        for (int half = 0; half < 2; ++half) {
            v4u kq[16];
            { const LAS v4u* sp = (const LAS v4u*)(Sl + 128 * half + 16 * e8);
#pragma unroll
              for (int u4 = 0; u4 < 4; ++u4) { const v4u pp = sp[u4];
                  kq[4 * u4 + 0] = *(const GAS v4u*)(kb2 + (size_t)(pp.x & 0x7fffffffu) * 128); kq[4 * u4 + 1] = *(const GAS v4u*)(kb2 + (size_t)(pp.y & 0x7fffffffu) * 128);
                  kq[4 * u4 + 2] = *(const GAS v4u*)(kb2 + (size_t)(pp.z & 0x7fffffffu) * 128); kq[4 * u4 + 3] = *(const GAS v4u*)(kb2 + (size_t)(pp.w & 0x7fffffffu) * 128); } }
            __builtin_amdgcn_sched_barrier(0);
#pragma unroll
            for (int r2 = 0; r2 < 2; ++r2) {
#pragma unroll
                for (int uu = 0; uu < 8; ++uu) { const int ksl = 8 * uu + e8; *(LAS v4u*)(Kst + ksl * 128 + 16 * (ch ^ ((ksl >> 1) & 7))) = kq[8 * r2 + uu]; }
#pragma unroll
                for (int g4 = 0; g4 < 4; ++g4) {
                    const int ksl = 16 * g4 + c16, eb = 128 * half + 64 * r2 + 16 * g4 + 4 * kg, f = (ksl >> 1) & 7;
                    const v4u k0 = *(const LAS v4u*)(Kst + ksl * 128 + 16 * ((2 * kg) ^ f)), k1 = *(const LAS v4u*)(Kst + ksl * 128 + 16 * ((2 * kg + 1) ^ f));
                    f32x4 a = (f32x4){0.f, 0.f, 0.f, 0.f};
                    a = __builtin_amdgcn_mfma_f32_16x16x32_fp8_fp8(pk_long(k0.x, k0.y), Aq[0], a, 0, 0, 0);
                    a = __builtin_amdgcn_mfma_f32_16x16x32_fp8_fp8(pk_long(k0.z, k0.w), Aq[1], a, 0, 0, 0);
                    a = __builtin_amdgcn_mfma_f32_16x16x32_fp8_fp8(pk_long(k1.x, k1.y), Aq[2], a, 0, 0, 0);
                    a = __builtin_amdgcn_mfma_f32_16x16x32_fp8_fp8(pk_long(k1.z, k1.w), Aq[3], a, 0, 0, 0);
                    f32x4 sv;
#pragma unroll
                    for (int j = 0; j < 4; ++j) { sv[j] = (eb + j < n) ? a[j] * scale : -__builtin_inff(); mxl = __builtin_fmaxf(mxl, sv[j]); }
                    if (c16 < 4) *(LAS f32x4*)(Pt + c16 * 256 + eb) = sv;
                }
            }
            __builtin_amdgcn_sched_barrier(0);
        }
        v4u vA[8], vB[8];
        { const LAS v4u* sp = (const LAS v4u*)(Sl + 16 * e8); const v4u p0 = sp[0], p1 = sp[1];
          vA[0] = *(const GAS v4u*)(vb2 + (size_t)(p0.x & 0x7fffffffu) * 128); vA[1] = *(const GAS v4u*)(vb2 + (size_t)(p0.y & 0x7fffffffu) * 128);
          vA[2] = *(const GAS v4u*)(vb2 + (size_t)(p0.z & 0x7fffffffu) * 128); vA[3] = *(const GAS v4u*)(vb2 + (size_t)(p0.w & 0x7fffffffu) * 128);
          vA[4] = *(const GAS v4u*)(vb2 + (size_t)(p1.x & 0x7fffffffu) * 128); vA[5] = *(const GAS v4u*)(vb2 + (size_t)(p1.y & 0x7fffffffu) * 128);
          vA[6] = *(const GAS v4u*)(vb2 + (size_t)(p1.z & 0x7fffffffu) * 128); vA[7] = *(const GAS v4u*)(vb2 + (size_t)(p1.w & 0x7fffffffu) * 128); }
        float mx[4];
        { const float mm = swap32_max(swap16_max(mxl));
#pragma unroll
          for (int j = 0; j < 4; ++j) mx[j] = __int_as_float(__builtin_amdgcn_readlane(__float_as_int(mm), j)); }
        LDS_WAIT();
        float sum[4] = {0.f, 0.f, 0.f, 0.f};
#pragma unroll
        for (int j = 0; j < 4; ++j)
#pragma unroll
            for (int i = 0; i < 4; ++i) {
                const int e = lane + 64 * i;
                const float pr = __builtin_amdgcn_exp2f(Pt[j * 256 + e] - mx[j] + 8.0f);
                sum[j] += pr; Pt[j * 256 + e] = pr;
            }
#pragma unroll
        for (int j = 0; j < 4; ++j) sum[j] = wave_sum(sum[j]);
        { const int tn = task + NGW; if (tn < 4 * S) { const int g20 = tn / S, t2 = tn - g20 * S, g2 = (g20 + gsh) & 3;
#pragma unroll
            for (int i = 0; i < 4; ++i) selv[i] = sel[(size_t)t2 * TOPK + lane + 64 * i];
            { const unsigned char* q8 = Qp + pg8::tm_off(t2, (4 * g2 + (c16 & 3)) * 128 + 32 * kg, 2048); qv[0] = *(const GAS v4u*)q8; qv[1] = *(const GAS v4u*)(q8 + 16); } } }
        LDS_WAIT();
        f32x4 oacc[8];
#pragma unroll
        for (int dt = 0; dt < 8; ++dt) oacc[dt] = (f32x4){0.f, 0.f, 0.f, 0.f};
#pragma unroll
        for (int c4 = 0; c4 < 4; ++c4) {
#pragma unroll
            for (int uu = 0; uu < 8; ++uu) { const int ksl = 8 * uu + e8; *(LAS v4u*)(Kst + ksl * 128 + 16 * (ch ^ ((ksl >> 1) & 7))) = (c4 & 1) ? vB[uu] : vA[uu]; }
            if (c4 < 3) {
                const LAS unsigned* sp = Sl + 128 * ((c4 + 1) >> 1) + 16 * e8 + 8 * ((c4 + 1) & 1); const v4u p0 = *(const LAS v4u*)sp, p1 = *(const LAS v4u*)(sp + 4);
                const unsigned ps[8] = {p0.x, p0.y, p0.z, p0.w, p1.x, p1.y, p1.z, p1.w};
#pragma unroll
                for (int u = 0; u < 8; ++u) { const v4u vv = *(const GAS v4u*)(vb2 + (size_t)(ps[u] & 0x7fffffffu) * 128); if (c4 & 1) vA[u] = vv; else vB[u] = vv; }
            }
#pragma unroll
            for (int ks2 = 0; ks2 < 2; ++ks2) {
                const LAS float* pp = Pt + (c16 & 3) * 256 + 64 * c4 + 32 * ks2 + 8 * kg;
                const f32x4 p0 = *(const LAS f32x4*)pp, p1 = *(const LAS f32x4*)(pp + 4);
                int w0 = __builtin_amdgcn_cvt_pk_fp8_f32(p0[0], p0[1], 0, false); w0 = __builtin_amdgcn_cvt_pk_fp8_f32(p0[2], p0[3], w0, true);
                int w1 = __builtin_amdgcn_cvt_pk_fp8_f32(p1[0], p1[1], 0, false); w1 = __builtin_amdgcn_cvt_pk_fp8_f32(p1[2], p1[3], w1, true);
                const long Ap = (c16 < 4) ? pk_long((unsigned)w0, (unsigned)w1) : 0l;
                const int ksl = 32 * ks2 + 8 * kg + (c16 >> 1), f = (ksl >> 1) & 7;
                const LAS unsigned char* vrow = Kst + ksl * 128 + 8 * (c16 & 1);
#pragma unroll
                for (int dt = 0; dt < 8; ++dt) {
                    const v2i bv = __builtin_amdgcn_ds_read_tr8_b64_v2i32((LAS v2i*)(vrow + 16 * (dt ^ f)));
                    oacc[dt] = __builtin_amdgcn_mfma_f32_16x16x32_fp8_fp8(pk_long((unsigned)bv.x, (unsigned)bv.y), Ap, oacc[dt], 0, 0, 0);
                }
            }
        }
        LDS_WAIT();
        if (c16 < 4) {
            const float sh = c16 == 0 ? sum[0] : (c16 == 1 ? sum[1] : (c16 == 2 ? sum[2] : sum[3])); const float inv = 1.0f / sh;
            bf16* ob = Op + ktm_off(t, (4 * g + c16) * 128 + 4 * kg);
#pragma unroll
            for (int dt = 0; dt < 8; ++dt) { v2u w; w.x = pk2(oacc[dt][0] * inv, oacc[dt][1] * inv); w.y = pk2(oacc[dt][2] * inv, oacc[dt][3] * inv);
                *(GAS v2u*)(ob + (dt >> 2) * 16384 + 16 * (dt & 3)) = w; }
        }
        LDS_WAIT();
    }
}

constexpr size_t KC8_BYTES = (size_t)4 * 512 * 4096;
__device__ __forceinline__ unsigned pk4_fp8(float a, float b, float c, float d) { int w = __builtin_amdgcn_cvt_pk_fp8_f32(a, b, 0, false); return (unsigned)__builtin_amdgcn_cvt_pk_fp8_f32(c, d, w, true); }
__device__ __forceinline__ float bfu(unsigned short v) { return __uint_as_float(((unsigned)v) << 16); }
__device__ __forceinline__ void p8_kv_copies(Frame& F) {
    const bf16* Ks = (const bf16*)(F.ws + WS_KS); const bf16* Vs = (const bf16*)(F.ws + WS_VS);
    LAS unsigned short* scr = (LAS unsigned short*)(F.lds + RING_OFF + F.wave * 16384);
    const int gw = F.vcu * NWAVES + F.wave, NGW = F.G * NWAVES, lane = F.lane;
    constexpr int NITEM = 3 * 4 * (S / 32);
    auto item_load = [&](int it, v4u (&kr)[8], v4u (&vr)[8]) {
        const int tile = it & 511, kh = (it >> 9) & 3, g = it >> 11;
        const int sh = 2 * g, per = S >> sh;
        const int idx0 = tile * 32, rho = idx0 / per, kap0 = idx0 - rho * per;
#pragma unroll
        for (int q = 0; q < 8; ++q) {
            const int ch = q * 64 + lane, key = ch >> 4, cc = ch & 15;
            const int pos = rho + ((kap0 + key) << sh);
            kr[q] = *(const GAS v4u*)(Ks + pg8::tm_off(pos, kh * 128 + 8 * cc, 512));
            vr[q] = *(const GAS v4u*)(Vs + pg8::tm_off(pos, kh * 128 + 8 * cc, 512));
        }
    };
    v4u kc[8], vc[8], kn[8], vn[8];
    if (gw < NITEM) item_load(gw, kc, vc);
    for (int it = gw; it < NITEM; it += NGW) {
        const int tile = it & 511, kh = (it >> 9) & 3, g = it >> 11;
        unsigned char* Kc = F.outb + (size_t)g * KC8_BYTES + (size_t)(kh * 512 + tile) * 4096;
        unsigned char* Vc = F.ws + (g == 0 ? WS_VT0 : (g == 1 ? WS_VT1 : WS_VT2)) + (size_t)(kh * 512 + tile) * 4096;
        const bool more = it + NGW < NITEM;
        if (more) item_load(it + NGW, kn, vn);
#pragma unroll
        for (int q = 0; q < 8; ++q) {
            const int ch = q * 64 + lane, key = ch >> 4, cc = ch & 15;
            *(LAS v4u*)(scr + key * 128 + 8 * cc) = kc[q];
            *(LAS v4u*)(scr + 4096 + key * 128 + 8 * cc) = vc[q];
        }
        LDS_WAIT(); asm volatile("" ::: "memory");
#pragma unroll
        for (int q = 0; q < 4; ++q) {
            const int co = q * 64 + lane;
            { const int hh = co & 1, key = (co >> 1) & 31, ksp = co >> 6;
              const LAS unsigned short* s0 = scr + key * 128 + 32 * ksp + 8 * hh;
              v4u w; w.x = pk4_fp8(bfu(s0[0]), bfu(s0[1]), bfu(s0[2]), bfu(s0[3])); w.y = pk4_fp8(bfu(s0[4]), bfu(s0[5]), bfu(s0[6]), bfu(s0[7]));
              w.z = pk4_fp8(bfu(s0[16]), bfu(s0[17]), bfu(s0[18]), bfu(s0[19])); w.w = pk4_fp8(bfu(s0[20]), bfu(s0[21]), bfu(s0[22]), bfu(s0[23]));
              *(GAS v4u*)(Kc + 16 * co) = w; }
            { const int hh = co & 1, dimt = (co >> 1) & 31, dt = co >> 6, dim = 32 * dt + dimt;
              float e[16];
#pragma unroll
              for (int s2 = 0; s2 < 2; ++s2)
#pragma unroll
                  for (int j = 0; j < 8; ++j) e[8 * s2 + j] = bfu(scr[4096 + (16 * s2 + 8 * (j >> 2) + 4 * hh + (j & 3)) * 128 + dim]);
              v4u w; w.x = pk4_fp8(e[0], e[1], e[2], e[3]); w.y = pk4_fp8(e[4], e[5], e[6], e[7]); w.z = pk4_fp8(e[8], e[9], e[10], e[11]); w.w = pk4_fp8(e[12], e[13], e[14], e[15]);
              *(GAS v4u*)(Vc + 16 * co) = w; }
        }
        LDS_WAIT(); asm volatile("" ::: "memory");
        if (more) {
#pragma unroll
            for (int q = 0; q < 8; ++q) { kc[q] = kn[q]; vc[q] = vn[q]; }
        }
    }
}

__device__ __forceinline__ void p9_dilated_dense(Frame& F) {
    const unsigned char* Q2 = F.ws + WS_Q2; bf16* O2 = (bf16*)(F.ws + WS_O2);
    const int lane = F.lane, ar = lane & 31, h = lane >> 5, qi = ar >> 2, rep = ar & 3;
    const int gw = F.vcu * NWAVES + F.wave, NGW = F.G * NWAVES;
    const float scale = 0.08838834764831845f * 1.4426950408889634f;
    for (int uid = gw; uid < 8192; uid += NGW) {
        const int c = uid & 15, b = (uid >> 4) & 127, kh = uid >> 11;
        const int t = c + 16 * (8 * b + qi);
        f32x16 O[4];
#pragma unroll
        for (int dt = 0; dt < 4; ++dt)
#pragma unroll
            for (int i = 0; i < 16; ++i) O[dt][i] = 0.f;
        float m = -1e30f, l = 0.f;
#pragma unroll 1
        for (int g = 0; g < 3; ++g) {
            const int sh = 2 * g, per = S >> sh;
            const int rho = (g == 0) ? 0 : ((g == 1) ? (c & 3) : c);
            const int tau = (t - rho) >> sh;
            const int wlo = tau > 128 ? tau - 128 : 0; const unsigned wrng = (unsigned)(tau - wlo);
            const int tau0 = (c + 128 * b - rho) >> sh, tau7 = tau0 + 7 * (16 >> sh);
            const int full_lo = tau7 > 128 ? tau7 - 128 : 0, full_hi = tau0;
            const int kap0 = (g == 0) ? (128 * b - 128) : ((g == 1) ? (32 * b - 128) : ((8 * b - 128) & ~31));
            const int ntile = (g == 0) ? 8 : 5;
            const int tmax = (per >> 5) - 1;
            const unsigned char* Kc = F.outb + (size_t)g * KC8_BYTES + ((size_t)kh * 512 + (size_t)rho * (per >> 5)) * 4096 + (ar * 2 + h) * 16;
            const unsigned char* Vc = F.ws + (g == 0 ? WS_VT0 : (g == 1 ? WS_VT1 : WS_VT2)) + ((size_t)kh * 512 + (size_t)rho * (per >> 5)) * 4096 + (ar * 2 + h) * 16;
            long Qf[8];
            const int tt0 = kap0 >= -31 ? 0 : ((-31 - kap0) + 31) / 32;
            v4u K0[4], V0[4], K1[4], V1[4], K2[4], V2[4]; long Pf[2]; f32x16 acc;
#define P9_GLD(dst_, ptr_, off_) asm volatile("global_load_dwordx4 %0, %1, off offset:" #off_ : "=v"(dst_) : "v"(ptr_) : "memory")
#define P9_LOAD(KF_, VF_, tt_) do { int ti_ = (kap0 + 32 * ((tt_) < ntile ? (tt_) : ntile - 1)) >> 5;     \
                ti_ = ti_ < 0 ? 0 : (ti_ > tmax ? tmax : ti_); const unsigned char* kp_ = Kc + (size_t)ti_ * 4096; const unsigned char* vp_ = Vc + (size_t)ti_ * 4096; \
                P9_GLD(KF_[0], kp_, 0); P9_GLD(KF_[1], kp_, 1024); P9_GLD(KF_[2], kp_, 2048); P9_GLD(KF_[3], kp_, 3072); P9_GLD(VF_[0], vp_, 0); P9_GLD(VF_[1], vp_, 1024); P9_GLD(VF_[2], vp_, 2048); P9_GLD(VF_[3], vp_, 3072); } while (0)
#define P9_WAIT(KF_, VF_) do { asm volatile("s_waitcnt vmcnt(16)" : "+v"(KF_[0]), "+v"(KF_[1]), "+v"(KF_[2]), "+v"(KF_[3]), "+v"(VF_[0]), "+v"(VF_[1]), "+v"(VF_[2]), "+v"(VF_[3]) :: "memory"); __builtin_amdgcn_sched_barrier(0); } while (0)
#define P9_BODY(KF_, VF_, tt_) do { \
                _Pragma("unroll") for (int i = 0; i < 16; ++i) acc[i] = 0.f; \
                _Pragma("unroll") for (int kp2 = 0; kp2 < 4; ++kp2) { acc = __builtin_amdgcn_mfma_f32_32x32x16_fp8_fp8(pk_long(KF_[kp2].x, KF_[kp2].y), Qf[2 * kp2], acc, 0, 0, 0); \
                    acc = __builtin_amdgcn_mfma_f32_32x32x16_fp8_fp8(pk_long(KF_[kp2].z, KF_[kp2].w), Qf[2 * kp2 + 1], acc, 0, 0, 0); } \
                const int kt = kap0 + 32 * (tt_); float mloc = -__builtin_inff(); \
                if (!(kt >= full_lo && kt + 31 <= full_hi)) {            \
                    const unsigned dbase = (unsigned)(kt + 4 * h - wlo); \
                    _Pragma("unroll") for (int i = 0; i < 16; ++i) acc[i] = (dbase + (unsigned)((i & 3) + 8 * (i >> 2)) <= wrng) ? acc[i] : -__builtin_inff(); } \
                _Pragma("unroll") for (int i = 0; i < 16; ++i) mloc = __builtin_fmaxf(mloc, acc[i]); \
                mloc = swap32_max(mloc) * scale;                         \
                const float mnew = __builtin_fmaxf(m, mloc); const float alpha = __builtin_amdgcn_exp2f(m - mnew); const float off = 8.0f - mnew; float ls = 0.f; \
                _Pragma("unroll") for (int i = 0; i < 16; ++i) { acc[i] = __builtin_amdgcn_exp2f(__builtin_fmaf(acc[i], scale, off)); ls += acc[i]; } \
                ls = swap32_sum(ls); l = l * alpha + ls; m = mnew; \
                _Pragma("unroll") for (int dt = 0; dt < 4; ++dt) _Pragma("unroll") for (int i = 0; i < 16; ++i) O[dt][i] *= alpha; \
                _Pragma("unroll") for (int s2 = 0; s2 < 2; ++s2) Pf[s2] = pk_long(pk4_fp8(acc[8 * s2 + 0], acc[8 * s2 + 1], acc[8 * s2 + 2], acc[8 * s2 + 3]), pk4_fp8(acc[8 * s2 + 4], acc[8 * s2 + 5], acc[8 * s2 + 6], acc[8 * s2 + 7])); \
                _Pragma("unroll") for (int dt = 0; dt < 4; ++dt) { O[dt] = __builtin_amdgcn_mfma_f32_32x32x16_fp8_fp8(pk_long(VF_[dt].x, VF_[dt].y), Pf[0], O[dt], 0, 0, 0); \
                    O[dt] = __builtin_amdgcn_mfma_f32_32x32x16_fp8_fp8(pk_long(VF_[dt].z, VF_[dt].w), Pf[1], O[dt], 0, 0, 0); } } while (0)
            P9_LOAD(K0, V0, tt0); P9_LOAD(K1, V1, tt0 + 1); P9_LOAD(K2, V2, tt0 + 2);
            { const unsigned char* qp = Q2 + pg8::tm_off(t, (g * 16 + 4 * kh + rep) * 128 + 8 * h, 6144);
#pragma unroll
              for (int ks = 0; ks < 8; ++ks) Qf[ks] = *(const GAS long*)(qp + 16 * ks); }
            asm volatile("" : "+v"(Qf[0]), "+v"(Qf[1]), "+v"(Qf[2]), "+v"(Qf[3]), "+v"(Qf[4]), "+v"(Qf[5]), "+v"(Qf[6]), "+v"(Qf[7]) :: "memory");
            for (int tt = tt0; tt < ntile; tt += 3) {
                P9_WAIT(K0, V0); P9_BODY(K0, V0, tt); P9_LOAD(K0, V0, tt + 3);
                if (tt + 1 >= ntile) break;
                P9_WAIT(K1, V1); P9_BODY(K1, V1, tt + 1); P9_LOAD(K1, V1, tt + 4);
                if (tt + 2 >= ntile) break;
                P9_WAIT(K2, V2); P9_BODY(K2, V2, tt + 2); P9_LOAD(K2, V2, tt + 5);
            }
            asm volatile("s_waitcnt vmcnt(0)" : "+v"(K0[0]), "+v"(K0[1]), "+v"(K0[2]), "+v"(K0[3]), "+v"(V0[0]), "+v"(V0[1]), "+v"(V0[2]), "+v"(V0[3]), "+v"(K1[0]), "+v"(K1[1]), "+v"(K1[2]), "+v"(K1[3]),
                         "+v"(V1[0]), "+v"(V1[1]), "+v"(V1[2]), "+v"(V1[3]), "+v"(K2[0]), "+v"(K2[1]), "+v"(K2[2]), "+v"(K2[3]), "+v"(V2[0]), "+v"(V2[1]), "+v"(V2[2]), "+v"(V2[3]) :: "memory");
#undef P9_GLD
#undef P9_LOAD
#undef P9_WAIT
#undef P9_BODY
        }
        const float inv = 1.0f / l;
        bf16* op = O2 + ktm_off(t, (4 * kh + rep) * 128 + 8 * h);
#pragma unroll
        for (int dt = 0; dt < 4; ++dt)
#pragma unroll
            for (int q = 0; q < 4; q += 2) {
                const unsigned x0 = pg8::cvt_pk_bf16(O[dt][4 * q] * inv, O[dt][4 * q + 1] * inv), x1 = pg8::cvt_pk_bf16(O[dt][4 * q + 2] * inv, O[dt][4 * q + 3] * inv);
                const unsigned y0 = pg8::cvt_pk_bf16(O[dt][4 * q + 4] * inv, O[dt][4 * q + 5] * inv), y1 = pg8::cvt_pk_bf16(O[dt][4 * q + 6] * inv, O[dt][4 * q + 7] * inv);
                const auto r0 = __builtin_amdgcn_permlane32_swap(x0, y0, false, false), r1 = __builtin_amdgcn_permlane32_swap(x1, y1, false, false);
                v4u w; w.x = r0[0]; w.y = r1[0]; w.z = r0[1]; w.w = r1[1];
                *(GAS v4u*)(op + (dt >> 1) * 16384 + 32 * (dt & 1) + 8 * q) = w;
            }
    }
}

__device__ __forceinline__ void p13_final(Frame& F, const Params& P) {
    const int gw = F.vcu * NWAVES + F.wave, NGW = F.G * NWAVES;
    const pg8::ssq_t* ss4 = (const pg8::ssq_t*)(F.ws + WS_SS) + 4 * S; const float* gn = P.in[12]; const bf16* hb = (const bf16*)(F.ws + WS_HB);
    f32x4 gv[4][2];
#pragma unroll
    for (int j = 0; j < 4; ++j) { gv[j][0] = *((const f32x4*)gn + 2 * (F.lane + 64 * j)); gv[j][1] = *((const f32x4*)gn + 2 * (F.lane + 64 * j) + 1); }
    for (int m = gw; m < S; m += NGW) {
        const float rs = pg8::rstd_of(ss4[m]);
        const GAS v4u* hr = (const GAS v4u*)(hb + (size_t)(m >> 8) * (256 * D) + (size_t)((F.lane >> 3) * 16384 + (m & 255) * 64 + 8 * (F.lane & 7)));
        GAS f32x4* xr = (GAS f32x4*)(P.out + (size_t)m * D);
#pragma unroll
        for (int j = 0; j < 4; ++j) {
            const v4u v = hr[(8 * 16384 / 8) * j];
            const f32x4 lo = (f32x4){__uint_as_float(v.x << 16), __uint_as_float(v.x & 0xffff0000u), __uint_as_float(v.y << 16), __uint_as_float(v.y & 0xffff0000u)};
            const f32x4 hi = (f32x4){__uint_as_float(v.z << 16), __uint_as_float(v.z & 0xffff0000u), __uint_as_float(v.w << 16), __uint_as_float(v.w & 0xffff0000u)};
            xr[2 * (F.lane + 64 * j)] = lo * rs * gv[j][0]; xr[2 * (F.lane + 64 * j) + 1] = hi * rs * gv[j][1];
        }
    }
}


__global__ void __launch_bounds__(NWAVES * 64, 2) yoco_fwd(Params P) {
    extern __shared__ __attribute__((aligned(16))) unsigned char lds[];
    Frame F;
    F.lds = (LAS unsigned char*)lds;
    F.tid = threadIdx.x; F.lane = F.tid & 63; F.wave = __builtin_amdgcn_readfirstlane(F.tid >> 6);
    F.G = gridDim.x; { const int bx = blockIdx.x; F.vcu = (F.G % 8 == 0) ? (bx % 8) * (F.G / 8) + bx / 8 : bx; }
    F.ws = P.ws; F.outb = (unsigned char*)P.out;
    volatile LAS unsigned* MISC = (volatile LAS unsigned*)(F.lds + MISC_OFF);
    for (int u = F.tid; u < (LDS_BYTES - LDSCTL_OFF) / 4; u += NWAVES * 64) ((LAS unsigned*)(F.lds + LDSCTL_OFF))[u] = 0u;
    __syncthreads();
    const int lo = P.ph_lo, hi = P.ph_hi;
    const bool multi = (hi - lo) > 1;
    XcdBarrier bar; bar.bar = (unsigned*)(P.ws + WS_CTL) + CW_BAR; bar.x = 0; bar.st = nullptr;
    if (multi) bar = xcd_barrier_post((unsigned*)(P.ws + WS_CTL) + CW_BAR, MISC + 8);
#define IN(k) (lo <= (k) && (k) < hi)
#define BOTH(k) (IN(k) && IN((k) + 1))
#define GRID_BAR(k) do { if (BOTH(k)) xcd_barrier(bar); } while (0)
#ifndef PROBE_MASK
#define PROBE_MASK 0
#endif
#define REP(k) _Pragma("unroll") for (int rep_ = 0; rep_ < ((((PROBE_MASK) >> (k)) & 1) ? 2 : 1); ++rep_)
    unsigned char* ws = P.ws;
    pg8::ssq_t* ss = (pg8::ssq_t*)(ws + WS_SS);
    const float* cosh = (const float*)(ws + WS_COSH); const float* sinh = (const float*)(ws + WS_SINH);
    const float* cosi = (const float*)(ws + WS_COSI); const float* sini = (const float*)(ws + WS_SINI);
    bf16* hb = (bf16*)(ws + WS_HB);
    const int bx = (int)blockIdx.x;

    if (IN(0)) { REP(0) { p0_prologue(F, P); } GRID_BAR(0); }
    if (IN(1)) {
        pg8::Gemm g{hb, (const bf16*)(ws + WS_WIN), S, 4096, D}; pg8::StaticOrder So; So.init(S, 4096, F.G, bx);
        pg8::EpiIn E{ss, cosh, sinh, cosi, sini, (bf16*)(ws + WS_QA), (bf16*)(ws + WS_KA), (bf16*)(ws + WS_VA), (bf16*)(ws + WS_QI), (bf16*)(ws + WS_KI), (float*)(ws + WS_WI)};
        REP(1) { p1_kiwi(F, cosi, sini); pg8::gemm_phase<pg8::EpiIn, pg8::StaticOrder, true, true, true>(F.lds + RING_OFF, g, So, E); }
        GRID_BAR(1);
    }
    if (IN(2)) {
        REP(2) {
            if (F.wave == NWAVES - 1) convert_items<CONV_NF>(F, P, WI0, W_NITEMS, F.vcu, F.G);
            p2_indexer<0>(F);
        } GRID_BAR(2); }
    if (IN(3)) { REP(3) { p3_sparse_fp8(F); } GRID_BAR(3); }
    if (IN(4)) {
        pg8::Gemm g{(const bf16*)(ws + WS_OA), (const bf16*)(ws + WS_WOA), S, D, D}; pg8::StaticOrder So; So.init(S, D, F.G, bx);
        pg8::EpiRes E{hb, ss + 1 * S};
        pg8::gemm_phase<pg8::EpiRes, pg8::StaticOrder, true, true, true>(F.lds + RING_OFF, g, So, E);
        GRID_BAR(4);
    }
    if (IN(5)) {
        pg8::Gemm g{hb, (const bf16*)(ws + WS_WUP), S, FF, D}; pg8::StaticOrder So; So.init(S, FF, F.G, bx);
        pg8::EpiUp E{ss + 1 * S, (bf16*)(ws + WS_U), FF, 0};
        REP(5) pg8::gemm_phase<pg8::EpiUp, pg8::StaticOrder, true, true, true>(F.lds + RING_OFF, g, So, E);
        GRID_BAR(5);
    }
    if (IN(6)) {
        pg8::Gemm g{(const bf16*)(ws + WS_U), (const bf16*)(ws + WS_WDN), S, D, FF}; pg8::StaticOrder So; So.init(S, D, F.G, bx);
        pg8::EpiRes E{hb, ss + 2 * S};
        if (pg8::RowOrder::usable(S, D, F.G)) { pg8::RowOrder Ro; Ro.init(S, D, F.G, bx); pg8::gemm_phase<pg8::EpiRes, pg8::RowOrder, true, true, true>(F.lds + RING_OFF, g, Ro, E); }
        else pg8::gemm_phase<pg8::EpiRes, pg8::StaticOrder, true, true, true>(F.lds + RING_OFF, g, So, E);
        GRID_BAR(6);
    }
    if (IN(7)) {
        pg8::Gemm g{hb, (const bf16*)(ws + WS_WKVQ), S, NKVQ, D}; pg8::StaticOrder So; So.init(S, NKVQ, F.G, bx);
        pg8::EpiKvq E{ss + 2 * S, cosh, sinh, (bf16*)(ws + WS_KS), (bf16*)(ws + WS_VS), (bf16*)(ws + WS_Q2)};
        REP(7) pg8::gemm_phase<pg8::EpiKvq, pg8::StaticOrder, true, true, true>(F.lds + RING_OFF, g, So, E);
        GRID_BAR(7);
    }
    if (IN(8)) { REP(8) { p8_kv_copies(F); } GRID_BAR(8); }
    if (IN(9)) { REP(9) { p9_dilated_dense(F); } GRID_BAR(9); }
    if (IN(10)) {
        pg8::Gemm g{(const bf16*)(ws + WS_O2), (const bf16*)(ws + WS_WOB), S, D, D}; pg8::StaticOrder So; So.init(S, D, F.G, bx);
        pg8::EpiRes E{hb, ss + 3 * S};
        pg8::gemm_phase<pg8::EpiRes, pg8::StaticOrder, true, true, true>(F.lds + RING_OFF, g, So, E);
        GRID_BAR(10);
    }
    if (IN(11)) {
        pg8::Gemm g{hb, (const bf16*)(F.outb + OUT_WUP2), S, FF, D}; pg8::StaticOrder So; So.init(S, FF, F.G, bx);
        pg8::EpiUp E{ss + 3 * S, (bf16*)(ws + WS_U), FF, 0};
        REP(11) pg8::gemm_phase<pg8::EpiUp, pg8::StaticOrder, true, true, true>(F.lds + RING_OFF, g, So, E);
        GRID_BAR(11);
    }
    if (IN(12)) {
        pg8::Gemm g{(const bf16*)(ws + WS_U), (const bf16*)(F.outb + OUT_WDN2), S, D, FF}; pg8::StaticOrder So; So.init(S, D, F.G, bx);
        pg8::EpiRes E{hb, ss + 4 * S};
        if (pg8::RowOrder::usable(S, D, F.G)) { pg8::RowOrder Ro; Ro.init(S, D, F.G, bx); pg8::gemm_phase<pg8::EpiRes, pg8::RowOrder, true, true, true>(F.lds + RING_OFF, g, Ro, E); }
        else pg8::gemm_phase<pg8::EpiRes, pg8::StaticOrder, true, true, true>(F.lds + RING_OFF, g, So, E);
        GRID_BAR(12);
    }
    if (IN(13)) { p13_final(F, P); }
#undef IN
#undef BOTH
#undef GRID_BAR
}

extern "C" void kernel_launch(void* const* d_in, const int* in_sizes, int n_in, void* d_out, int out_size, void* d_ws, size_t ws_size, hipStream_t stream) {
    static int grid = 0;
    if (grid == 0) {
        if (n_in != 13 || in_sizes[0] != S * D || out_size != S * D || ws_size < WS_END) { fprintf(stderr, "kernel_launch: unexpected shapes / workspace (n_in %d, ws %zu, need %zu)\n", n_in, ws_size, (size_t)WS_END); grid = -1; return; }
        int dev = 0, cus = 0, per_cu = 0;
        if (hipGetDevice(&dev) != hipSuccess || hipDeviceGetAttribute(&cus, hipDeviceAttributeMultiprocessorCount, dev) != hipSuccess) { grid = -1; return; }
        if (hipFuncSetAttribute((const void*)yoco_fwd, hipFuncAttributeMaxDynamicSharedMemorySize, LDS_BYTES) != hipSuccess) { fprintf(stderr, "kernel_launch: hipFuncSetAttribute failed\n"); grid = -1; return; }
        if (hipOccupancyMaxActiveBlocksPerMultiprocessor(&per_cu, (const void*)yoco_fwd, NWAVES * 64, LDS_BYTES) != hipSuccess || per_cu < 1) fprintf(stderr, "kernel_launch: occupancy query reports %d\n", per_cu);
        (void)hipGetLastError();
        grid = cus;
    }
    if (grid < 0) return;
    (void)hipMemsetAsync((char*)d_ws + WS_CTL, 0, CTL_ZERO_BYTES, stream);
    Params p{};
    for (int i = 0; i < 13; ++i) p.in[i] = (const float*)d_in[i];
    p.out = (float*)d_out; p.ws = (unsigned char*)d_ws;
    for (int i = 0; i < 16; ++i) p.invh[i] = (float)std::pow(500000.0, (double)(-(float)(2 * i) / 32.0f));
    for (int i = 0; i < 8; ++i) p.invi[i] = (float)std::pow(500000.0, (double)(-(float)(2 * i) / 16.0f));
#if MK_ONE_LAUNCH
    p.ph_lo = 0; p.ph_hi = N_PHASES;
    hipLaunchKernelGGL(yoco_fwd, dim3(grid), dim3(NWAVES * 64), LDS_BYTES, stream, p);
#else
    for (int k = 0; k < N_PHASES; ++k) { p.ph_lo = k; p.ph_hi = k + 1; hipLaunchKernelGGL(yoco_fwd, dim3(grid), dim3(NWAVES * 64), LDS_BYTES, stream, p); }
#endif
}
```
